# Optimizing an MI355X kernel written in HIP

```python
import math
import jax, jax.numpy as jnp
from jax import lax
import numpy as np

D_MODEL = 1024
BATCH = 8
SEQ = 4096
DEPTH = 4

N_MIXERS = 3
N_A = (DEPTH + 2) // 3
N_B = (DEPTH + 1) // 3
N_C = DEPTH // 3

DN_ALPHA = (2.0 * DEPTH) ** 0.25
DN_BETA = (8.0 * DEPTH) ** -0.25
LN_EPS = 1e-5

A_HEADS = 16
A_HEAD_DIM = D_MODEL // A_HEADS
A_BRANCHES = ((128, 1), (512, 4), (2048, 16))
A_BLOCK = 128
A_ROT_DIM = A_HEAD_DIM // 4
ROPE_THETA = 500000.0

B_HEADS = 8
B_QK_DIM = D_MODEL // (2 * B_HEADS)
B_V_DIM = D_MODEL // B_HEADS
B_QK_W = 2 * B_HEADS * B_QK_DIM
B_CONV = 4
B_CHUNK = 64
B_IN = B_QK_W + 2 * D_MODEL + 2 * B_HEADS

C_HEADS = 4
C_QK_DIM = D_MODEL // C_HEADS
C_V_DIM = 2 * D_MODEL // C_HEADS
C_CHUNK = 64
C_THETA = 10000.0
C_IN = 2 * D_MODEL + 4 * D_MODEL

MOE_GROUPS = 8
MOE_PER_GROUP = 8
MOE_EXPERTS = MOE_GROUPS * MOE_PER_GROUP
MOE_TOPK = 2
MOE_HIDDEN = D_MODEL // 4
MOE_BLOCK = 128

kernel_name = "hybrid_dilated_mlstm_retention_hmoe"


def layer_norm(x, g, b):
    xf = x.astype(jnp.float32)
    mu = jnp.mean(xf, -1, keepdims=True)
    var = jnp.mean(jnp.square(xf - mu), -1, keepdims=True)
    return ((xf - mu) * lax.rsqrt(var + LN_EPS) * g + b).astype(x.dtype)


def head_norm(h, g):
    mu = jnp.mean(h, -1, keepdims=True)
    var = jnp.mean(jnp.square(h - mu), -1, keepdims=True)
    return (h - mu) * lax.rsqrt(var + LN_EPS) * g


def rope_tables(positions, dim, theta):
    inv = theta ** (-jnp.arange(0, dim, 2, dtype=jnp.float32) / dim)
    ang = positions.astype(jnp.float32)[:, None] * inv[None, :]
    return jnp.cos(ang), jnp.sin(ang)


def apply_rope(t, cos, sin):
    half = t.shape[-1] // 2
    c, s = cos[:, None, :], sin[:, None, :]
    t1, t2 = t[..., :half], t[..., half:]
    return jnp.concatenate([t1 * c - t2 * s, t2 * c + t1 * s], -1)


def dilated_branch(q, k, v, dilation, n_back):
    b, s, h, dh = q.shape
    L = s // dilation
    nb = -(-L // A_BLOCK)
    Lp = nb * A_BLOCK

    def split(t):
        t = t.reshape(b, L, dilation, h, dh).transpose(0, 2, 3, 1, 4)
        t = jnp.pad(t, ((0, 0), (0, 0), (0, 0), (0, Lp - L), (0, 0)))
        return t.reshape(b, dilation, h, nb, A_BLOCK, dh)

    def with_prev(tb):
        prev = jnp.concatenate([jnp.zeros_like(tb[:, :, :, :1]), tb[:, :, :, :-1]], axis=3)
        return jnp.concatenate([prev, tb], axis=4)

    qb = split(q)
    kb = with_prev(split(k))
    vb = with_prev(split(v))
    scores = jnp.einsum('brhnqd,brhnkd->brhnqk', qb, kb)
    qi = jnp.arange(A_BLOCK)[:, None]
    ki = jnp.arange(2 * A_BLOCK)[None, :]
    rel = qi + A_BLOCK - ki
    kpos = jnp.arange(nb)[:, None, None] * A_BLOCK - A_BLOCK + ki[None]
    mask = (rel >= 0) & (rel <= n_back) & (kpos >= 0)
    scores = jnp.where(mask, scores, -jnp.inf)
    m = jnp.max(scores, -1, keepdims=True)
    p = jnp.exp(scores - m)
    den = jnp.sum(p, -1, keepdims=True)
    o = jnp.einsum('brhnqk,brhnkd->brhnqd', p, vb) / den
    lse = (m + jnp.log(den))[..., 0]
    o = o.reshape(b, dilation, h, Lp, dh)[:, :, :, :L].transpose(0, 3, 1, 2, 4).reshape(b, s, h, dh)
    lse = lse.reshape(b, dilation, h, Lp)[..., :L].transpose(0, 3, 1, 2).reshape(b, s, h)
    return o, lse


def mixer_dilated(x, w_in, w_out, cos, sin):
    b, s, _ = x.shape
    qkv = (x @ w_in).astype(jnp.float32).reshape(b, s, 3, A_HEADS, A_HEAD_DIM)
    q, k, v = qkv[:, :, 0], qkv[:, :, 1], qkv[:, :, 2]
    q = jnp.concatenate([apply_rope(q[..., :A_ROT_DIM], cos, sin), q[..., A_ROT_DIM:]], -1)
    k = jnp.concatenate([apply_rope(k[..., :A_ROT_DIM], cos, sin), k[..., A_ROT_DIM:]], -1)
    q = q * (A_HEAD_DIM ** -0.5)
    outs, lses = [], []
    for window, dilation in A_BRANCHES:
        o_g, lse_g = dilated_branch(q, k, v, dilation, window // dilation)
        outs.append(o_g)
        lses.append(lse_g)
    wts = jax.nn.softmax(jnp.stack(lses, 0), axis=0)
    o = jnp.einsum('gbsh,gbshd->bshd', wts, jnp.stack(outs, 0))
    return o.reshape(b, s, D_MODEL).astype(x.dtype) @ w_out


def causal_depthwise_conv(u, w, bias):
    kw, c = w.shape
    y = lax.conv_general_dilated(u, w[:, None, :].astype(u.dtype), window_strides=(1,),
                                 padding=[(kw - 1, 0)], dimension_numbers=('NWC', 'WIO', 'NWC'),
                                 feature_group_count=c)
    return y + bias.astype(u.dtype)


def mlstm_chunkwise(q, k, v, i_pre, logf):
    b, h, s, dk = q.shape
    dv = v.shape[-1]
    L = B_CHUNK
    nc = s // L
    def chunks(t):
        return jnp.moveaxis(t.reshape(b, h, nc, L, *t.shape[3:]), 2, 0)
    causal = jnp.tril(jnp.ones((L, L), dtype=bool))

    def step(carry, inp):
        C, n, m = carry
        qj, kj, vj, ij, fj = inp
        a = jnp.cumsum(fj, axis=-1)
        dmat = jnp.where(causal, a[..., :, None] - a[..., None, :] + ij[..., None, :], -jnp.inf)
        inter = a + m[..., None]
        m_t = jnp.maximum(inter, jnp.max(dmat, -1))
        sc = jnp.einsum('bhtd,bhsd->bhts', qj, kj) * jnp.exp(dmat - m_t[..., None])
        g_inter = jnp.exp(inter - m_t)
        num = jnp.einsum('bhts,bhsv->bhtv', sc, vj) + g_inter[..., None] * jnp.einsum('bhtd,bhdv->bhtv', qj, C)
        den = jnp.sum(sc, -1) + g_inter * jnp.einsum('bhtd,bhd->bht', qj, n)
        h_out = num / jnp.maximum(jnp.abs(den), jnp.exp(-m_t))[..., None]
        a_end = a[..., -1]
        w_s = a_end[..., None] - a + ij
        m_new = jnp.maximum(a_end + m, jnp.max(w_s, -1))
        decay = jnp.exp(a_end + m - m_new)
        ws = jnp.exp(w_s - m_new[..., None])
        C_new = decay[..., None, None] * C + jnp.einsum('bhs,bhsd,bhsv->bhdv', ws, kj, vj)
        n_new = decay[..., None] * n + jnp.einsum('bhs,bhsd->bhd', ws, kj)
        return (C_new, n_new, m_new), h_out

    init = (jnp.zeros((b, h, dk, dv), jnp.float32), jnp.zeros((b, h, dk), jnp.float32),
            jnp.zeros((b, h), jnp.float32))
    _, hs = lax.scan(step, init, (chunks(q), chunks(k), chunks(v), chunks(i_pre), chunks(logf)))
    return hs.transpose(1, 0, 3, 2, 4).reshape(b, s, h, dv)


def mixer_mlstm(x, w_in, gate_bias, conv_w, conv_b, norm_g, w_out):
    b, s, _ = x.shape
    proj = x @ w_in
    qk = proj[..., :B_QK_W]
    v = proj[..., B_QK_W:B_QK_W + D_MODEL]
    o = proj[..., B_QK_W + D_MODEL:B_QK_W + 2 * D_MODEL]
    gates = proj[..., B_QK_W + 2 * D_MODEL:].astype(jnp.float32) + gate_bias
    qk = jax.nn.silu(causal_depthwise_conv(qk, conv_w, conv_b)).astype(jnp.float32)
    half = B_QK_W // 2
    q = qk[..., :half].reshape(b, s, B_HEADS, B_QK_DIM).transpose(0, 2, 1, 3)
    k = qk[..., half:].reshape(b, s, B_HEADS, B_QK_DIM).transpose(0, 2, 1, 3) * (B_QK_DIM ** -0.5)
    v = v.astype(jnp.float32).reshape(b, s, B_HEADS, B_V_DIM).transpose(0, 2, 1, 3)
    i_pre = gates[..., :B_HEADS].transpose(0, 2, 1)
    logf = jax.nn.log_sigmoid(gates[..., B_HEADS:]).transpose(0, 2, 1)
    hh = mlstm_chunkwise(q, k, v, i_pre, logf)
    hh = head_norm(hh, norm_g.reshape(B_HEADS, B_V_DIM)).reshape(b, s, D_MODEL)
    out = hh * jax.nn.sigmoid(o.astype(jnp.float32))
    return out.astype(x.dtype) @ w_out


def retention_chunkwise(q, k, v):
    b, h, s, dk = q.shape
    dv = v.shape[-1]
    L = C_CHUNK
    nc = s // L
    log_gamma = jnp.log(1.0 - 2.0 ** (-5.0 - jnp.arange(h, dtype=jnp.float32)))
    idx = jnp.arange(L, dtype=jnp.float32)
    rel = idx[:, None] - idx[None, :]
    dmask = jnp.where(rel >= 0, jnp.exp(jnp.maximum(rel, 0.0)[None] * log_gamma[:, None, None]), 0.0)
    xi = jnp.exp((idx + 1.0)[None] * log_gamma[:, None])
    zeta = jnp.exp((L - 1.0 - idx)[None] * log_gamma[:, None])
    chunk_decay = jnp.exp(L * log_gamma)
    def chunks(t):
        return jnp.moveaxis(t.reshape(b, h, nc, L, t.shape[-1]), 2, 0)

    def step(R, inp):
        qj, kj, vj = inp
        sc = jnp.einsum('bhtd,bhsd->bhts', qj, kj) * dmask
        out = jnp.einsum('bhts,bhsv->bhtv', sc, vj) + xi[..., None] * jnp.einsum('bhtd,bhdv->bhtv', qj, R)
        R = chunk_decay[:, None, None] * R + jnp.einsum('bhsd,bhsv->bhdv', kj * zeta[..., None], vj)
        return R, out

    _, outs = lax.scan(step, jnp.zeros((b, h, dk, dv), jnp.float32), (chunks(q), chunks(k), chunks(v)))
    return outs.transpose(1, 0, 3, 2, 4).reshape(b, s, h, dv)


def mixer_retention(x, w_in, norm_g, w_out, cos, sin):
    b, s, _ = x.shape
    proj = x @ w_in
    q = proj[..., :D_MODEL].astype(jnp.float32).reshape(b, s, C_HEADS, C_QK_DIM)
    k = proj[..., D_MODEL:2 * D_MODEL].astype(jnp.float32).reshape(b, s, C_HEADS, C_QK_DIM)
    v = proj[..., 2 * D_MODEL:4 * D_MODEL].astype(jnp.float32).reshape(b, s, C_HEADS, C_V_DIM)
    g = proj[..., 4 * D_MODEL:].astype(jnp.float32)
    q = apply_rope(q, cos, sin).transpose(0, 2, 1, 3)
    k = (apply_rope(k, cos, sin) * (C_QK_DIM ** -0.5)).transpose(0, 2, 1, 3)
    v = v.transpose(0, 2, 1, 3)
    o = retention_chunkwise(q, k, v)
    o = head_norm(o, norm_g.reshape(C_HEADS, C_V_DIM)).reshape(b, s, 2 * D_MODEL)
    o = o * jax.nn.silu(g)
    return o.astype(x.dtype) @ w_out


def moe_ffn(x, wg_r, bg_r, we_r, be_r, w_gate, w_up, w_down):
    b, s, d = x.shape
    xt = x.reshape(-1, d)
    n = xt.shape[0]
    g_logits = (xt @ wg_r).astype(jnp.float32) + bg_r
    grp = jnp.argmax(g_logits, -1)
    p_grp = jnp.take_along_axis(jax.nn.softmax(g_logits, -1), grp[:, None], -1)[:, 0]
    e_logits = ((xt @ we_r).astype(jnp.float32) + be_r).reshape(n, MOE_GROUPS, MOE_PER_GROUP)
    e_in = jnp.take_along_axis(e_logits, grp[:, None, None], axis=1)[:, 0]
    top_v, top_i = lax.top_k(e_in, MOE_TOPK)
    gates = jax.nn.softmax(top_v, -1) * p_grp[:, None]
    eid = (grp[:, None] * MOE_PER_GROUP + top_i).reshape(-1).astype(jnp.int32)
    tok = jnp.repeat(jnp.arange(n, dtype=jnp.int32), MOE_TOPK)
    order = jnp.argsort(eid)
    eid_s, tok_s, gate_s = eid[order], tok[order], gates.reshape(-1)[order]
    counts = jnp.bincount(eid, length=MOE_EXPERTS)
    starts = jnp.cumsum(counts) - counts
    padded = (counts + MOE_BLOCK - 1) // MOE_BLOCK * MOE_BLOCK
    pends = jnp.cumsum(padded)
    pstarts = pends - padded
    n_assign = n * MOE_TOPK
    dest = pstarts[eid_s] + (jnp.arange(n_assign) - starts[eid_s])
    P = n_assign + MOE_EXPERTS * MOE_BLOCK
    nb = P // MOE_BLOCK
    buf_tok = jnp.full((P,), n, jnp.int32).at[dest].set(tok_s)
    x_pad = jnp.concatenate([xt, jnp.zeros((1, d), xt.dtype)], 0)
    xb = x_pad[buf_tok].reshape(nb, MOE_BLOCK, d)
    blk_e = jnp.minimum(jnp.searchsorted(pends, jnp.arange(nb) * MOE_BLOCK, side='right'), MOE_EXPERTS - 1)

    def expert_block(args):
        xblk, e = args
        return (jax.nn.silu(xblk @ w_gate[e]) * (xblk @ w_up[e])) @ w_down[e]

    yb = lax.map(expert_block, (xb, blk_e)).reshape(P, d)
    y = yb[dest] * gate_s[:, None].astype(x.dtype)
    out = jnp.zeros((n, d), x.dtype).at[tok_s].add(y)
    return out.reshape(b, s, d)


def setup_inputs(seed: int = 0) -> dict:
    key = jax.random.key(seed)
    ks = jax.random.split(key, 26)
    f32 = jnp.float32
    D = D_MODEL
    def nrm(k, shape, scale):
        return jax.random.normal(k, shape, f32) * scale
    return {
        "x": nrm(ks[0], (BATCH, SEQ, D), 1.0),
        "positions": jnp.arange(SEQ, dtype=jnp.int32),
        "ln1_g": 1.0 + nrm(ks[1], (DEPTH, D), 0.02),
        "ln1_b": nrm(ks[2], (DEPTH, D), 0.02),
        "ln2_g": 1.0 + nrm(ks[3], (DEPTH, D), 0.02),
        "ln2_b": nrm(ks[4], (DEPTH, D), 0.02),
        "a_w_in": nrm(ks[5], (N_A, D, 3 * D), D ** -0.5),
        "a_w_out": nrm(ks[6], (N_A, D, D), DN_BETA * D ** -0.5),
        "b_w_in": nrm(ks[7], (N_B, D, B_IN), D ** -0.5),
        "b_gate_bias": jnp.concatenate([nrm(ks[8], (N_B, B_HEADS), 0.1),
                                        jnp.broadcast_to(jnp.linspace(3.0, 6.0, B_HEADS, dtype=f32), (N_B, B_HEADS))
                                        + nrm(ks[9], (N_B, B_HEADS), 0.1)], -1),
        "b_conv_w": nrm(ks[10], (N_B, B_CONV, B_QK_W), B_CONV ** -0.5),
        "b_conv_b": nrm(ks[11], (N_B, B_QK_W), 0.02),
        "b_norm_g": 1.0 + nrm(ks[12], (N_B, D), 0.02),
        "b_w_out": nrm(ks[13], (N_B, D, D), DN_BETA * D ** -0.5),
        "c_w_in": nrm(ks[14], (N_C, D, C_IN), D ** -0.5),
        "c_norm_g": 1.0 + nrm(ks[15], (N_C, 2 * D), 0.02),
        "c_w_out": nrm(ks[16], (N_C, 2 * D, D), DN_BETA * (2 * D) ** -0.5),
        "r_group_w": nrm(ks[17], (DEPTH, D, MOE_GROUPS), D ** -0.5),
        "r_group_b": nrm(ks[18], (DEPTH, MOE_GROUPS), 0.01),
        "r_expert_w": nrm(ks[19], (DEPTH, D, MOE_EXPERTS), D ** -0.5),
        "r_expert_b": nrm(ks[20], (DEPTH, MOE_EXPERTS), 0.01),
        "e_w_gate": nrm(ks[21], (DEPTH, MOE_EXPERTS, D, MOE_HIDDEN), D ** -0.5),
        "e_w_up": nrm(ks[22], (DEPTH, MOE_EXPERTS, D, MOE_HIDDEN), D ** -0.5),
        "e_w_down": nrm(ks[23], (DEPTH, MOE_EXPERTS, MOE_HIDDEN, D), DN_BETA * MOE_HIDDEN ** -0.5),
    }


def reference(x, positions, ln1_g, ln1_b, ln2_g, ln2_b, a_w_in, a_w_out, b_w_in, b_gate_bias,
              b_conv_w, b_conv_b, b_norm_g, b_w_out, c_w_in, c_norm_g, c_w_out, r_group_w,
              r_group_b, r_expert_w, r_expert_b, e_w_gate, e_w_up, e_w_down):
    cos_a, sin_a = rope_tables(positions, A_ROT_DIM, ROPE_THETA)
    cos_c, sin_c = rope_tables(positions, C_QK_DIM, C_THETA)
    h = x
    for i in range(DEPTH):
        kind, j = i % N_MIXERS, i // N_MIXERS
        if kind == 0:
            y = mixer_dilated(h, a_w_in[j], a_w_out[j], cos_a, sin_a)
        elif kind == 1:
            y = mixer_mlstm(h, b_w_in[j], b_gate_bias[j], b_conv_w[j], b_conv_b[j], b_norm_g[j], b_w_out[j])
        else:
            y = mixer_retention(h, c_w_in[j], c_norm_g[j], c_w_out[j], cos_c, sin_c)
        h = layer_norm(DN_ALPHA * h + y, ln1_g[i], ln1_b[i])
        y = moe_ffn(h, r_group_w[i], r_group_b[i], r_expert_w[i], r_expert_b[i],
                    e_w_gate[i], e_w_up[i], e_w_down[i])
        h = layer_norm(DN_ALPHA * h + y, ln2_g[i], ln2_b[i])
    return h
```

```cpp
#define EN_MIX_A 1
#define EN_MIX_B 1
#define EN_MIX_C 1
#define EN_MOE 1
#include <hip/hip_runtime.h>
#include <hip/hip_cooperative_groups.h>
#include <cstdio>
#include <cstdint>
#include <cmath>
namespace cg = cooperative_groups;

#ifndef EN_MIX_A
#define EN_MIX_A 1
#endif
#ifndef EN_MIX_B
#define EN_MIX_B 1
#endif
#ifndef EN_MIX_C
#define EN_MIX_C 1
#endif
#ifndef EN_MOE
#define EN_MOE 1
#endif

#define LAS __attribute__((address_space(3)))
typedef unsigned short bf16_t;
typedef short bf16x8 __attribute__((ext_vector_type(8)));
typedef short s16x4 __attribute__((ext_vector_type(4)));
typedef float f32x4 __attribute__((ext_vector_type(4)));
typedef float f32x2 __attribute__((ext_vector_type(2)));
typedef unsigned u32x4 __attribute__((ext_vector_type(4)));
typedef unsigned u32x2 __attribute__((ext_vector_type(2)));

constexpr int NTOK = 32768, DM = 1024, SEQ = 4096, NBATCH = 8, DEPTH = 4;
constexpr float DN_ALPHA = 1.6817928305074292f;
constexpr float LN_EPS = 1e-5f;
constexpr int MOE_MAXROWS = 81920;
constexpr int MOE_MAXTILES = 320;

constexpr size_t al256(size_t x) { return (x + 255) & ~(size_t)255; }
constexpr size_t OFF_CTL = 0, SZ_CTL = 1u << 20;
constexpr size_t OFF_COSA = OFF_CTL + SZ_CTL;
constexpr size_t OFF_SINA = OFF_COSA + (size_t)SEQ * 8 * 4;
constexpr size_t OFF_COSC = OFF_SINA + (size_t)SEQ * 8 * 4;
constexpr size_t OFF_SINC = OFF_COSC + (size_t)SEQ * 128 * 4;
constexpr size_t OFF_PAR = OFF_SINC + (size_t)SEQ * 128 * 4;
constexpr int PAR_LN1G = 0, PAR_LN1B = 4096, PAR_LN2G = 8192, PAR_LN2B = 12288, PAR_GBIAS = 16384, PAR_CONVW = 16400, PAR_CONVB = 20496, PAR_BNG = 21520, PAR_CNG = 22544, PAR_RGB = 24592, PAR_REB = 24624, PAR_END = 24880;
constexpr size_t OFF_WG = OFF_PAR + (size_t)25088 * 4;
constexpr size_t OFF_WR = OFF_WG + 16 * 1024 * 4;
constexpr size_t OFF_WA_IN = OFF_WR + (size_t)4 * 2 * 80 * 1024 * 2;
constexpr size_t OFF_WA_OUT = OFF_WA_IN + (size_t)2 * 3072 * 1024 * 2;
constexpr size_t OFF_WB_IN = OFF_WA_OUT + (size_t)2 * 1024 * 1024 * 2;
constexpr size_t OFF_WB_OUT = OFF_WB_IN + (size_t)3072 * 1024 * 2;
constexpr size_t OFF_WC_IN = OFF_WB_OUT + (size_t)1024 * 1024 * 2;
constexpr size_t OFF_WC_OUT = OFF_WC_IN + (size_t)6144 * 1024 * 2;
constexpr size_t OFF_WE_GU = OFF_WC_OUT + (size_t)1024 * 2048 * 2;
constexpr size_t OFF_WE_D = OFF_WE_GU + (size_t)64 * 512 * 1024 * 2;
constexpr size_t OFF_H = OFF_WE_D + (size_t)64 * 1024 * 256 * 2;
constexpr size_t OFF_HB = OFF_H + (size_t)NTOK * DM * 4;
constexpr size_t OFF_GATES = OFF_HB + (size_t)NTOK * DM * 2;
constexpr size_t OFF_EID = OFF_GATES + (size_t)NTOK * 16 * 4;
constexpr size_t OFF_GATE = OFF_EID + (size_t)NTOK * 2 * 4;
constexpr size_t OFF_SLOT = OFF_GATE + (size_t)NTOK * 2 * 4;
constexpr size_t OFF_ROWGATE = OFF_SLOT + (size_t)NTOK * 2 * 4;
constexpr size_t OFF_R = al256(OFF_ROWGATE + (size_t)MOE_MAXROWS * 4);
constexpr size_t SZ_TOK1K = (size_t)NTOK * 1024 * 2;
constexpr size_t RA_Q = 0, RA_K = SZ_TOK1K, RA_V = 2 * SZ_TOK1K, RA_OG = 3 * SZ_TOK1K, RA_LSE = 6 * SZ_TOK1K;
constexpr size_t RB_PROJ = 0, RB_ORAW = 3 * SZ_TOK1K, RB_ONORM = 4 * SZ_TOK1K;
constexpr size_t RC_Q = 0, RC_K = SZ_TOK1K, RC_V = 2 * SZ_TOK1K, RC_G = 4 * SZ_TOK1K, RC_ORAW = 6 * SZ_TOK1K;
constexpr size_t RM_XB = 0, RM_HID = (size_t)MOE_MAXROWS * 1024 * 2, RM_YEXP = RM_HID + (size_t)MOE_MAXROWS * 256 * 2;
constexpr size_t SZ_R = 8 * SZ_TOK1K;
constexpr size_t WS_END = OFF_R + SZ_R;
static_assert(RA_LSE + (size_t)3 * NTOK * 16 * 4 <= SZ_R && RM_YEXP + (size_t)MOE_MAXROWS * 1024 * 2 <= SZ_R, "region R");

constexpr int LDS_BYTES = 163840;
constexpr int LDS_MISC = 131072;

__device__ __forceinline__ unsigned f2bf(float f) { unsigned u = __builtin_bit_cast(unsigned, f); return (u + 0x7fffu + ((u >> 16) & 1u)) >> 16; }
__device__ __forceinline__ unsigned pk2(float lo, float hi) { return f2bf(lo) | (f2bf(hi) << 16); }
__device__ __forceinline__ float bf2f(unsigned short b) { return __builtin_bit_cast(float, (unsigned)b << 16); }
__device__ __forceinline__ float bflo(unsigned w) { return __builtin_bit_cast(float, w << 16); }
__device__ __forceinline__ float bfhi(unsigned w) { return __builtin_bit_cast(float, w & 0xffff0000u); }
__device__ __forceinline__ float wave_sum(float v) {
#pragma unroll
    for (int o = 1; o < 64; o <<= 1) v += __shfl_xor(v, o);
    return v;
}
__device__ __forceinline__ float silu_f(float x) { return x / (1.f + __expf(-x)); }
__device__ __forceinline__ float sigmoid_f(float x) { return 1.f / (1.f + __expf(-x)); }

namespace pg8 {
#define PG8_LAS __attribute__((address_space(3)))
typedef unsigned short bf16_t;
typedef short bf16x8 __attribute__((ext_vector_type(8)));
typedef float f32x4 __attribute__((ext_vector_type(4)));
typedef unsigned u32x4 __attribute__((ext_vector_type(4)));
constexpr int BM = 256, BK = 64, HALF = 128, HTB = HALF * BK * 2  , STAGE_BYTES = 8 * HTB, NXCD = 8, WGM = 8;

__host__ __device__ __forceinline__ int lds_byte(int r, int c) { const int st = (r >> 4) * 2 + (c >> 5), rr = r & 15, cc = c & 31, ob = rr * 64 + cc * 2; return st * 1024 + (ob ^ (((ob >> 9) & 1) << 5)); }
__host__ __device__ __forceinline__ void stage_rc(int b, int& R, int& C) { const int st = b / 1024, sb = b % 1024, swz = sb ^ (((sb >> 9) & 1) << 5); R = (st >> 1) * 16 + swz / 64; C = (st & 1) * 32 + (swz % 64) / 2; }
__host__ __device__ __forceinline__ int perm32(int rho) { const int n = rho >> 4, i = rho & 15; return 8 * (i >> 2) + 4 * n + (i & 3); }

struct Unit { int pm, pn, pb; };
struct Gemm { const bf16_t* A; const bf16_t* Bt; int M, N, K; };

struct StaticOrder {
    int nM, nN, nwg, G, c;
    __host__ __device__ void init(int M, int N, int G_, int c_) { nM = M / BM; nN = N / BM; nwg = nM * nN; G = G_; c = c_; }
    __host__ __device__ bool next(int i, Unit& u) const {
        const long L = (long)i * G + c; if (L >= nwg) return false;
        int wgid = (int)L; { const int q = nwg / NXCD, r = nwg % NXCD, xcd = wgid % NXCD, off = wgid / NXCD; wgid = (xcd < r ? xcd * (q + 1) : r * (q + 1) + (xcd - r) * q) + off; }
        const int nig = WGM * nN, gid = wgid / nig, fm = gid * WGM, gsz = (nM - fm) < WGM ? (nM - fm) : WGM;
        u.pm = fm + ((wgid % nig) % gsz); u.pn = (wgid % nig) / gsz; u.pb = u.pn; return true;
    }
    __device__ __forceinline__ void a_ready(const Unit&) const {}
    __device__ __forceinline__ void done(const Unit&) const {}
};
__device__ __forceinline__ unsigned cvt_pk_bf16(float lo, float hi) { unsigned r; asm volatile("v_cvt_pk_bf16_f32 %0, %1, %2" : "=v"(r) : "v"(lo), "v"(hi)); return r; }
typedef float f32x2 __attribute__((ext_vector_type(2)));
template <class Epi, class Sched, bool ALIGN_EPI = false, bool SP2 = false>
__device__ __forceinline__ void gemm_phase(PG8_LAS unsigned char* lds, const Gemm g, const Sched& S, const Epi& E, const int tid) {
    const int wid = __builtin_amdgcn_readfirstlane(tid >> 6), lane = tid & 63, wr = wid >> 2, wc = wid & 3, fr = lane & 15, fq = lane >> 4;
    const int K = g.K, nt = K / BK;
    unsigned voffA[2], voffB[2];
#pragma unroll
    for (int i = 0; i < 2; ++i) { int R, C; stage_rc(tid * 16 + i * 8192, R, C); const int Rb = Epi::PERM ? ((R & ~31) + perm32(R & 31)) : R;
        voffA[i] = (unsigned)(R * K + C) * 2u; voffB[i] = (unsigned)(Rb * K + C) * 2u; }
    const size_t kstep = (size_t)(BK * 2);
    const size_t hstep = (size_t)HALF * K * 2;
    const size_t tstep = 2 * hstep;
    const unsigned ldsw = (unsigned)wid * 1024u;
    const int aoff = lds_byte(wr * 64 + fr, fq * 8), boff = lds_byte(wc * 32 + fr, fq * 8);
#define PG8_SA(b, h) (((b) * 2 + (h)) * HTB)
#define PG8_SB(b, h) ((4 + (b) * 2 + (h)) * HTB)
#define PG8_STAGE(bufoff, gbase, voff) do { _Pragma("unroll") for (int _i = 0; _i < 2; ++_i) \
        __builtin_amdgcn_global_load_lds((const unsigned*)((const char*)(gbase) + (voff)[_i]), (PG8_LAS unsigned*)(lds + (bufoff) + ldsw + _i * 8192), 16, 0, 0); } while (0)
#define PG8_LDA(dst, b, h) do { _Pragma("unroll") for (int m = 0; m < 4; ++m) _Pragma("unroll") for (int k = 0; k < 2; ++k) dst[m][k] = *(const PG8_LAS bf16x8*)(lds + PG8_SA(b, h) + aoff + m * 2048 + k * 1024); } while (0)
#define PG8_LDB(dst, b, h) do { _Pragma("unroll") for (int n = 0; n < 2; ++n) _Pragma("unroll") for (int k = 0; k < 2; ++k) dst[n][k] = *(const PG8_LAS bf16x8*)(lds + PG8_SB(b, h) + boff + n * 2048 + k * 1024); } while (0)
#define PG8_MMA(ai, bj, At, Bt) do { __builtin_amdgcn_s_setprio(1); _Pragma("unroll") for (int m = 0; m < 4; ++m) _Pragma("unroll") for (int n = 0; n < 2; ++n) _Pragma("unroll") for (int k = 0; k < 2; ++k) \
        acc[ai][bj][m][n] = __builtin_amdgcn_mfma_f32_16x16x32_bf16(Bt[n][k], At[m][k], acc[ai][bj][m][n], 0, 0, 0); __builtin_amdgcn_s_setprio(0); } while (0)
#define PG8_WAIT_V(n) asm volatile("s_waitcnt vmcnt(" #n ")" ::: "memory")
#define PG8_WAIT_L(n) asm volatile("s_waitcnt lgkmcnt(" #n ")" ::: "memory")
#define PG8_BAR __builtin_amdgcn_s_barrier()
#define PG8_SCHED __builtin_amdgcn_sched_barrier(0)
    Unit cur, nxt; int ui = 0;
    if (!S.next(0, cur)) return;
    f32x4 acc[2][2][4][2];
#pragma unroll
    for (int a = 0; a < 2; ++a)
#pragma unroll
        for (int b = 0; b < 2; ++b)
#pragma unroll
            for (int m = 0; m < 4; ++m)
#pragma unroll
                for (int n = 0; n < 2; ++n) acc[a][b][m][n] = (f32x4){0.f, 0.f, 0.f, 0.f};
    bf16x8 At[4][2], B0[2][2], B1[2][2];
    const char* cA = (const char*)g.A + (size_t)cur.pm * tstep; const char* cB = (const char*)g.Bt + (size_t)cur.pb * tstep;
    S.a_ready(cur);
    if constexpr (SP2) {
        PG8_STAGE(PG8_SB(0, 0), cB, voffB); PG8_STAGE(PG8_SB(0, 1), cB + hstep, voffB); PG8_STAGE(PG8_SA(0, 0), cA, voffA); PG8_STAGE(PG8_SA(0, 1), cA + hstep, voffA);
        if (wr == 1) PG8_BAR;
        PG8_WAIT_V(2); PG8_BAR;
        PG8_STAGE(PG8_SB(1, 0), cB + kstep, voffB); PG8_STAGE(PG8_SA(1, 0), cA + kstep, voffA); PG8_STAGE(PG8_SB(1, 1), cB + hstep + kstep, voffB);
        PG8_WAIT_V(6); PG8_BAR;
    } else {
        PG8_STAGE(PG8_SB(0, 0), cB, voffB); PG8_STAGE(PG8_SA(0, 0), cA, voffA); PG8_STAGE(PG8_SB(0, 1), cB + hstep, voffB); PG8_STAGE(PG8_SA(0, 1), cA + hstep, voffA);
        if (wr == 1) PG8_BAR;
        PG8_WAIT_V(4); PG8_BAR;
        PG8_STAGE(PG8_SB(1, 0), cB + kstep, voffB); PG8_STAGE(PG8_SA(1, 0), cA + kstep, voffA); PG8_STAGE(PG8_SB(1, 1), cB + hstep + kstep, voffB);
        PG8_WAIT_V(6); PG8_BAR;
    }
    for (;;) {
        const bool has_next = S.next(ui + 1, nxt);
        const char* nA = has_next ? (const char*)g.A + (size_t)nxt.pm * tstep : cA; const char* nB = has_next ? (const char*)g.Bt + (size_t)nxt.pb * tstep : cB;
#pragma unroll 1
        for (int t = 0; t < nt; t += 2) {
            const bool last = (t == nt - 2);
            const char* a1 = cA + (size_t)(t + 1) * kstep;
            const char* a2 = last ? nA : cA + (size_t)(t + 2) * kstep; const char* b2 = last ? nB : cB + (size_t)(t + 2) * kstep;
            const char* a3 = a2 + kstep; const char* b3 = b2 + kstep;
            if (last && has_next) S.a_ready(nxt);
            if constexpr (SP2) {
            PG8_LDB(B0, 0, 0); PG8_LDB(B1, 0, 1); PG8_SCHED; PG8_LDA(At, 0, 0); PG8_STAGE(PG8_SA(1, 1), a1 + hstep, voffA);
            PG8_WAIT_V(8); PG8_WAIT_L(0); PG8_BAR; PG8_MMA(0, 0, At, B0); PG8_MMA(0, 1, At, B1); PG8_BAR; PG8_SCHED;
            PG8_LDA(At, 0, 1); PG8_STAGE(PG8_SB(0, 0), b2, voffB); PG8_STAGE(PG8_SB(0, 1), b2 + hstep, voffB); PG8_STAGE(PG8_SA(0, 0), a2, voffA);
            PG8_WAIT_V(8); PG8_WAIT_L(0); PG8_BAR; PG8_MMA(1, 0, At, B0); PG8_MMA(1, 1, At, B1); PG8_BAR; PG8_SCHED;
            PG8_LDB(B0, 1, 0); PG8_LDB(B1, 1, 1); PG8_SCHED; PG8_LDA(At, 1, 0); PG8_STAGE(PG8_SA(0, 1), a2 + hstep, voffA);
            PG8_WAIT_V(8); PG8_WAIT_L(0); PG8_BAR; PG8_MMA(0, 0, At, B0); PG8_MMA(0, 1, At, B1); PG8_BAR; PG8_SCHED;
            PG8_LDA(At, 1, 1); PG8_STAGE(PG8_SB(1, 0), b3, voffB); PG8_STAGE(PG8_SB(1, 1), b3 + hstep, voffB); PG8_STAGE(PG8_SA(1, 0), a3, voffA);
            PG8_WAIT_V(8); PG8_WAIT_L(0); PG8_BAR; PG8_MMA(1, 0, At, B0); PG8_MMA(1, 1, At, B1); PG8_BAR; PG8_SCHED;
            } else {
            PG8_LDB(B0, 0, 0); PG8_SCHED; PG8_LDA(At, 0, 0); PG8_STAGE(PG8_SA(1, 1), a1 + hstep, voffA);
            PG8_WAIT_L(8); PG8_BAR; PG8_WAIT_L(0); PG8_MMA(0, 0, At, B0); PG8_BAR; PG8_SCHED;
            PG8_LDB(B1, 0, 1); PG8_STAGE(PG8_SB(0, 0), b2, voffB);
            PG8_BAR; PG8_WAIT_L(0); PG8_MMA(0, 1, At, B1); PG8_BAR;
            PG8_LDA(At, 0, 1); PG8_STAGE(PG8_SA(0, 0), a2, voffA);
            PG8_BAR; PG8_WAIT_L(0); PG8_MMA(1, 0, At, B0); PG8_BAR; PG8_SCHED;
            PG8_STAGE(PG8_SB(0, 1), b2 + hstep, voffB);
            PG8_WAIT_V(6); PG8_BAR; PG8_MMA(1, 1, At, B1); PG8_BAR;
            PG8_LDB(B0, 1, 0); PG8_SCHED; PG8_LDA(At, 1, 0); PG8_STAGE(PG8_SA(0, 1), a2 + hstep, voffA);
            PG8_WAIT_L(8); PG8_BAR; PG8_WAIT_L(0); PG8_MMA(0, 0, At, B0); PG8_BAR; PG8_SCHED;
            PG8_LDB(B1, 1, 1); PG8_STAGE(PG8_SB(1, 0), b3, voffB);
            PG8_BAR; PG8_WAIT_L(0); PG8_MMA(0, 1, At, B1); PG8_BAR;
            PG8_LDA(At, 1, 1); PG8_STAGE(PG8_SA(1, 0), a3, voffA);
            PG8_BAR; PG8_WAIT_L(0); PG8_MMA(1, 0, At, B0); PG8_BAR; PG8_SCHED;
            PG8_STAGE(PG8_SB(1, 1), b3 + hstep, voffB);
            PG8_WAIT_V(6); PG8_BAR; PG8_MMA(1, 1, At, B1); PG8_BAR;
            }
        }
        if constexpr (ALIGN_EPI) { if (wr == 0) PG8_BAR; }
        if constexpr (!Epi::AFTER_DRAIN) { E(acc, cur, wr, wc, fr, fq); S.done(cur); }
        if (!has_next) break;
#pragma unroll
        for (int a = 0; a < 2; ++a)
#pragma unroll
            for (int b = 0; b < 2; ++b)
#pragma unroll
                for (int m = 0; m < 4; ++m)
#pragma unroll
                    for (int n = 0; n < 2; ++n) acc[a][b][m][n] = (f32x4){0.f, 0.f, 0.f, 0.f};
        cur = nxt; cA = nA; cB = nB; ++ui;
        if constexpr (ALIGN_EPI) { if (wr == 1) PG8_BAR; }
    }
    PG8_WAIT_V(0);
    if constexpr (!ALIGN_EPI) { if (wr == 0) PG8_BAR; }
    PG8_BAR;
    if constexpr (Epi::AFTER_DRAIN) { E.fused(acc, cur, wr, wc, fr, fq, lds, wid, lane); S.done(cur); }
#undef PG8_SA
#undef PG8_SB
#undef PG8_STAGE
#undef PG8_LDA
#undef PG8_LDB
#undef PG8_MMA
#undef PG8_WAIT_V
#undef PG8_WAIT_L
#undef PG8_BAR
#undef PG8_SCHED
}

typedef unsigned u32x2 __attribute__((ext_vector_type(2)));
constexpr int kSeq = 4096;

struct EpiQkvA {
    static constexpr bool PERM = false, AFTER_DRAIN = false;
    bf16_t* QKV; size_t stride; const float *cosA, *sinA;
    __device__ __forceinline__ void operator()(const f32x4 (&acc)[2][2][4][2], const Unit& u, int wr, int wc, int fr, int fq) const {
        const int sel = u.pn >> 2; bf16_t* base = QKV + (size_t)sel * stride;
        const float sc = sel == 0 ? 0.125f : 1.f;
        const int colt = (u.pn & 3) * 256 + wc * 32 + 4 * fq;
        const bool rot = (sel < 2) && ((wc & 1) == 0);
#pragma unroll
        for (int ai = 0; ai < 2; ++ai)
#pragma unroll
            for (int m = 0; m < 4; ++m) {
                const int row = u.pm * BM + ai * HALF + wr * 64 + m * 16 + fr;
                f32x4 cs = {1.f, 1.f, 1.f, 1.f}, sn = {0.f, 0.f, 0.f, 0.f};
                if (rot) { const int sp = row & (kSeq - 1); cs = *(const f32x4*)(cosA + sp * 8 + 4 * (fq & 1)); sn = *(const f32x4*)(sinA + sp * 8 + 4 * (fq & 1)); }
#pragma unroll
                for (int bj = 0; bj < 2; ++bj)
#pragma unroll
                    for (int n = 0; n < 2; ++n) {
                        f32x4 v = acc[ai][bj][m][n];
                        if (n == 0 && rot) {
                            f32x4 p; p[0] = __shfl_xor(v[0], 32); p[1] = __shfl_xor(v[1], 32); p[2] = __shfl_xor(v[2], 32); p[3] = __shfl_xor(v[3], 32);
                            v = (fq < 2) ? (v * cs - p * sn) : (v * cs + p * sn);
                        }
                        v = v * sc;
                        u32x2 w; w.x = cvt_pk_bf16(v[0], v[1]); w.y = cvt_pk_bf16(v[2], v[3]);
                        *(u32x2*)(base + (size_t)row * 1024 + colt + bj * HALF + n * 16) = w;
                    }
            }
    }
};

struct EpiBf16Plain {
    static constexpr bool PERM = true, AFTER_DRAIN = false;
    bf16_t* O; int ldc;
    __device__ __forceinline__ void operator()(const f32x4 (&acc)[2][2][4][2], const Unit& u, int wr, int wc, int fr, int fq) const {
        const int row0 = u.pm * BM + wr * 64 + fr, col0 = u.pn * BM + wc * 32 + 8 * fq;
#pragma unroll
        for (int ai = 0; ai < 2; ++ai)
#pragma unroll
            for (int m = 0; m < 4; ++m) { bf16_t* rowp = O + (size_t)(row0 + ai * HALF + m * 16) * ldc + col0;
#pragma unroll
                for (int bj = 0; bj < 2; ++bj) { const f32x4 v0 = acc[ai][bj][m][0], v1 = acc[ai][bj][m][1];
                    u32x4 w; w.x = cvt_pk_bf16(v0[0], v0[1]); w.y = cvt_pk_bf16(v0[2], v0[3]); w.z = cvt_pk_bf16(v1[0], v1[1]); w.w = cvt_pk_bf16(v1[2], v1[3]);
                    *(u32x4*)(rowp + bj * HALF) = w; } }
    }
};

struct EpiProjC {
    static constexpr bool PERM = true, AFTER_DRAIN = false;
    bf16_t *QK, *VG; size_t qk_stride, vg_stride; const float *cosC, *sinC;
    __device__ __forceinline__ void operator()(const f32x4 (&acc)[2][2][4][2], const Unit& u, int wr, int wc, int fr, int fq) const {
        const int row0 = u.pm * BM + wr * 64 + fr;
        if (u.pn < 8) {
            const bool isk = u.pn >= 4; bf16_t* base = QK + (isk ? qk_stride : (size_t)0); const float sc = isk ? 0.0625f : 1.f;
            const int i0 = wc * 32 + 8 * fq, colb = (u.pn & 3) * 256 + i0;
#pragma unroll
            for (int ai = 0; ai < 2; ++ai)
#pragma unroll
                for (int m = 0; m < 4; ++m) {
                    const int row = row0 + ai * HALF + m * 16, sp = row & (kSeq - 1);
                    const f32x4 c0 = *(const f32x4*)(cosC + sp * 128 + i0), c1 = *(const f32x4*)(cosC + sp * 128 + i0 + 4);
                    const f32x4 s0 = *(const f32x4*)(sinC + sp * 128 + i0), s1 = *(const f32x4*)(sinC + sp * 128 + i0 + 4);
                    const f32x4 x1a = acc[ai][0][m][0], x1b = acc[ai][0][m][1], x2a = acc[ai][1][m][0], x2b = acc[ai][1][m][1];
                    const f32x4 o1a = (x1a * c0 - x2a * s0) * sc, o1b = (x1b * c1 - x2b * s1) * sc;
                    const f32x4 o2a = (x2a * c0 + x1a * s0) * sc, o2b = (x2b * c1 + x1b * s1) * sc;
                    bf16_t* rowp = base + (size_t)row * 1024 + colb;
                    u32x4 w; w.x = cvt_pk_bf16(o1a[0], o1a[1]); w.y = cvt_pk_bf16(o1a[2], o1a[3]); w.z = cvt_pk_bf16(o1b[0], o1b[1]); w.w = cvt_pk_bf16(o1b[2], o1b[3]);
                    *(u32x4*)rowp = w;
                    w.x = cvt_pk_bf16(o2a[0], o2a[1]); w.y = cvt_pk_bf16(o2a[2], o2a[3]); w.z = cvt_pk_bf16(o2b[0], o2b[1]); w.w = cvt_pk_bf16(o2b[2], o2b[3]);
                    *(u32x4*)(rowp + HALF) = w;
                }
        } else {
            bf16_t* base = VG + (u.pn >= 16 ? vg_stride : (size_t)0); const int col0 = ((u.pn - 8) & 7) * 256 + wc * 32 + 8 * fq;
#pragma unroll
            for (int ai = 0; ai < 2; ++ai)
#pragma unroll
                for (int m = 0; m < 4; ++m) { bf16_t* rowp = base + (size_t)(row0 + ai * HALF + m * 16) * 2048 + col0;
#pragma unroll
                    for (int bj = 0; bj < 2; ++bj) { const f32x4 v0 = acc[ai][bj][m][0], v1 = acc[ai][bj][m][1];
                        u32x4 w; w.x = cvt_pk_bf16(v0[0], v0[1]); w.y = cvt_pk_bf16(v0[2], v0[3]); w.z = cvt_pk_bf16(v1[0], v1[1]); w.w = cvt_pk_bf16(v1[2], v1[3]);
                        *(u32x4*)(rowp + bj * HALF) = w; } }
        }
    }
};

struct EpiResidual {
    static constexpr bool PERM = false, AFTER_DRAIN = false;
    const float* hin; float* hout; float alpha;
    __device__ __forceinline__ void operator()(const f32x4 (&acc)[2][2][4][2], const Unit& u, int wr, int wc, int fr, int fq) const {
        const int row0 = u.pm * BM + wr * 64 + fr, col0 = u.pn * BM + wc * 32 + 4 * fq;
#pragma unroll
        for (int ai = 0; ai < 2; ++ai)
#pragma unroll
            for (int m = 0; m < 4; ++m) { const size_t off = (size_t)(row0 + ai * HALF + m * 16) * 1024 + col0;
#pragma unroll
                for (int bj = 0; bj < 2; ++bj)
#pragma unroll
                    for (int n = 0; n < 2; ++n) { const f32x4 hv = *(const f32x4*)(hin + off + bj * HALF + n * 16);
                        *(f32x4*)(hout + off + bj * HALF + n * 16) = hv * alpha + acc[ai][bj][m][n]; } }
    }
};

struct EpiMoeGU {
    static constexpr bool PERM = true, AFTER_DRAIN = false;
    bf16_t* HID;
    __device__ __forceinline__ void operator()(const f32x4 (&acc)[2][2][4][2], const Unit& u, int wr, int wc, int fr, int fq) const {
        const int row0 = u.pm * BM + wr * 64 + fr, col0 = u.pn * 128 + wc * 32 + 8 * fq;
#pragma unroll
        for (int ai = 0; ai < 2; ++ai)
#pragma unroll
            for (int m = 0; m < 4; ++m) {
                f32x4 h[2];
#pragma unroll
                for (int n = 0; n < 2; ++n) { const f32x4 g = acc[ai][0][m][n], up = acc[ai][1][m][n];
#pragma unroll
                    for (int j = 0; j < 4; ++j) h[n][j] = g[j] / (1.f + __expf(-g[j])) * up[j]; }
                u32x4 w; w.x = cvt_pk_bf16(h[0][0], h[0][1]); w.y = cvt_pk_bf16(h[0][2], h[0][3]); w.z = cvt_pk_bf16(h[1][0], h[1][1]); w.w = cvt_pk_bf16(h[1][2], h[1][3]);
                *(u32x4*)(HID + (size_t)(row0 + ai * HALF + m * 16) * 256 + col0) = w;
            }
    }
};

struct EpiMoeDown {
    static constexpr bool PERM = true, AFTER_DRAIN = false;
    bf16_t* Y; const float* rowgate;
    __device__ __forceinline__ void operator()(const f32x4 (&acc)[2][2][4][2], const Unit& u, int wr, int wc, int fr, int fq) const {
        const int row0 = u.pm * BM + wr * 64 + fr, col0 = u.pn * BM + wc * 32 + 8 * fq;
#pragma unroll
        for (int ai = 0; ai < 2; ++ai)
#pragma unroll
            for (int m = 0; m < 4; ++m) { const int row = row0 + ai * HALF + m * 16; const float gt = rowgate[row]; bf16_t* rowp = Y + (size_t)row * 1024 + col0;
#pragma unroll
                for (int bj = 0; bj < 2; ++bj) { const f32x4 v0 = acc[ai][bj][m][0] * gt, v1 = acc[ai][bj][m][1] * gt;
                    u32x4 w; w.x = cvt_pk_bf16(v0[0], v0[1]); w.y = cvt_pk_bf16(v0[2], v0[3]); w.z = cvt_pk_bf16(v1[0], v1[1]); w.w = cvt_pk_bf16(v1[2], v1[3]);
                    *(u32x4*)(rowp + bj * HALF) = w; } }
    }
};

struct MoeOrder {
    const PG8_LAS int* tile_e; int ntiles, ncol, bmul, G, c;
    __device__ __forceinline__ bool next(int i, Unit& u) const {
        const int L = i * G + c; if (L >= ntiles * ncol) return false;
        const int ti = L / ncol, j = L - ti * ncol;
        u.pm = ti; u.pn = j; u.pb = __builtin_amdgcn_readfirstlane(tile_e[ti] * bmul + j); return true;
    }
    __device__ __forceinline__ void a_ready(const Unit&) const {}
    __device__ __forceinline__ void done(const Unit&) const {}
};
}

struct Params {
    const float* in[24]; float* out; unsigned char* ws;
    double invA[8]; double invC[128];
};
typedef const __attribute__((address_space(4))) Params* ParamsK;
__device__ __forceinline__ ParamsK fresh_params() { ParamsK q = (ParamsK)__builtin_amdgcn_kernarg_segment_ptr(); asm volatile("" : "+s"(q)); return q; }
struct Ctx {
    int tid, lane, wave, G, bid;
    LAS unsigned char* lds;
};
__device__ __forceinline__ Ctx make_ctx(LAS unsigned char* lds) {
    Ctx c; int tid = threadIdx.x; asm volatile("" : "+v"(tid)); int bid = blockIdx.x; asm volatile("" : "+s"(bid)); int G = gridDim.x; asm volatile("" : "+s"(G));
    asm volatile("" : "+s"(lds));
    c.tid = tid; c.lane = tid & 63; c.wave = __builtin_amdgcn_readfirstlane(tid >> 6); c.G = G; c.bid = bid; c.lds = lds; return c;
}

__device__ __forceinline__ void transpose_item(const float* W, int ldw, int k0, int n0, bf16_t* WT, int K, size_t dstrow0, LAS float* scr, int lane) {
#pragma unroll 8
    for (int i = 0; i < 32; ++i) { const int kk = 2 * i + (lane >> 5); scr[kk * 33 + (lane & 31)] = W[(size_t)(k0 + kk) * ldw + n0 + (lane & 31)]; }
    asm volatile("s_waitcnt lgkmcnt(0)" ::: "memory");
    const int c = lane & 7;
#pragma unroll
    for (int j = 0; j < 4; ++j) { const int n = (lane >> 3) + 8 * j; const LAS float* s = scr + (8 * c) * 33 + n;
        u32x4 o; o.x = pk2(s[0 * 33], s[1 * 33]); o.y = pk2(s[2 * 33], s[3 * 33]); o.z = pk2(s[4 * 33], s[5 * 33]); o.w = pk2(s[6 * 33], s[7 * 33]);
        *(u32x4*)(WT + (dstrow0 + n) * K + k0 + 8 * c) = o; }
    asm volatile("s_waitcnt lgkmcnt(0)" ::: "memory");
}
__device__ __forceinline__ void transpose_matrix(const Ctx& c, const float* W, int K, int ldw, int ncols, bf16_t* WT) {
    LAS float* scr = (LAS float*)(c.lds + c.wave * 8704);
    const int gw = c.bid * 8 + c.wave, NGW = c.G * 8, nblk = ncols / 32, items = (K / 64) * nblk;
    for (int it = gw; it < items; it += NGW) { const int kb = it / nblk, nb = it - kb * nblk; transpose_item(W, ldw, 64 * kb, 32 * nb, WT, K, (size_t)(32 * nb), scr, c.lane); }
}
__device__ __forceinline__ void convert_experts(LAS unsigned char* lds_, int layer) {
    const Ctx c = make_ctx(lds_); layer = __builtin_amdgcn_readfirstlane(layer); asm volatile("" : "+s"(layer));
    LAS float* scr = (LAS float*)(c.lds + c.wave * 8704);
    const int gw = c.bid * 8 + c.wave, NGW = c.G * 8;
    ParamsK q = fresh_params(); const float* Wg = q->in[21] + (size_t)layer * 64 * 1024 * 256; const float* Wu = q->in[22] + (size_t)layer * 64 * 1024 * 256; const float* Wd = q->in[23] + (size_t)layer * 64 * 256 * 1024;
    unsigned char* ws = q->ws;
    bf16_t* GU = (bf16_t*)(ws + OFF_WE_GU); bf16_t* D = (bf16_t*)(ws + OFF_WE_D);
    for (int it = gw; it < 64 * 384; it += NGW) {
        const int e = it / 384, r = it - e * 384;
        if (r < 256) { const int isup = r >> 7, rr = r & 127, kb = rr >> 3, nb = rr & 7, n0 = 32 * nb;
            const float* W = (isup ? Wu : Wg) + (size_t)e * 1024 * 256;
            transpose_item(W, 256, 64 * kb, n0, GU, 1024, (size_t)e * 512 + (n0 >> 7) * 256 + isup * 128 + (n0 & 127), scr, c.lane);
        } else { const int rr = r - 256, kb = rr >> 5, nb = rr & 31;
            transpose_item(Wd + (size_t)e * 256 * 1024, 1024, 64 * kb, 32 * nb, D, 256, (size_t)e * 1024 + 32 * nb, scr, c.lane); }
    }
}
__device__ __forceinline__ void rope_entry(double w, int pos, float& co, float& si) {
    const double w2 = w * w; double cs = 1.0, sn = w, tc = 1.0, ts = w;
#pragma unroll
    for (int k = 1; k <= 11; ++k) { tc = -tc * w2 / (double)((2 * k - 1) * (2 * k)); ts = -ts * w2 / (double)((2 * k) * (2 * k + 1)); cs += tc; sn += ts; }
    double rc = 1.0, rs = 0.0, bc = cs, bs = sn; unsigned pp = (unsigned)pos;
#pragma unroll 1
    for (int b = 0; b < 20; ++b) { const bool on = ((pp >> b) & 1u) != 0u; const double t = rc * bc - rs * bs, u2 = rc * bs + rs * bc; rc = on ? t : rc; rs = on ? u2 : rs; const double t2 = bc * bc - bs * bs; bs = 2.0 * bc * bs; bc = t2; }
    co = (float)rc; si = (float)rs;
}
__device__ __forceinline__ void phase_prologue(LAS unsigned char* lds_) {
    const Ctx c = make_ctx(lds_);
    unsigned char* ws = fresh_params()->ws;
    transpose_matrix(c, fresh_params()->in[6], 1024, 3072, 3072, (bf16_t*)(ws + OFF_WA_IN));
    transpose_matrix(c, fresh_params()->in[6] + (size_t)1024 * 3072, 1024, 3072, 3072, (bf16_t*)(ws + OFF_WA_IN) + (size_t)3072 * 1024);
    transpose_matrix(c, fresh_params()->in[7], 1024, 1024, 1024, (bf16_t*)(ws + OFF_WA_OUT));
    transpose_matrix(c, fresh_params()->in[7] + (size_t)1024 * 1024, 1024, 1024, 1024, (bf16_t*)(ws + OFF_WA_OUT) + (size_t)1024 * 1024);
    transpose_matrix(c, fresh_params()->in[8], 1024, 3088, 3072, (bf16_t*)(ws + OFF_WB_IN));
    transpose_matrix(c, fresh_params()->in[13], 1024, 1024, 1024, (bf16_t*)(ws + OFF_WB_OUT));
    transpose_matrix(c, fresh_params()->in[14], 1024, 6144, 6144, (bf16_t*)(ws + OFF_WC_IN));
    transpose_matrix(c, fresh_params()->in[16], 2048, 1024, 1024, (bf16_t*)(ws + OFF_WC_OUT));
    const int gt = c.bid * 512 + c.tid, NT = c.G * 512;
    { bf16_t* WR = (bf16_t*)(ws + OFF_WR);
      for (int i = gt; i < 4 * 80 * 1024; i += NT) { const int layer = i / (80 * 1024), r = i - layer * 80 * 1024, n = r >> 10, k = r & 1023;
          float w = 0.f; if (n < 8) w = fresh_params()->in[17][((size_t)layer * 1024 + k) * 8 + n]; else if (n < 72) w = fresh_params()->in[19][((size_t)layer * 1024 + k) * 64 + (n - 8)];
          const unsigned hi = f2bf(w); const float lo = w - __builtin_bit_cast(float, hi << 16);
          WR[((size_t)layer * 2 + 0) * 80 * 1024 + r] = (bf16_t)hi; WR[((size_t)layer * 2 + 1) * 80 * 1024 + r] = (bf16_t)f2bf(lo); } }
    { float* WG = (float*)(ws + OFF_WG); for (int i = gt; i < 16 * 1024; i += NT) { const int o = i >> 10, k = i & 1023; WG[i] = fresh_params()->in[8][(size_t)k * 3088 + 3072 + o]; } }
    { float* par = (float*)(ws + OFF_PAR);
      for (int i = gt; i < PAR_END; i += NT) { float v;
          if (i < PAR_LN1B) v = fresh_params()->in[2][i]; else if (i < PAR_LN2G) v = fresh_params()->in[3][i - PAR_LN1B]; else if (i < PAR_LN2B) v = fresh_params()->in[4][i - PAR_LN2G]; else if (i < PAR_GBIAS) v = fresh_params()->in[5][i - PAR_LN2B];
          else if (i < PAR_CONVW) v = fresh_params()->in[9][i - PAR_GBIAS]; else if (i < PAR_CONVB) v = fresh_params()->in[10][i - PAR_CONVW]; else if (i < PAR_BNG) v = fresh_params()->in[11][i - PAR_CONVB]; else if (i < PAR_CNG) v = fresh_params()->in[12][i - PAR_BNG];
          else if (i < PAR_RGB) v = fresh_params()->in[15][i - PAR_CNG]; else if (i < PAR_REB) v = fresh_params()->in[18][i - PAR_RGB]; else v = fresh_params()->in[20][i - PAR_REB];
          par[i] = v; } }
    { const int* pos = (const int*)fresh_params()->in[1]; float* cA = (float*)(ws + OFF_COSA); float* sA = (float*)(ws + OFF_SINA); float* cC = (float*)(ws + OFF_COSC); float* sC = (float*)(ws + OFF_SINC);
      for (int i = gt; i < SEQ * 136; i += NT) { const int s = i / 136, f = i - s * 136; float co, si;
          if (f < 8) { rope_entry(fresh_params()->invA[f], pos[s], co, si); cA[s * 8 + f] = co; sA[s * 8 + f] = si; }
          else { rope_entry(fresh_params()->invC[f - 8], pos[s], co, si); cC[s * 128 + f - 8] = co; sC[s * 128 + f - 8] = si; } } }
    { const f32x4* x4 = (const f32x4*)fresh_params()->in[0]; u32x2* hb = (u32x2*)(ws + OFF_HB);
      for (size_t i = gt; i < (size_t)NTOK * DM / 4; i += NT) { const f32x4 v = x4[i]; u32x2 w; w.x = pk2(v[0], v[1]); w.y = pk2(v[2], v[3]); hb[i] = w; } }
}

__device__ __forceinline__ void ln_apply(f32x4 (&v)[4], const f32x4 (&g)[4], const f32x4 (&b)[4]) {
    float s = 0.f;
#pragma unroll
    for (int j = 0; j < 4; ++j) s += (v[j][0] + v[j][1]) + (v[j][2] + v[j][3]);
    const float mean = wave_sum(s) * (1.f / DM); float s2 = 0.f;
#pragma unroll
    for (int j = 0; j < 4; ++j) { v[j] = v[j] - mean; s2 += (v[j][0] * v[j][0] + v[j][1] * v[j][1]) + (v[j][2] * v[j][2] + v[j][3] * v[j][3]); }
    const float rstd = 1.f / sqrtf(wave_sum(s2) * (1.f / DM) + LN_EPS);
#pragma unroll
    for (int j = 0; j < 4; ++j) v[j] = v[j] * rstd * g[j] + b[j];
}

__device__ __forceinline__ void phase_ln1_router(LAS unsigned char* lds_, int layer, bool mixed, bool do_router) {
    const Ctx c = make_ctx(lds_); layer = __builtin_amdgcn_readfirstlane(layer); asm volatile("" : "+s"(layer));
    unsigned char* ws = fresh_params()->ws;
    float* H = (float*)(ws + OFF_H); bf16_t* HB = (bf16_t*)(ws + OFF_HB);
    const float* src = mixed ? H : (layer == 0 ? fresh_params()->in[0] : H); const float scale = mixed ? 1.0f : DN_ALPHA;
    const float* par = (const float*)(ws + OFF_PAR); const float* lg = par + PAR_LN1G + layer * DM; const float* lb = par + PAR_LN1B + layer * DM;
    f32x4 g[4], b[4];
#pragma unroll
    for (int j = 0; j < 4; ++j) { g[j] = *(const f32x4*)(lg + 4 * c.lane + 256 * j); b[j] = *(const f32x4*)(lb + 4 * c.lane + 256 * j); }
    LAS int* hist = (LAS int*)(c.lds);
    LAS float* lgt = (LAS float*)(c.lds + 1024) + c.wave * (16 * 80);
    const bf16_t* WRh = (const bf16_t*)(ws + OFF_WR) + (size_t)(layer * 2 + 0) * 80 * 1024; const bf16_t* WRl = WRh + 80 * 1024;
    const int fr = c.lane & 15, fq = c.lane >> 4;
    for (int rb = c.bid; rb < NTOK / 128; rb += c.G) {
        const int row0 = rb * 128 + c.wave * 16;
        if (c.tid < 64) hist[c.tid] = 0;
        for (int r = 0; r < 16; ++r) {
            const size_t ro = (size_t)(row0 + r) * DM + 4 * c.lane; f32x4 v[4];
#pragma unroll
            for (int j = 0; j < 4; ++j) v[j] = *(const f32x4*)(src + ro + 256 * j) * scale;
            ln_apply(v, g, b);
#pragma unroll
            for (int j = 0; j < 4; ++j) { *(f32x4*)(H + ro + 256 * j) = v[j]; u32x2 w; w.x = pk2(v[j][0], v[j][1]); w.y = pk2(v[j][2], v[j][3]); *(u32x2*)(HB + ro + 256 * j) = w; }
        }
        __syncthreads();
        if (do_router) {
            f32x4 acc[5];
#pragma unroll
            for (int t = 0; t < 5; ++t) acc[t] = (f32x4){0.f, 0.f, 0.f, 0.f};
            const float* arow = H + (size_t)(row0 + fr) * DM + fq * 8;
            for (int ks = 0; ks < 32; ++ks) {
                const f32x4 a0 = *(const f32x4*)(arow + ks * 32), a1 = *(const f32x4*)(arow + ks * 32 + 4);
                bf16x8 ah, al;
#pragma unroll
                for (int j = 0; j < 4; ++j) { const unsigned h0 = f2bf(a0[j]), h1 = f2bf(a1[j]); ah[j] = (short)h0; ah[4 + j] = (short)h1;
                    al[j] = (short)f2bf(a0[j] - __builtin_bit_cast(float, h0 << 16)); al[4 + j] = (short)f2bf(a1[j] - __builtin_bit_cast(float, h1 << 16)); }
#pragma unroll
                for (int t = 0; t < 5; ++t) {
                    const bf16x8 bh = *(const bf16x8*)(WRh + (size_t)(t * 16 + fr) * 1024 + ks * 32 + fq * 8);
                    const bf16x8 bl = *(const bf16x8*)(WRl + (size_t)(t * 16 + fr) * 1024 + ks * 32 + fq * 8);
                    acc[t] = __builtin_amdgcn_mfma_f32_16x16x32_bf16(ah, bh, acc[t], 0, 0, 0);
                    acc[t] = __builtin_amdgcn_mfma_f32_16x16x32_bf16(al, bh, acc[t], 0, 0, 0);
                    acc[t] = __builtin_amdgcn_mfma_f32_16x16x32_bf16(ah, bl, acc[t], 0, 0, 0);
                }
            }
#pragma unroll
            for (int t = 0; t < 5; ++t) { const int n = t * 16 + fr; float bias = 0.f; if (n < 8) bias = par[PAR_RGB + layer * 8 + n]; else if (n < 72) bias = par[PAR_REB + layer * 64 + n - 8];
#pragma unroll
                for (int r = 0; r < 4; ++r) lgt[(4 * fq + r) * 80 + n] = acc[t][r] + bias; }
            __syncthreads();
            if (c.lane < 16) {
                const LAS float* L = lgt + c.lane * 80; const int tok = row0 + c.lane;
                int grp = 0; float gm = L[0];
#pragma unroll
                for (int i = 1; i < 8; ++i) { const float x = L[i]; if (x > gm) { gm = x; grp = i; } }
                float se = 0.f;
#pragma unroll
                for (int i = 0; i < 8; ++i) se += __expf(L[i] - gm);
                const float pg = 1.f / se;
                const LAS float* E = L + 8 + grp * 8;
                int i0 = 0; float v0 = E[0];
#pragma unroll
                for (int i = 1; i < 8; ++i) { const float x = E[i]; if (x > v0) { v0 = x; i0 = i; } }
                int i1 = -1; float v1 = -3.0e38f;
#pragma unroll
                for (int i = 0; i < 8; ++i) { const float x = E[i]; if (i != i0 && x > v1) { v1 = x; i1 = i; } }
                const float ex = __expf(v1 - v0), g0 = pg / (1.f + ex), g1 = pg * ex / (1.f + ex);
                const int e0 = grp * 8 + i0, e1 = grp * 8 + i1;
                int* EID = (int*)(ws + OFF_EID); float* GT = (float*)(ws + OFF_GATE);
                EID[tok * 2] = e0; EID[tok * 2 + 1] = e1; GT[tok * 2] = g0; GT[tok * 2 + 1] = g1;
                __hip_atomic_fetch_add(hist + e0, 1, __ATOMIC_RELAXED, __HIP_MEMORY_SCOPE_WORKGROUP);
                __hip_atomic_fetch_add(hist + e1, 1, __ATOMIC_RELAXED, __HIP_MEMORY_SCOPE_WORKGROUP);
            }
            __syncthreads();
            if (c.tid < 64) ((int*)(ws + OFF_CTL))[rb * 64 + c.tid] = hist[c.tid];
        }
        __syncthreads();
    }
}

__device__ __forceinline__ void phase_ln2(LAS unsigned char* lds_, int layer, bool last, bool with_moe, bool do_gates) {
    const Ctx c = make_ctx(lds_); layer = __builtin_amdgcn_readfirstlane(layer); asm volatile("" : "+s"(layer));
    unsigned char* ws = fresh_params()->ws;
    float* dst = last ? fresh_params()->out : (float*)(ws + OFF_H);
    const float* H = (const float*)(ws + OFF_H); bf16_t* HB = (bf16_t*)(ws + OFF_HB);
    const float* par = (const float*)(ws + OFF_PAR); const float* lg = par + PAR_LN2G + layer * DM; const float* lb = par + PAR_LN2B + layer * DM;
    f32x4 g[4], b[4];
#pragma unroll
    for (int j = 0; j < 4; ++j) { g[j] = *(const f32x4*)(lg + 4 * c.lane + 256 * j); b[j] = *(const f32x4*)(lb + 4 * c.lane + 256 * j); }
    const int* SLOT = (const int*)(ws + OFF_SLOT); const bf16_t* Y = (const bf16_t*)(ws + OFF_R + RM_YEXP);
    LAS float* wg = (LAS float*)c.lds;
    if (do_gates) { const float* WG = (const float*)(ws + OFF_WG); for (int i = c.tid; i < 16 * 1024 / 4; i += 512) ((LAS f32x4*)wg)[i] = ((const f32x4*)WG)[i]; __syncthreads(); }
    float* GATES = (float*)(ws + OFF_GATES);
    for (int row = c.bid * 8 + c.wave; row < NTOK; row += c.G * 8) {
        const size_t ro = (size_t)row * DM + 4 * c.lane; f32x4 v[4];
#pragma unroll
        for (int j = 0; j < 4; ++j) v[j] = *(const f32x4*)(H + ro + 256 * j) * DN_ALPHA;
        if (with_moe) {
            const int s0 = SLOT[row * 2], s1 = SLOT[row * 2 + 1];
            const bf16_t* y0 = Y + (size_t)s0 * DM + 4 * c.lane; const bf16_t* y1 = Y + (size_t)s1 * DM + 4 * c.lane;
#pragma unroll
            for (int j = 0; j < 4; ++j) { const u32x2 a = *(const u32x2*)(y0 + 256 * j), bb = *(const u32x2*)(y1 + 256 * j);
                v[j][0] += bflo(a.x) + bflo(bb.x); v[j][1] += bfhi(a.x) + bfhi(bb.x); v[j][2] += bflo(a.y) + bflo(bb.y); v[j][3] += bfhi(a.y) + bfhi(bb.y); }
        }
        ln_apply(v, g, b);
#pragma unroll
        for (int j = 0; j < 4; ++j) { *(f32x4*)(dst + ro + 256 * j) = v[j]; u32x2 w; w.x = pk2(v[j][0], v[j][1]); w.y = pk2(v[j][2], v[j][3]); *(u32x2*)(HB + ro + 256 * j) = w; }
        if (do_gates) {
            float mine = 0.f;
#pragma unroll
            for (int o = 0; o < 16; ++o) { float s = 0.f;
#pragma unroll
                for (int j = 0; j < 4; ++j) { const f32x4 w = *(const LAS f32x4*)(wg + o * 1024 + 4 * c.lane + 256 * j); s += (v[j][0] * w[0] + v[j][1] * w[1]) + (v[j][2] * w[2] + v[j][3] * w[3]); }
                s = wave_sum(s); if (c.lane == o) mine = s; }
            if (c.lane < 16) GATES[(size_t)row * 16 + c.lane] = mine + par[PAR_GBIAS + c.lane];
        }
    }
}

__device__ __forceinline__ void phase_moe_scan(LAS unsigned char* lds_) {
    const Ctx c = make_ctx(lds_);
    unsigned char* ws = fresh_params()->ws;
    const int* CNT = (const int*)(ws + OFF_CTL); const int* EID = (const int*)(ws + OFF_EID); const float* GT = (const float*)(ws + OFF_GATE);
    int* SLOT = (int*)(ws + OFF_SLOT); float* RG = (float*)(ws + OFF_ROWGATE);
    const bf16_t* HB = (const bf16_t*)(ws + OFF_HB); bf16_t* XB = (bf16_t*)(ws + OFF_R + RM_XB);
    LAS int* part = (LAS int*)c.lds;
    LAS int* tot = part + 1024;
    LAS int* bef = tot + 64;
    LAS int* pst = bef + 64;
    LAS int* eids = pst + 64;
    LAS int* dst = eids + 256;
    LAS int* misc = (LAS int*)(c.lds + LDS_MISC);
    { const int e = c.tid & 63, pt = c.tid >> 6; int sa = 0;
      for (int bb = pt * 32; bb < pt * 32 + 32; ++bb) sa += CNT[bb * 64 + e];
      part[pt * 64 + e] = sa; }
    __syncthreads();
    if (c.tid < 64) { int sa = 0;
#pragma unroll
        for (int pt = 0; pt < 8; ++pt) sa += part[pt * 64 + c.tid];
        tot[c.tid] = sa; }
    __syncthreads();
    if (c.tid == 0) { int pos = 0, nt = 0;
        for (int e = 0; e < 64; ++e) { pst[e] = pos; const int n = (tot[e] + 255) >> 8; for (int k = 0; k < n; ++k) misc[1 + nt++] = e; pos += n * 256; }
        misc[0] = nt; }
    __syncthreads();
    for (int rb = c.bid; rb < NTOK / 128; rb += c.G) {
        { const int e = c.tid & 63, pt = c.tid >> 6; int sb = 0;
          for (int bb = pt * 32; bb < pt * 32 + 32; ++bb) { const int v = CNT[bb * 64 + e]; if (bb < rb) sb += v; }
          part[512 + pt * 64 + e] = sb; }
        __syncthreads();
        if (c.tid < 64) { int sb = 0;
#pragma unroll
            for (int pt = 0; pt < 8; ++pt) sb += part[512 + pt * 64 + c.tid];
            bef[c.tid] = sb; }
        if (c.tid < 256) eids[c.tid] = EID[(rb * 128) * 2 + c.tid];
        __syncthreads();
        if (c.tid < 256) { const int e = eids[c.tid]; int rank = 0; for (int a = 0; a < c.tid; ++a) rank += (eids[a] == e) ? 1 : 0;
            const int d = pst[e] + bef[e] + rank; dst[c.tid] = d; SLOT[(rb * 128) * 2 + c.tid] = d; RG[d] = GT[(rb * 128) * 2 + c.tid]; }
        __syncthreads();
        for (int idx = c.tid; idx < 256 * 128; idx += 512) { const int a = idx >> 7, ch = idx & 127; const int tok = rb * 128 + (a >> 1);
            *(u32x4*)(XB + (size_t)dst[a] * DM + ch * 8) = *(const u32x4*)(HB + (size_t)tok * DM + ch * 8); }
        __syncthreads();
    }
}

__device__ __forceinline__ void phase_attn(LAS unsigned char* lds_) {
    const Ctx c = make_ctx(lds_);
    unsigned char* ws = fresh_params()->ws;
    const bf16_t* Qg = (const bf16_t*)(ws + OFF_R + RA_Q); const bf16_t* Kg = (const bf16_t*)(ws + OFF_R + RA_K); const bf16_t* Vg = (const bf16_t*)(ws + OFF_R + RA_V);
    bf16_t* OG = (bf16_t*)(ws + OFF_R + RA_OG); float* LSE = (float*)(ws + OFF_R + RA_LSE);
    LAS bf16_t* Ks = (LAS bf16_t*)c.lds; LAS bf16_t* Vs = Ks + 384 * 72;
    const int fr = c.lane & 15, fq = c.lane >> 4;
    for (int u = c.bid; u < NBATCH * 16 * 48; u += c.G) {
        const int bh = u / 48, sub = u - bh * 48, b = bh >> 4, h = bh & 15, g = sub >> 4, idx = sub & 15;
        const int dsh = 2 * g, d = 1 << dsh, nqb = 16 >> dsh, r = idx / nqb, qb = idx - r * nqb;
        const int lq0 = qb * 256, lk0 = lq0 - 128;
        const size_t tokbase = (size_t)b * SEQ;
        __syncthreads();
        for (int i = c.tid; i < 384 * 8; i += 512) { const int ri = i >> 3, ch = i & 7, l = lk0 + ri;
            if (l >= 0) { const size_t ga = (tokbase + (size_t)l * d + r) * DM + h * 64 + ch * 8;
                *(LAS u32x4*)(Ks + ri * 72 + ch * 8) = *(const u32x4*)(Kg + ga); *(LAS u32x4*)(Vs + ri * 72 + ch * 8) = *(const u32x4*)(Vg + ga); } }
        __syncthreads();
#pragma unroll 1
        for (int grp = 0; grp < 2; ++grp) {
            const int l0 = lq0 + c.wave * 32 + grp * 16;
            const size_t qtok = tokbase + (size_t)(l0 + fr) * d + r;
            const bf16x8 q0 = *(const bf16x8*)(Qg + qtok * DM + h * 64 + fq * 8), q1 = *(const bf16x8*)(Qg + qtok * DM + h * 64 + 32 + fq * 8);
            const int rb0 = l0 - 128 - lk0;
            const int jmin = (l0 - 128 < 0) ? ((128 - l0) >> 4) : 0;
            f32x4 s[9]; float mx = -3.0e38f;
#pragma unroll
            for (int jb = 0; jb < 9; ++jb) {
                if (jb >= jmin) {
                    const LAS bf16_t* kr = Ks + (rb0 + jb * 16 + fr) * 72 + fq * 8;
                    const bf16x8 k0 = *(const LAS bf16x8*)kr, k1 = *(const LAS bf16x8*)(kr + 32);
                    f32x4 a = {0.f, 0.f, 0.f, 0.f};
                    a = __builtin_amdgcn_mfma_f32_16x16x32_bf16(k0, q0, a, 0, 0, 0);
                    a = __builtin_amdgcn_mfma_f32_16x16x32_bf16(k1, q1, a, 0, 0, 0);
#pragma unroll
                    for (int rg = 0; rg < 4; ++rg) { const int rel = 128 + fr - (16 * jb + 4 * fq + rg); if (rel < 0 || rel > 128) a[rg] = -3.0e38f; mx = fmaxf(mx, a[rg]); }
                    s[jb] = a;
                } else s[jb] = (f32x4){-3.0e38f, -3.0e38f, -3.0e38f, -3.0e38f};
            }
            mx = fmaxf(mx, __shfl_xor(mx, 16)); mx = fmaxf(mx, __shfl_xor(mx, 32));
            float lsum = 0.f;
#pragma unroll
            for (int jb = 0; jb < 9; ++jb)
#pragma unroll
                for (int rg = 0; rg < 4; ++rg) { const float e = __expf(s[jb][rg] - mx); s[jb][rg] = e; lsum += e; }
            lsum += __shfl_xor(lsum, 16); lsum += __shfl_xor(lsum, 32);
            f32x4 o[4];
#pragma unroll
            for (int db = 0; db < 4; ++db) o[db] = (f32x4){0.f, 0.f, 0.f, 0.f};
            const int tq = (c.lane & 15) >> 2, tp = c.lane & 3;
#pragma unroll
            for (int i = 0; i < 5; ++i) {
                const int jA = 2 * i, jB = 2 * i + 1;
                bf16x8 pf;
                { const unsigned w0 = pk2(s[jA][0], s[jA][1]), w1 = pk2(s[jA][2], s[jA][3]); unsigned w2 = 0u, w3 = 0u;
                  if (jB < 9) { w2 = pk2(s[jB][0], s[jB][1]); w3 = pk2(s[jB][2], s[jB][3]); }
                  pf[0] = (short)(w0 & 0xffff); pf[1] = (short)(w0 >> 16); pf[2] = (short)(w1 & 0xffff); pf[3] = (short)(w1 >> 16);
                  pf[4] = (short)(w2 & 0xffff); pf[5] = (short)(w2 >> 16); pf[6] = (short)(w3 & 0xffff); pf[7] = (short)(w3 >> 16); }
                const int ja = (jA >= jmin) ? jA : 8, jbb = (jB < 9 && jB >= jmin) ? jB : 8;
                const LAS bf16_t* va = Vs + (rb0 + ja * 16 + 4 * fq + tq) * 72 + tp * 4;
                const LAS bf16_t* vb = Vs + (rb0 + jbb * 16 + 4 * fq + tq) * 72 + tp * 4;
#pragma unroll
                for (int db = 0; db < 4; ++db) {
                    const s16x4 x = __builtin_amdgcn_ds_read_tr16_b64_v4i16((LAS s16x4*)(va + db * 16));
                    const s16x4 y = __builtin_amdgcn_ds_read_tr16_b64_v4i16((LAS s16x4*)(vb + db * 16));
                    bf16x8 vf; vf[0] = x[0]; vf[1] = x[1]; vf[2] = x[2]; vf[3] = x[3]; vf[4] = y[0]; vf[5] = y[1]; vf[6] = y[2]; vf[7] = y[3];
                    o[db] = __builtin_amdgcn_mfma_f32_16x16x32_bf16(vf, pf, o[db], 0, 0, 0);
                }
            }
            const float inv = 1.f / lsum;
            bf16_t* op = OG + (size_t)g * NTOK * DM + qtok * DM + h * 64 + 4 * fq;
#pragma unroll
            for (int db = 0; db < 4; ++db) { u32x2 w; w.x = pk2(o[db][0] * inv, o[db][1] * inv); w.y = pk2(o[db][2] * inv, o[db][3] * inv); *(u32x2*)(op + db * 16) = w; }
            if (fq == 0) LSE[(size_t)g * NTOK * 16 + qtok * 16 + h] = mx + __logf(lsum);
        }
    }
}
__device__ __forceinline__ void phase_attn_combine(LAS unsigned char* lds_) {
    const Ctx c = make_ctx(lds_);
    unsigned char* ws = fresh_params()->ws;
    const bf16_t* OG = (const bf16_t*)(ws + OFF_R + RA_OG); const float* LSE = (const float*)(ws + OFF_R + RA_LSE); bf16_t* O = (bf16_t*)(ws + OFF_R + RA_Q);
    for (int row = c.bid * 8 + c.wave; row < NTOK; row += c.G * 8) {
        const int h = c.lane >> 2;
        const float l0 = LSE[(size_t)row * 16 + h], l1 = LSE[(size_t)NTOK * 16 + (size_t)row * 16 + h], l2 = LSE[(size_t)2 * NTOK * 16 + (size_t)row * 16 + h];
        const float m = fmaxf(l0, fmaxf(l1, l2)); float w0 = __expf(l0 - m), w1 = __expf(l1 - m), w2 = __expf(l2 - m); const float iv = 1.f / (w0 + w1 + w2); w0 *= iv; w1 *= iv; w2 *= iv;
        const size_t off = (size_t)row * DM + c.lane * 16;
#pragma unroll
        for (int hf = 0; hf < 2; ++hf) {
            const u32x4 a = *(const u32x4*)(OG + off + hf * 8), bq = *(const u32x4*)(OG + (size_t)NTOK * DM + off + hf * 8), cq = *(const u32x4*)(OG + (size_t)2 * NTOK * DM + off + hf * 8);
            u32x4 o;
#pragma unroll
            for (int k = 0; k < 4; ++k) { const float lo = w0 * bflo(a[k]) + w1 * bflo(bq[k]) + w2 * bflo(cq[k]), hi = w0 * bfhi(a[k]) + w1 * bfhi(bq[k]) + w2 * bfhi(cq[k]); o[k] = pk2(lo, hi); }
            *(u32x4*)(O + off + hf * 8) = o;
        }
    }
}

template <int DK, int DVS, bool ML> struct ScanLds {
    static constexpr int QS = 0, QROW = DK + 8;
    static constexpr int KS = QS + 64 * QROW * 2;
    static constexpr int KZT = KS + 64 * QROW * 2;
    static constexpr int VT = KZT + DK * 72 * 2;
    static constexpr int PS = VT + DVS * 72 * 2;
    static constexpr int RBT = PS + 64 * 72 * 2;
    static constexpr int SC = RBT + DVS * QROW * 2;
    static constexpr int OS = ML ? SC + 2048 : KS;
    static constexpr int END = ML ? OS + 64 * DVS * 4 : SC + 2048;
};
template <int DK, int DVS, bool ML>
__device__ __forceinline__ void phase_scan(LAS unsigned char* lds_) {
    const Ctx c = make_ctx(lds_);
    typedef ScanLds<DK, DVS, ML> L; static_assert(L::END <= LDS_BYTES, "scan LDS");
    constexpr int QROW = L::QROW, NCJ = DVS / 16, NRI = DK / 16, DVR = ML ? 32 : 64, NSL = ML ? 4 : 8, NH = ML ? 8 : 4;
    unsigned char* ws = fresh_params()->ws;
    LAS bf16_t* Qs = (LAS bf16_t*)(c.lds + L::QS); LAS bf16_t* Ksh = (LAS bf16_t*)(c.lds + L::KS); LAS bf16_t* Kzt = (LAS bf16_t*)(c.lds + L::KZT);
    LAS bf16_t* Vt = (LAS bf16_t*)(c.lds + L::VT); LAS bf16_t* Ps = (LAS bf16_t*)(c.lds + L::PS); LAS bf16_t* Rbt = (LAS bf16_t*)(c.lds + L::RBT);
    LAS float* sc = (LAS float*)(c.lds + L::SC); LAS float* Os = (LAS float*)(c.lds + L::OS);
    LAS float* cu = sc, *rb = sc + 64, *xi = sc + 128, *zeta = sc + 192, *em = sc + 256, *chi = sc + 320;
    const int fr = c.lane & 15, fq = c.lane >> 4, w = c.wave;
    for (int u = c.bid; u < NBATCH * NH * NSL; u += c.G) {
        const int b = u / (NH * NSL), h = (u / NSL) % NH, sl = u % NSL;
        __syncthreads();
        for (int i = c.tid; i < DVS * QROW / 2; i += 512) ((LAS unsigned*)Rbt)[i] = 0u;
        if (ML) { for (int i = c.tid; i < 16 * 72; i += 512) { const int rr = i / 72; Vt[(32 + rr) * 72 + (i - rr * 72)] = (rr == 0) ? (bf16_t)0x3F80 : (bf16_t)0; } }
        else if (c.tid < 64) { const float lgm = __logf(1.f - exp2f(-5.f - (float)h)); const int s = c.tid;
            cu[s] = -(float)s * lgm; rb[s] = -(float)s * lgm; xi[s] = __expf((float)(s + 1) * lgm); zeta[s] = __expf((float)(63 - s) * lgm); if (s == 0) chi[0] = __expf(64.f * lgm); }
        __syncthreads();
        f32x4 accR[(NRI >= 8 ? NRI / 8 : 1)][NCJ];
#pragma unroll
        for (int a = 0; a < (NRI >= 8 ? NRI / 8 : 1); ++a)
#pragma unroll
            for (int q = 0; q < NCJ; ++q) accR[a][q] = (f32x4){0.f, 0.f, 0.f, 0.f};
        float mprev = 0.f;
        for (int ch = 0; ch < 64; ++ch) {
            const size_t tok0 = (size_t)b * SEQ + (size_t)ch * 64;
            if (ML) {
                if (w == 0) {
                    const float* G = (const float*)(ws + OFF_GATES) + (tok0 + c.lane) * 16;
                    const float ig = G[h], fg = G[8 + h];
                    const float lf = fminf(fg, 0.f) - log1pf(__expf(-fabsf(fg)));
                    float a = lf;
#pragma unroll
                    for (int o = 1; o < 64; o <<= 1) { const float t = __shfl_up(a, o); if (c.lane >= o) a += t; }
                    const float uu = ig - a; float bm = uu;
#pragma unroll
                    for (int o = 1; o < 64; o <<= 1) { const float t = __shfl_up(bm, o); if (c.lane >= o) bm = fmaxf(bm, t); }
                    const float bt = fmaxf(mprev, bm), b63 = __shfl(bt, 63), a63 = __shfl(a, 63);
                    cu[c.lane] = uu; rb[c.lane] = bt; xi[c.lane] = __expf(mprev - bt); zeta[c.lane] = __expf(uu - b63); em[c.lane] = __expf(-(a + bt));
                    if (c.lane == 0) chi[0] = __expf(mprev - b63);
                    mprev = a63 + b63;
                }
                __syncthreads();
            }
            if (ML) {
                const bf16_t* PR = (const bf16_t*)(ws + OFF_R + RB_PROJ);
                const float* cw = (const float*)(ws + OFF_PAR) + PAR_CONVW; const float* cb = (const float*)(ws + OFF_PAR) + PAR_CONVB;
                for (int i = c.tid; i < 2 * 64 * 8; i += 512) {
                    const int isk = i >> 9, row = (i >> 3) & 63, cc = i & 7, ch0 = isk * 512 + h * 64 + cc * 8, spos = ch * 64 + row;
                    float y[8];
#pragma unroll
                    for (int e = 0; e < 8; ++e) y[e] = cb[ch0 + e];
#pragma unroll
                    for (int j = 0; j < 4; ++j) { if (spos - 3 + j >= 0) { const u32x4 x = *(const u32x4*)(PR + (tok0 + row - 3 + j) * 3072 + ch0);
                        const f32x4 w0 = *(const f32x4*)(cw + j * 1024 + ch0), w1 = *(const f32x4*)(cw + j * 1024 + ch0 + 4);
                        y[0] += w0[0] * bflo(x[0]); y[1] += w0[1] * bfhi(x[0]); y[2] += w0[2] * bflo(x[1]); y[3] += w0[3] * bfhi(x[1]);
                        y[4] += w1[0] * bflo(x[2]); y[5] += w1[1] * bfhi(x[2]); y[6] += w1[2] * bflo(x[3]); y[7] += w1[3] * bfhi(x[3]); } }
                    const float ksc = isk ? 0.125f : 1.f;
#pragma unroll
                    for (int e = 0; e < 8; ++e) y[e] = silu_f(y[e]) * ksc;
                    u32x4 o; o[0] = pk2(y[0], y[1]); o[1] = pk2(y[2], y[3]); o[2] = pk2(y[4], y[5]); o[3] = pk2(y[6], y[7]);
                    if (!isk) *(LAS u32x4*)(Qs + row * QROW + cc * 8) = o;
                    else { *(LAS u32x4*)(Ksh + row * QROW + cc * 8) = o; const float z = zeta[row];
#pragma unroll
                        for (int e = 0; e < 8; ++e) Kzt[(cc * 8 + e) * 72 + row] = (bf16_t)f2bf(y[e] * z); }
                }
                for (int i = c.tid; i < 64 * 4; i += 512) { const int row = i >> 2, cc = i & 3;
                    const u32x4 x = *(const u32x4*)(PR + (tok0 + row) * 3072 + 1024 + h * 128 + sl * 32 + cc * 8);
#pragma unroll
                    for (int e = 0; e < 4; ++e) { Vt[(cc * 8 + 2 * e) * 72 + row] = (bf16_t)(x[e] & 0xffff); Vt[(cc * 8 + 2 * e + 1) * 72 + row] = (bf16_t)(x[e] >> 16); } }
            } else {
                const bf16_t* Qg = (const bf16_t*)(ws + OFF_R + RC_Q); const bf16_t* Kg = (const bf16_t*)(ws + OFF_R + RC_K); const bf16_t* Vg = (const bf16_t*)(ws + OFF_R + RC_V);
                for (int i = c.tid; i < 64 * (DK / 8); i += 512) { const int row = i / (DK / 8), cc = i - row * (DK / 8);
                    *(LAS u32x4*)(Qs + row * QROW + cc * 8) = *(const u32x4*)(Qg + (tok0 + row) * DM + h * DK + cc * 8);
                    const u32x4 x = *(const u32x4*)(Kg + (tok0 + row) * DM + h * DK + cc * 8);
                    *(LAS u32x4*)(Ksh + row * QROW + cc * 8) = x; const float z = zeta[row];
#pragma unroll
                    for (int e = 0; e < 4; ++e) { Kzt[(cc * 8 + 2 * e) * 72 + row] = (bf16_t)f2bf(bflo(x[e]) * z); Kzt[(cc * 8 + 2 * e + 1) * 72 + row] = (bf16_t)f2bf(bfhi(x[e]) * z); } }
                for (int i = c.tid; i < 64 * 8; i += 512) { const int row = i >> 3, cc = i & 7;
                    const u32x4 x = *(const u32x4*)(Vg + (tok0 + row) * 2048 + h * 512 + sl * 64 + cc * 8);
#pragma unroll
                    for (int e = 0; e < 4; ++e) { Vt[(cc * 8 + 2 * e) * 72 + row] = (bf16_t)(x[e] & 0xffff); Vt[(cc * 8 + 2 * e + 1) * 72 + row] = (bf16_t)(x[e] >> 16); } }
            }
            __syncthreads();
            { const int ti = w >> 1, tj0 = (w & 1) * 2;
              f32x4 a0 = {0.f, 0.f, 0.f, 0.f}, a1 = {0.f, 0.f, 0.f, 0.f};
              if (tj0 <= ti) {
#pragma unroll
                  for (int ks = 0; ks < DK / 32; ++ks) { const bf16x8 qa = *(const LAS bf16x8*)(Qs + (16 * ti + fr) * QROW + ks * 32 + fq * 8);
                      const bf16x8 k0 = *(const LAS bf16x8*)(Ksh + (16 * tj0 + fr) * QROW + ks * 32 + fq * 8), k1 = *(const LAS bf16x8*)(Ksh + (16 * tj0 + 16 + fr) * QROW + ks * 32 + fq * 8);
                      a0 = __builtin_amdgcn_mfma_f32_16x16x32_bf16(qa, k0, a0, 0, 0, 0); a1 = __builtin_amdgcn_mfma_f32_16x16x32_bf16(qa, k1, a1, 0, 0, 0); } }
              const float cu0 = cu[16 * tj0 + fr], cu1 = cu[16 * tj0 + 16 + fr];
#pragma unroll
              for (int rg = 0; rg < 4; ++rg) { const int t = 16 * ti + 4 * fq + rg, s0 = 16 * tj0 + fr, s1 = s0 + 16; const float rt = rb[t];
                  Ps[t * 72 + s0] = (bf16_t)f2bf(s0 <= t ? a0[rg] * __expf(cu0 - rt) : 0.f);
                  Ps[t * 72 + s1] = (bf16_t)f2bf(s1 <= t ? a1[rg] * __expf(cu1 - rt) : 0.f); } }
            __syncthreads();
            { const int ti = w >> 1, c0 = (w & 1) ? (NCJ + 1) / 2 : 0, c1 = (w & 1) ? NCJ : (NCJ + 1) / 2;
              const bf16x8 pa0 = *(const LAS bf16x8*)(Ps + (16 * ti + fr) * 72 + fq * 8), pa1 = *(const LAS bf16x8*)(Ps + (16 * ti + fr) * 72 + 32 + fq * 8);
#pragma unroll
              for (int cj = 0; cj < NCJ; ++cj) { if (cj >= c0 && cj < c1) {
                  f32x4 o1 = {0.f, 0.f, 0.f, 0.f}, o2 = {0.f, 0.f, 0.f, 0.f};
                  o1 = __builtin_amdgcn_mfma_f32_16x16x32_bf16(pa0, *(const LAS bf16x8*)(Vt + (16 * cj + fr) * 72 + fq * 8), o1, 0, 0, 0);
                  o1 = __builtin_amdgcn_mfma_f32_16x16x32_bf16(pa1, *(const LAS bf16x8*)(Vt + (16 * cj + fr) * 72 + 32 + fq * 8), o1, 0, 0, 0);
#pragma unroll
                  for (int ks = 0; ks < DK / 32; ++ks)
                      o2 = __builtin_amdgcn_mfma_f32_16x16x32_bf16(*(const LAS bf16x8*)(Qs + (16 * ti + fr) * QROW + ks * 32 + fq * 8), *(const LAS bf16x8*)(Rbt + (16 * cj + fr) * QROW + ks * 32 + fq * 8), o2, 0, 0, 0);
#pragma unroll
                  for (int rg = 0; rg < 4; ++rg) { const int t = 16 * ti + 4 * fq + rg; Os[t * DVS + 16 * cj + fr] = o1[rg] + xi[t] * o2[rg]; } } } }
            __syncthreads();
            { const float cx = chi[0];
              if (NRI >= 8 || w < NRI) {
#pragma unroll
                  for (int a = 0; a < (NRI >= 8 ? NRI / 8 : 1); ++a) { const int ri = (NRI >= 8) ? w * (NRI / 8) + a : w;
                      const bf16x8 ka0 = *(const LAS bf16x8*)(Kzt + (16 * ri + fr) * 72 + fq * 8), ka1 = *(const LAS bf16x8*)(Kzt + (16 * ri + fr) * 72 + 32 + fq * 8);
#pragma unroll
                      for (int cj = 0; cj < NCJ; ++cj) { f32x4 r4 = accR[a][cj] * cx;
                          r4 = __builtin_amdgcn_mfma_f32_16x16x32_bf16(ka0, *(const LAS bf16x8*)(Vt + (16 * cj + fr) * 72 + fq * 8), r4, 0, 0, 0);
                          r4 = __builtin_amdgcn_mfma_f32_16x16x32_bf16(ka1, *(const LAS bf16x8*)(Vt + (16 * cj + fr) * 72 + 32 + fq * 8), r4, 0, 0, 0);
                          accR[a][cj] = r4;
                          u32x2 wv; wv.x = pk2(r4[0], r4[1]); wv.y = pk2(r4[2], r4[3]); *(LAS u32x2*)(Rbt + (16 * cj + fr) * QROW + 16 * ri + 4 * fq) = wv; } } }
              if (ML) { bf16_t* OR = (bf16_t*)(ws + OFF_R + RB_ORAW);
                  const int t = c.tid >> 3, c4 = (c.tid & 7) * 4; const float den = Os[t * DVS + 32], dn = 1.f / fmaxf(fabsf(den), em[t]);
                  const f32x4 x = *(const LAS f32x4*)(Os + t * DVS + c4); u32x2 wv; wv.x = pk2(x[0] * dn, x[1] * dn); wv.y = pk2(x[2] * dn, x[3] * dn);
                  *(u32x2*)(OR + (tok0 + t) * DM + h * 128 + sl * 32 + c4) = wv;
              } else { bf16_t* OR = (bf16_t*)(ws + OFF_R + RC_ORAW);
                  const int t = c.tid >> 3, c8 = (c.tid & 7) * 8; const f32x4 x0 = *(const LAS f32x4*)(Os + t * DVS + c8), x1 = *(const LAS f32x4*)(Os + t * DVS + c8 + 4);
                  u32x4 wv; wv[0] = pk2(x0[0], x0[1]); wv[1] = pk2(x0[2], x0[3]); wv[2] = pk2(x1[0], x1[1]); wv[3] = pk2(x1[2], x1[3]);
                  *(u32x4*)(OR + (tok0 + t) * 2048 + h * 512 + sl * 64 + c8) = wv; } }
            __syncthreads();
        }
    }
}

__device__ __forceinline__ void phase_norm_b(LAS unsigned char* lds_) {
    const Ctx c = make_ctx(lds_);
    unsigned char* ws = fresh_params()->ws;
    const bf16_t* OR = (const bf16_t*)(ws + OFF_R + RB_ORAW); const bf16_t* PR = (const bf16_t*)(ws + OFF_R + RB_PROJ); bf16_t* ON = (bf16_t*)(ws + OFF_R + RB_ONORM);
    const float* ng = (const float*)(ws + OFF_PAR) + PAR_BNG;
    float gv[16];
#pragma unroll
    for (int k = 0; k < 16; ++k) gv[k] = ng[c.lane * 16 + k];
    for (int row = c.bid * 8 + c.wave; row < NTOK; row += c.G * 8) {
        float x[16], gt[16];
#pragma unroll
        for (int hf = 0; hf < 2; ++hf) { const u32x4 a = *(const u32x4*)(OR + (size_t)row * DM + c.lane * 16 + hf * 8), gq = *(const u32x4*)(PR + (size_t)row * 3072 + 2048 + c.lane * 16 + hf * 8);
#pragma unroll
            for (int k = 0; k < 4; ++k) { x[hf * 8 + 2 * k] = bflo(a[k]); x[hf * 8 + 2 * k + 1] = bfhi(a[k]); gt[hf * 8 + 2 * k] = bflo(gq[k]); gt[hf * 8 + 2 * k + 1] = bfhi(gq[k]); } }
        float s = 0.f;
#pragma unroll
        for (int k = 0; k < 16; ++k) s += x[k];
        s += __shfl_xor(s, 1); s += __shfl_xor(s, 2); s += __shfl_xor(s, 4);
        const float mu = s * (1.f / 128.f); float q = 0.f;
#pragma unroll
        for (int k = 0; k < 16; ++k) { x[k] -= mu; q += x[k] * x[k]; }
        q += __shfl_xor(q, 1); q += __shfl_xor(q, 2); q += __shfl_xor(q, 4);
        const float rstd = 1.f / sqrtf(q * (1.f / 128.f) + LN_EPS);
        u32x4 o0, o1;
#pragma unroll
        for (int k = 0; k < 4; ++k) { o0[k] = pk2(x[2 * k] * rstd * gv[2 * k] * sigmoid_f(gt[2 * k]), x[2 * k + 1] * rstd * gv[2 * k + 1] * sigmoid_f(gt[2 * k + 1]));
            o1[k] = pk2(x[8 + 2 * k] * rstd * gv[8 + 2 * k] * sigmoid_f(gt[8 + 2 * k]), x[9 + 2 * k] * rstd * gv[9 + 2 * k] * sigmoid_f(gt[9 + 2 * k])); }
        *(u32x4*)(ON + (size_t)row * DM + c.lane * 16) = o0; *(u32x4*)(ON + (size_t)row * DM + c.lane * 16 + 8) = o1;
    }
}
__device__ __forceinline__ void phase_norm_c(LAS unsigned char* lds_) {
    const Ctx c = make_ctx(lds_);
    unsigned char* ws = fresh_params()->ws;
    const bf16_t* OR = (const bf16_t*)(ws + OFF_R + RC_ORAW); const bf16_t* GG = (const bf16_t*)(ws + OFF_R + RC_G); bf16_t* ON = (bf16_t*)(ws + OFF_R + RC_V);
    const float* ng = (const float*)(ws + OFF_PAR) + PAR_CNG;
    for (int row = c.bid * 8 + c.wave; row < NTOK; row += c.G * 8) {
        float x[32];
#pragma unroll
        for (int qd = 0; qd < 4; ++qd) { const u32x4 a = *(const u32x4*)(OR + (size_t)row * 2048 + c.lane * 32 + qd * 8);
#pragma unroll
            for (int k = 0; k < 4; ++k) { x[qd * 8 + 2 * k] = bflo(a[k]); x[qd * 8 + 2 * k + 1] = bfhi(a[k]); } }
        float s = 0.f;
#pragma unroll
        for (int k = 0; k < 32; ++k) s += x[k];
        s += __shfl_xor(s, 1); s += __shfl_xor(s, 2); s += __shfl_xor(s, 4); s += __shfl_xor(s, 8);
        const float mu = s * (1.f / 512.f); float q = 0.f;
#pragma unroll
        for (int k = 0; k < 32; ++k) { x[k] -= mu; q += x[k] * x[k]; }
        q += __shfl_xor(q, 1); q += __shfl_xor(q, 2); q += __shfl_xor(q, 4); q += __shfl_xor(q, 8);
        const float rstd = 1.f / sqrtf(q * (1.f / 512.f) + LN_EPS);
#pragma unroll
        for (int qd = 0; qd < 4; ++qd) { const u32x4 gq = *(const u32x4*)(GG + (size_t)row * 2048 + c.lane * 32 + qd * 8);
            const f32x4 g0 = *(const f32x4*)(ng + c.lane * 32 + qd * 8), g1 = *(const f32x4*)(ng + c.lane * 32 + qd * 8 + 4);
            u32x4 o;
#pragma unroll
            for (int k = 0; k < 4; ++k) { const float ga = (k < 2) ? g0[2 * k] : g1[2 * k - 4], gb = (k < 2) ? g0[2 * k + 1] : g1[2 * k - 3];
                o[k] = pk2(x[qd * 8 + 2 * k] * rstd * ga * silu_f(bflo(gq[k])), x[qd * 8 + 2 * k + 1] * rstd * gb * silu_f(bfhi(gq[k]))); }
            *(u32x4*)(ON + (size_t)row * 2048 + c.lane * 32 + qd * 8) = o; }
    }
}

#define WS_FRESH() unsigned char* ws = fresh_params()->ws
__device__ __forceinline__ void gemm_qkv_a(LAS unsigned char* lds_, int jj) { const Ctx c = make_ctx(lds_); jj = __builtin_amdgcn_readfirstlane(jj); asm volatile("" : "+s"(jj)); WS_FRESH();
    pg8::Gemm g{(const pg8::bf16_t*)(ws + OFF_HB), (const pg8::bf16_t*)(ws + OFF_WA_IN) + (size_t)jj * 3072 * 1024, NTOK, 3072, 1024}; pg8::StaticOrder S; S.init(NTOK, 3072, c.G, c.bid);
    pg8::EpiQkvA E{(bf16_t*)(ws + OFF_R + RA_Q), SZ_TOK1K / 2, (const float*)(ws + OFF_COSA), (const float*)(ws + OFF_SINA)};
    pg8::gemm_phase<pg8::EpiQkvA, pg8::StaticOrder, true, true>(c.lds, g, S, E, c.tid); }
__device__ __forceinline__ void gemm_proj_b(LAS unsigned char* lds_) { const Ctx c = make_ctx(lds_); WS_FRESH();
    pg8::Gemm g{(const pg8::bf16_t*)(ws + OFF_HB), (const pg8::bf16_t*)(ws + OFF_WB_IN), NTOK, 3072, 1024}; pg8::StaticOrder S; S.init(NTOK, 3072, c.G, c.bid);
    pg8::EpiBf16Plain E{(bf16_t*)(ws + OFF_R + RB_PROJ), 3072};
    pg8::gemm_phase<pg8::EpiBf16Plain, pg8::StaticOrder, true, true>(c.lds, g, S, E, c.tid); }
__device__ __forceinline__ void gemm_proj_c(LAS unsigned char* lds_) { const Ctx c = make_ctx(lds_); WS_FRESH();
    pg8::Gemm g{(const pg8::bf16_t*)(ws + OFF_HB), (const pg8::bf16_t*)(ws + OFF_WC_IN), NTOK, 6144, 1024}; pg8::StaticOrder S; S.init(NTOK, 6144, c.G, c.bid);
    pg8::EpiProjC E{(bf16_t*)(ws + OFF_R + RC_Q), (bf16_t*)(ws + OFF_R + RC_V), (RC_K - RC_Q) / 2, (RC_G - RC_V) / 2, (const float*)(ws + OFF_COSC), (const float*)(ws + OFF_SINC)};
    pg8::gemm_phase<pg8::EpiProjC, pg8::StaticOrder, true, true>(c.lds, g, S, E, c.tid); }
__device__ __forceinline__ void gemm_out(LAS unsigned char* lds_, int kind, int jj, bool first) { const Ctx c = make_ctx(lds_); kind = __builtin_amdgcn_readfirstlane(kind); asm volatile("" : "+s"(kind)); jj = __builtin_amdgcn_readfirstlane(jj); asm volatile("" : "+s"(jj)); WS_FRESH();
    const size_t aoff = OFF_R + (kind == 0 ? RA_Q : (kind == 1 ? RB_ONORM : RC_V));
    const size_t boff = kind == 0 ? OFF_WA_OUT + (size_t)jj * 1024 * 1024 * 2 : (kind == 1 ? OFF_WB_OUT : OFF_WC_OUT);
    pg8::Gemm g{(const pg8::bf16_t*)(ws + aoff), (const pg8::bf16_t*)(ws + boff), NTOK, 1024, kind == 2 ? 2048 : 1024}; pg8::StaticOrder S; S.init(NTOK, 1024, c.G, c.bid);
    pg8::EpiResidual E{first ? fresh_params()->in[0] : (const float*)(ws + OFF_H), (float*)(ws + OFF_H), DN_ALPHA};
    pg8::gemm_phase<pg8::EpiResidual, pg8::StaticOrder, true, true>(c.lds, g, S, E, c.tid); }
__device__ __forceinline__ void gemm_moe_gu(LAS unsigned char* lds_) { const Ctx c = make_ctx(lds_); WS_FRESH();
    const LAS int* misc = (const LAS int*)(c.lds + LDS_MISC); const int ntiles = __builtin_amdgcn_readfirstlane(misc[0]);
    pg8::Gemm g{(const pg8::bf16_t*)(ws + OFF_R + RM_XB), (const pg8::bf16_t*)(ws + OFF_WE_GU), 0, 0, 1024};
    pg8::MoeOrder S{misc + 1, ntiles, 2, 2, c.G, c.bid}; pg8::EpiMoeGU E{(bf16_t*)(ws + OFF_R + RM_HID)};
    pg8::gemm_phase<pg8::EpiMoeGU, pg8::MoeOrder, true, true>(c.lds, g, S, E, c.tid); }
__device__ __forceinline__ void gemm_moe_down(LAS unsigned char* lds_) { const Ctx c = make_ctx(lds_); WS_FRESH();
    const LAS int* misc = (const LAS int*)(c.lds + LDS_MISC); const int ntiles = __builtin_amdgcn_readfirstlane(misc[0]);
    pg8::Gemm g{(const pg8::bf16_t*)(ws + OFF_R + RM_HID), (const pg8::bf16_t*)(ws + OFF_WE_D), 0, 0, 256};
    pg8::MoeOrder S{misc + 1, ntiles, 4, 4, c.G, c.bid}; pg8::EpiMoeDown E{(bf16_t*)(ws + OFF_R + RM_YEXP), (const float*)(ws + OFF_ROWGATE)};
    pg8::gemm_phase<pg8::EpiMoeDown, pg8::MoeOrder, true, true>(c.lds, g, S, E, c.tid); }

__global__ void __launch_bounds__(512, 2) fwd_megakernel(Params p) {
    extern __shared__ __attribute__((aligned(16))) unsigned char lds_raw[];
    cg::grid_group grid = cg::this_grid();
    LAS unsigned char* lds = (LAS unsigned char*)lds_raw;

#ifndef NO_PROLOGUE
    phase_prologue(lds);
#endif
    grid.sync();

#pragma unroll 1
    for (int layer = 0; layer < DEPTH; ++layer) {
        const int kind = layer % 3, jj = layer / 3;
        const bool mix_on = (kind == 0) ? (EN_MIX_A != 0) : (kind == 1 ? (EN_MIX_B != 0) : (EN_MIX_C != 0));
        if (mix_on) {
            if (kind == 0) {
#if EN_MIX_A
                gemm_qkv_a(lds, jj);
                grid.sync();
                phase_attn(lds);
                grid.sync();
                phase_attn_combine(lds);
                grid.sync();
#endif
            } else if (kind == 1) {
#if EN_MIX_B
                gemm_proj_b(lds);
                grid.sync();
                phase_scan<64, 48, true>(lds);
                grid.sync();
                phase_norm_b(lds);
                grid.sync();
#endif
            } else {
#if EN_MIX_C
                gemm_proj_c(lds);
                grid.sync();
                phase_scan<256, 64, false>(lds);
                grid.sync();
                phase_norm_c(lds);
                grid.sync();
#endif
            }
            gemm_out(lds, kind, jj, layer == 0);
            grid.sync();
        }
        phase_ln1_router(lds, layer, mix_on, EN_MOE != 0);
        grid.sync();
#if EN_MOE
        convert_experts(lds, layer);
        __syncthreads();
        phase_moe_scan(lds);
        grid.sync();
#ifndef DBG_SKIP_GU
        gemm_moe_gu(lds);
#endif
        grid.sync();
#ifndef DBG_SKIP_DOWN
        gemm_moe_down(lds);
#endif
        grid.sync();
#endif
        phase_ln2(lds, layer, layer == DEPTH - 1, EN_MOE != 0, (layer + 1 < DEPTH) && ((layer + 1) % 3 == 1) && (EN_MIX_B != 0));
        grid.sync();
    }
}

extern "C" void kernel_launch(void* const* d_in, const int* in_sizes, int n_in, void* d_out, int out_size, void* d_ws, size_t ws_size, hipStream_t stream) {
    static int grid = 0;
    if (grid == 0) {
        if (n_in != 24 || in_sizes[0] != NTOK * DM || out_size != NTOK * DM || ws_size < WS_END) {
            fprintf(stderr, "kernel_launch: built for 24 inputs, x/out of %d floats, >= %zu bytes of workspace; got n_in %d, in0 %d, out %d, ws %zu; nothing launched\n", NTOK * DM, (size_t)WS_END, n_in, n_in > 0 ? in_sizes[0] : -1, out_size, ws_size);
            grid = -1; return; }
        int dev = 0, cus = 0, per_cu = 0;
        if (hipGetDevice(&dev) != hipSuccess || hipDeviceGetAttribute(&cus, hipDeviceAttributeMultiprocessorCount, dev) != hipSuccess) { fprintf(stderr, "kernel_launch: device query failed\n"); grid = -1; return; }
        if (hipFuncSetAttribute((const void*)fwd_megakernel, hipFuncAttributeMaxDynamicSharedMemorySize, LDS_BYTES) != hipSuccess) { fprintf(stderr, "kernel_launch: hipFuncSetAttribute(%d B LDS) failed\n", LDS_BYTES); grid = -1; return; }
        if (hipOccupancyMaxActiveBlocksPerMultiprocessor(&per_cu, (const void*)fwd_megakernel, 512, LDS_BYTES) != hipSuccess || per_cu < 1) { fprintf(stderr, "kernel_launch: occupancy query says %d blocks per CU\n", per_cu); (void)hipGetLastError(); per_cu = 1; }
        grid = cus * (per_cu > 1 ? 1 : per_cu);
    }
    if (grid < 0) return;
    Params p{};
    for (int i = 0; i < 24; ++i) p.in[i] = (const float*)d_in[i];
    p.out = (float*)d_out; p.ws = (unsigned char*)d_ws;
    for (int i = 0; i < 8; ++i) p.invA[i] = pow(500000.0, -(double)(2 * i) / 16.0);
    for (int i = 0; i < 128; ++i) p.invC[i] = pow(10000.0, -(double)(2 * i) / 256.0);
    void* args[] = {&p};
    const hipError_t e = hipLaunchCooperativeKernel((const void*)fwd_megakernel, dim3(grid), dim3(512), args, LDS_BYTES, stream);
    if (e != hipSuccess) fprintf(stderr, "kernel_launch: cooperative launch failed: %s (grid %d, %d B LDS)\n", hipGetErrorString(e), grid, LDS_BYTES);
}
```

```cpp
#define EN_MIX_A 1
#define EN_MIX_B 1
#define EN_MIX_C 1
#define EN_MOE 1
#include <hip/hip_runtime.h>
#include <hip/hip_cooperative_groups.h>
#include <cstdio>
#include <cstdint>
#include <cmath>
namespace cg = cooperative_groups;

#ifndef EN_MIX_A
#define EN_MIX_A 1
#endif
#ifndef EN_MIX_B
#define EN_MIX_B 1
#endif
#ifndef EN_MIX_C
#define EN_MIX_C 1
#endif
#ifndef EN_MOE
#define EN_MOE 1
#endif

#define LAS __attribute__((address_space(3)))
typedef unsigned short bf16_t;
typedef short bf16x8 __attribute__((ext_vector_type(8)));
typedef short s16x4 __attribute__((ext_vector_type(4)));
typedef float f32x4 __attribute__((ext_vector_type(4)));
typedef float f32x2 __attribute__((ext_vector_type(2)));
typedef unsigned u32x4 __attribute__((ext_vector_type(4)));
typedef unsigned u32x2 __attribute__((ext_vector_type(2)));

constexpr int NTOK = 32768, DM = 1024, SEQ = 4096, NBATCH = 8, DEPTH = 4;
constexpr float DN_ALPHA = 1.6817928305074292f;
constexpr float LN_EPS = 1e-5f;
constexpr int MOE_MAXROWS = 81920;
constexpr int MOE_MAXTILES = 320;

constexpr size_t al256(size_t x) { return (x + 255) & ~(size_t)255; }
constexpr size_t OFF_CTL = 0, SZ_CTL = 1u << 20;
constexpr size_t OFF_COSA = OFF_CTL + SZ_CTL;
constexpr size_t OFF_SINA = OFF_COSA + (size_t)SEQ * 8 * 4;
constexpr size_t OFF_COSC = OFF_SINA + (size_t)SEQ * 8 * 4;
constexpr size_t OFF_SINC = OFF_COSC + (size_t)SEQ * 128 * 4;
constexpr size_t OFF_PAR = OFF_SINC + (size_t)SEQ * 128 * 4;
constexpr int PAR_LN1G = 0, PAR_LN1B = 4096, PAR_LN2G = 8192, PAR_LN2B = 12288, PAR_GBIAS = 16384, PAR_CONVW = 16400, PAR_CONVB = 20496, PAR_BNG = 21520, PAR_CNG = 22544, PAR_RGB = 24592, PAR_REB = 24624, PAR_END = 24880;
constexpr size_t OFF_WG = OFF_PAR + (size_t)25088 * 4;
constexpr size_t OFF_WR = OFF_WG + 16 * 1024 * 4;
constexpr size_t OFF_WA_IN = OFF_WR + (size_t)4 * 2 * 80 * 1024 * 2;
constexpr size_t OFF_WA_OUT = OFF_WA_IN + (size_t)2 * 3072 * 1024 * 2;
constexpr size_t OFF_WB_IN = OFF_WA_OUT + (size_t)2 * 1024 * 1024 * 2;
constexpr size_t OFF_WB_OUT = OFF_WB_IN + (size_t)3072 * 1024 * 2;
constexpr size_t OFF_WC_IN = OFF_WB_OUT + (size_t)1024 * 1024 * 2;
constexpr size_t OFF_WC_OUT = OFF_WC_IN + (size_t)6144 * 1024 * 2;
constexpr size_t OFF_WE_GU = OFF_WC_OUT + (size_t)1024 * 2048 * 2;
constexpr size_t OFF_WE_D = OFF_WE_GU + (size_t)64 * 512 * 1024 * 2;
constexpr size_t OFF_H = OFF_WE_D + (size_t)64 * 1024 * 256 * 2;
constexpr size_t OFF_HB = OFF_H + (size_t)NTOK * DM * 4;
constexpr size_t OFF_GATES = OFF_HB + (size_t)NTOK * DM * 2;
constexpr size_t OFF_EID = OFF_GATES + (size_t)NTOK * 16 * 4;
constexpr size_t OFF_GATE = OFF_EID + (size_t)NTOK * 2 * 4;
constexpr size_t OFF_SLOT = OFF_GATE + (size_t)NTOK * 2 * 4;
constexpr size_t OFF_ROWGATE = OFF_SLOT + (size_t)NTOK * 2 * 4;
constexpr size_t OFF_R = al256(OFF_ROWGATE + (size_t)MOE_MAXROWS * 4);
constexpr size_t SZ_TOK1K = (size_t)NTOK * 1024 * 2;
constexpr size_t RA_Q = 0, RA_K = SZ_TOK1K, RA_V = 2 * SZ_TOK1K, RA_OG = 3 * SZ_TOK1K, RA_LSE = 6 * SZ_TOK1K;
constexpr size_t RB_PROJ = 0, RB_ORAW = 3 * SZ_TOK1K, RB_ONORM = 4 * SZ_TOK1K;
constexpr size_t RC_Q = 0, RC_K = SZ_TOK1K, RC_V = 2 * SZ_TOK1K, RC_G = 4 * SZ_TOK1K, RC_ORAW = 6 * SZ_TOK1K;
constexpr size_t RM_XB = 0, RM_HID = (size_t)MOE_MAXROWS * 1024 * 2, RM_YEXP = RM_HID + (size_t)MOE_MAXROWS * 256 * 2;
constexpr size_t SZ_R = 8 * SZ_TOK1K;
constexpr size_t WS_END = OFF_R + SZ_R;
static_assert(RA_LSE + (size_t)3 * NTOK * 16 * 4 <= SZ_R && RM_YEXP + (size_t)MOE_MAXROWS * 1024 * 2 <= SZ_R, "region R");

constexpr int LDS_BYTES = 163840;
constexpr int LDS_MISC = 131072;
constexpr int LDS_BAR = LDS_BYTES - 256;
constexpr size_t OFF_BAR = OFF_CTL + 262144;

__device__ __forceinline__ unsigned f2bf(float f) { unsigned u = __builtin_bit_cast(unsigned, f); return (u + 0x7fffu + ((u >> 16) & 1u)) >> 16; }
__device__ __forceinline__ unsigned pk2(float lo, float hi) { return f2bf(lo) | (f2bf(hi) << 16); }
__device__ __forceinline__ float bf2f(unsigned short b) { return __builtin_bit_cast(float, (unsigned)b << 16); }
__device__ __forceinline__ float bflo(unsigned w) { return __builtin_bit_cast(float, w << 16); }
__device__ __forceinline__ float bfhi(unsigned w) { return __builtin_bit_cast(float, w & 0xffff0000u); }
__device__ __forceinline__ float wave_sum(float v) {
#pragma unroll
    for (int o = 1; o < 64; o <<= 1) v += __shfl_xor(v, o);
    return v;
}
__device__ __forceinline__ float silu_f(float x) { return x / (1.f + __expf(-x)); }
__device__ __forceinline__ float sigmoid_f(float x) { return 1.f / (1.f + __expf(-x)); }

namespace pg8 {
#define PG8_LAS __attribute__((address_space(3)))
typedef unsigned short bf16_t;
typedef short bf16x8 __attribute__((ext_vector_type(8)));
typedef float f32x4 __attribute__((ext_vector_type(4)));
typedef unsigned u32x4 __attribute__((ext_vector_type(4)));
constexpr int BM = 256, BK = 64, HALF = 128, HTB = HALF * BK * 2  , STAGE_BYTES = 8 * HTB, NXCD = 8, WGM = 8;

__host__ __device__ __forceinline__ int lds_byte(int r, int c) { const int st = (r >> 4) * 2 + (c >> 5), rr = r & 15, cc = c & 31, ob = rr * 64 + cc * 2; return st * 1024 + (ob ^ (((ob >> 9) & 1) << 5)); }
__host__ __device__ __forceinline__ void stage_rc(int b, int& R, int& C) { const int st = b / 1024, sb = b % 1024, swz = sb ^ (((sb >> 9) & 1) << 5); R = (st >> 1) * 16 + swz / 64; C = (st & 1) * 32 + (swz % 64) / 2; }
__host__ __device__ __forceinline__ int perm32(int rho) { const int n = rho >> 4, i = rho & 15; return 8 * (i >> 2) + 4 * n + (i & 3); }

struct Unit { int pm, pn, pb; };
struct Gemm { const bf16_t* A; const bf16_t* Bt; int M, N, K; };

struct StaticOrder {
    int nM, nN, nwg, G, c;
    __host__ __device__ void init(int M, int N, int G_, int c_) { nM = M / BM; nN = N / BM; nwg = nM * nN; G = G_; c = c_; }
    __host__ __device__ bool next(int i, Unit& u) const {
        const long L = (long)i * G + c; if (L >= nwg) return false;
        int wgid = (int)L; { const int q = nwg / NXCD, r = nwg % NXCD, xcd = wgid % NXCD, off = wgid / NXCD; wgid = (xcd < r ? xcd * (q + 1) : r * (q + 1) + (xcd - r) * q) + off; }
        const int nig = WGM * nN, gid = wgid / nig, fm = gid * WGM, gsz = (nM - fm) < WGM ? (nM - fm) : WGM;
        u.pm = fm + ((wgid % nig) % gsz); u.pn = (wgid % nig) / gsz; u.pb = u.pn; return true;
    }
    __device__ __forceinline__ void a_ready(const Unit&) const {}
    __device__ __forceinline__ void done(const Unit&) const {}
};
__device__ __forceinline__ unsigned cvt_pk_bf16(float lo, float hi) { unsigned r; asm volatile("v_cvt_pk_bf16_f32 %0, %1, %2" : "=v"(r) : "v"(lo), "v"(hi)); return r; }
typedef float f32x2 __attribute__((ext_vector_type(2)));
template <class Epi, class Sched, bool ALIGN_EPI = false, bool SP2 = false>
__device__ __forceinline__ void gemm_phase(PG8_LAS unsigned char* lds, const Gemm g, const Sched& S, const Epi& E, const int tid) {
    const int wid = __builtin_amdgcn_readfirstlane(tid >> 6), lane = tid & 63, wr = wid >> 2, wc = wid & 3, fr = lane & 15, fq = lane >> 4;
    const int K = g.K, nt = K / BK;
    unsigned voffA[2], voffB[2];
#pragma unroll
    for (int i = 0; i < 2; ++i) { int R, C; stage_rc(tid * 16 + i * 8192, R, C); const int Rb = Epi::PERM ? ((R & ~31) + perm32(R & 31)) : R;
        voffA[i] = (unsigned)(R * K + C) * 2u; voffB[i] = (unsigned)(Rb * K + C) * 2u; }
    const size_t kstep = (size_t)(BK * 2);
    const size_t hstep = (size_t)HALF * K * 2;
    const size_t tstep = 2 * hstep;
    const unsigned ldsw = (unsigned)wid * 1024u;
    const int aoff = lds_byte(wr * 64 + fr, fq * 8), boff = lds_byte(wc * 32 + fr, fq * 8);
#define PG8_SA(b, h) (((b) * 2 + (h)) * HTB)
#define PG8_SB(b, h) ((4 + (b) * 2 + (h)) * HTB)
#define PG8_STAGE(bufoff, gbase, voff) do { _Pragma("unroll") for (int _i = 0; _i < 2; ++_i) \
        __builtin_amdgcn_global_load_lds((const unsigned*)((const char*)(gbase) + (voff)[_i]), (PG8_LAS unsigned*)(lds + (bufoff) + ldsw + _i * 8192), 16, 0, 0); } while (0)
#define PG8_LDA(dst, b, h) do { _Pragma("unroll") for (int m = 0; m < 4; ++m) _Pragma("unroll") for (int k = 0; k < 2; ++k) dst[m][k] = *(const PG8_LAS bf16x8*)(lds + PG8_SA(b, h) + aoff + m * 2048 + k * 1024); } while (0)
#define PG8_LDB(dst, b, h) do { _Pragma("unroll") for (int n = 0; n < 2; ++n) _Pragma("unroll") for (int k = 0; k < 2; ++k) dst[n][k] = *(const PG8_LAS bf16x8*)(lds + PG8_SB(b, h) + boff + n * 2048 + k * 1024); } while (0)
#define PG8_MMA(ai, bj, At, Bt) do { __builtin_amdgcn_s_setprio(1); _Pragma("unroll") for (int m = 0; m < 4; ++m) _Pragma("unroll") for (int n = 0; n < 2; ++n) _Pragma("unroll") for (int k = 0; k < 2; ++k) \
        acc[ai][bj][m][n] = __builtin_amdgcn_mfma_f32_16x16x32_bf16(Bt[n][k], At[m][k], acc[ai][bj][m][n], 0, 0, 0); __builtin_amdgcn_s_setprio(0); } while (0)
#define PG8_WAIT_V(n) asm volatile("s_waitcnt vmcnt(" #n ")" ::: "memory")
#define PG8_WAIT_L(n) asm volatile("s_waitcnt lgkmcnt(" #n ")" ::: "memory")
#define PG8_BAR __builtin_amdgcn_s_barrier()
#define PG8_SCHED __builtin_amdgcn_sched_barrier(0)
    Unit cur, nxt; int ui = 0;
    if (!S.next(0, cur)) return;
    f32x4 acc[2][2][4][2];
#pragma unroll
    for (int a = 0; a < 2; ++a)
#pragma unroll
        for (int b = 0; b < 2; ++b)
#pragma unroll
            for (int m = 0; m < 4; ++m)
#pragma unroll
                for (int n = 0; n < 2; ++n) acc[a][b][m][n] = (f32x4){0.f, 0.f, 0.f, 0.f};
    bf16x8 At[4][2], B0[2][2], B1[2][2];
    const char* cA = (const char*)g.A + (size_t)cur.pm * tstep; const char* cB = (const char*)g.Bt + (size_t)cur.pb * tstep;
    S.a_ready(cur);
    if constexpr (SP2) {
        PG8_STAGE(PG8_SB(0, 0), cB, voffB); PG8_STAGE(PG8_SB(0, 1), cB + hstep, voffB); PG8_STAGE(PG8_SA(0, 0), cA, voffA); PG8_STAGE(PG8_SA(0, 1), cA + hstep, voffA);
        if (wr == 1) PG8_BAR;
        PG8_WAIT_V(2); PG8_BAR;
        PG8_STAGE(PG8_SB(1, 0), cB + kstep, voffB); PG8_STAGE(PG8_SA(1, 0), cA + kstep, voffA); PG8_STAGE(PG8_SB(1, 1), cB + hstep + kstep, voffB);
        PG8_WAIT_V(6); PG8_BAR;
    } else {
        PG8_STAGE(PG8_SB(0, 0), cB, voffB); PG8_STAGE(PG8_SA(0, 0), cA, voffA); PG8_STAGE(PG8_SB(0, 1), cB + hstep, voffB); PG8_STAGE(PG8_SA(0, 1), cA + hstep, voffA);
        if (wr == 1) PG8_BAR;
        PG8_WAIT_V(4); PG8_BAR;
        PG8_STAGE(PG8_SB(1, 0), cB + kstep, voffB); PG8_STAGE(PG8_SA(1, 0), cA + kstep, voffA); PG8_STAGE(PG8_SB(1, 1), cB + hstep + kstep, voffB);
        PG8_WAIT_V(6); PG8_BAR;
    }
    for (;;) {
        const bool has_next = S.next(ui + 1, nxt);
        const char* nA = has_next ? (const char*)g.A + (size_t)nxt.pm * tstep : cA; const char* nB = has_next ? (const char*)g.Bt + (size_t)nxt.pb * tstep : cB;
#pragma unroll 1
        for (int t = 0; t < nt; t += 2) {
            const bool last = (t == nt - 2);
            const char* a1 = cA + (size_t)(t + 1) * kstep;
            const char* a2 = last ? nA : cA + (size_t)(t + 2) * kstep; const char* b2 = last ? nB : cB + (size_t)(t + 2) * kstep;
            const char* a3 = a2 + kstep; const char* b3 = b2 + kstep;
            if (last && has_next) S.a_ready(nxt);
            if constexpr (SP2) {
            PG8_LDB(B0, 0, 0); PG8_LDB(B1, 0, 1); PG8_SCHED; PG8_LDA(At, 0, 0); PG8_STAGE(PG8_SA(1, 1), a1 + hstep, voffA);
            PG8_WAIT_V(8); PG8_WAIT_L(0); PG8_BAR; PG8_MMA(0, 0, At, B0); PG8_MMA(0, 1, At, B1); PG8_BAR; PG8_SCHED;
            PG8_LDA(At, 0, 1); PG8_STAGE(PG8_SB(0, 0), b2, voffB); PG8_STAGE(PG8_SB(0, 1), b2 + hstep, voffB); PG8_STAGE(PG8_SA(0, 0), a2, voffA);
            PG8_WAIT_V(8); PG8_WAIT_L(0); PG8_BAR; PG8_MMA(1, 0, At, B0); PG8_MMA(1, 1, At, B1); PG8_BAR; PG8_SCHED;
            PG8_LDB(B0, 1, 0); PG8_LDB(B1, 1, 1); PG8_SCHED; PG8_LDA(At, 1, 0); PG8_STAGE(PG8_SA(0, 1), a2 + hstep, voffA);
            PG8_WAIT_V(8); PG8_WAIT_L(0); PG8_BAR; PG8_MMA(0, 0, At, B0); PG8_MMA(0, 1, At, B1); PG8_BAR; PG8_SCHED;
            PG8_LDA(At, 1, 1); PG8_STAGE(PG8_SB(1, 0), b3, voffB); PG8_STAGE(PG8_SB(1, 1), b3 + hstep, voffB); PG8_STAGE(PG8_SA(1, 0), a3, voffA);
            PG8_WAIT_V(8); PG8_WAIT_L(0); PG8_BAR; PG8_MMA(1, 0, At, B0); PG8_MMA(1, 1, At, B1); PG8_BAR; PG8_SCHED;
            } else {
            PG8_LDB(B0, 0, 0); PG8_SCHED; PG8_LDA(At, 0, 0); PG8_STAGE(PG8_SA(1, 1), a1 + hstep, voffA);
            PG8_WAIT_L(8); PG8_BAR; PG8_WAIT_L(0); PG8_MMA(0, 0, At, B0); PG8_BAR; PG8_SCHED;
            PG8_LDB(B1, 0, 1); PG8_STAGE(PG8_SB(0, 0), b2, voffB);
            PG8_BAR; PG8_WAIT_L(0); PG8_MMA(0, 1, At, B1); PG8_BAR;
            PG8_LDA(At, 0, 1); PG8_STAGE(PG8_SA(0, 0), a2, voffA);
            PG8_BAR; PG8_WAIT_L(0); PG8_MMA(1, 0, At, B0); PG8_BAR; PG8_SCHED;
            PG8_STAGE(PG8_SB(0, 1), b2 + hstep, voffB);
            PG8_WAIT_V(6); PG8_BAR; PG8_MMA(1, 1, At, B1); PG8_BAR;
            PG8_LDB(B0, 1, 0); PG8_SCHED; PG8_LDA(At, 1, 0); PG8_STAGE(PG8_SA(0, 1), a2 + hstep, voffA);
            PG8_WAIT_L(8); PG8_BAR; PG8_WAIT_L(0); PG8_MMA(0, 0, At, B0); PG8_BAR; PG8_SCHED;
            PG8_LDB(B1, 1, 1); PG8_STAGE(PG8_SB(1, 0), b3, voffB);
            PG8_BAR; PG8_WAIT_L(0); PG8_MMA(0, 1, At, B1); PG8_BAR;
            PG8_LDA(At, 1, 1); PG8_STAGE(PG8_SA(1, 0), a3, voffA);
            PG8_BAR; PG8_WAIT_L(0); PG8_MMA(1, 0, At, B0); PG8_BAR; PG8_SCHED;
            PG8_STAGE(PG8_SB(1, 1), b3 + hstep, voffB);
            PG8_WAIT_V(6); PG8_BAR; PG8_MMA(1, 1, At, B1); PG8_BAR;
            }
        }
        if constexpr (ALIGN_EPI) { if (wr == 0) PG8_BAR; }
        if constexpr (!Epi::AFTER_DRAIN) { E(acc, cur, wr, wc, fr, fq); S.done(cur); }
        if (!has_next) break;
#pragma unroll
        for (int a = 0; a < 2; ++a)
#pragma unroll
            for (int b = 0; b < 2; ++b)
#pragma unroll
                for (int m = 0; m < 4; ++m)
#pragma unroll
                    for (int n = 0; n < 2; ++n) acc[a][b][m][n] = (f32x4){0.f, 0.f, 0.f, 0.f};
        cur = nxt; cA = nA; cB = nB; ++ui;
        if constexpr (ALIGN_EPI) { if (wr == 1) PG8_BAR; }
    }
    PG8_WAIT_V(0);
    if constexpr (!ALIGN_EPI) { if (wr == 0) PG8_BAR; }
    PG8_BAR;
    if constexpr (Epi::AFTER_DRAIN) { E.fused(acc, cur, wr, wc, fr, fq, lds, wid, lane); S.done(cur); }
#undef PG8_SA
#undef PG8_SB
#undef PG8_STAGE
#undef PG8_LDA
#undef PG8_LDB
#undef PG8_MMA
#undef PG8_WAIT_V
#undef PG8_WAIT_L
#undef PG8_BAR
#undef PG8_SCHED
}

typedef unsigned u32x2 __attribute__((ext_vector_type(2)));
constexpr int kSeq = 4096;

struct EpiQkvA {
    static constexpr bool PERM = false, AFTER_DRAIN = false;
    bf16_t* QKV; size_t stride; const float *cosA, *sinA;
    __device__ __forceinline__ void operator()(const f32x4 (&acc)[2][2][4][2], const Unit& u, int wr, int wc, int fr, int fq) const {
        const int sel = u.pn >> 2; bf16_t* base = QKV + (size_t)sel * stride;
        const float sc = sel == 0 ? 0.125f : 1.f;
        const int colt = (u.pn & 3) * 256 + wc * 32 + 4 * fq;
        const bool rot = (sel < 2) && ((wc & 1) == 0);
#pragma unroll
        for (int ai = 0; ai < 2; ++ai)
#pragma unroll
            for (int m = 0; m < 4; ++m) {
                const int row = u.pm * BM + ai * HALF + wr * 64 + m * 16 + fr;
                f32x4 cs = {1.f, 1.f, 1.f, 1.f}, sn = {0.f, 0.f, 0.f, 0.f};
                if (rot) { const int sp = row & (kSeq - 1); cs = *(const f32x4*)(cosA + sp * 8 + 4 * (fq & 1)); sn = *(const f32x4*)(sinA + sp * 8 + 4 * (fq & 1)); }
#pragma unroll
                for (int bj = 0; bj < 2; ++bj)
#pragma unroll
                    for (int n = 0; n < 2; ++n) {
                        f32x4 v = acc[ai][bj][m][n];
                        if (n == 0 && rot) {
                            f32x4 p; p[0] = __shfl_xor(v[0], 32); p[1] = __shfl_xor(v[1], 32); p[2] = __shfl_xor(v[2], 32); p[3] = __shfl_xor(v[3], 32);
                            v = (fq < 2) ? (v * cs - p * sn) : (v * cs + p * sn);
                        }
                        v = v * sc;
                        u32x2 w; w.x = cvt_pk_bf16(v[0], v[1]); w.y = cvt_pk_bf16(v[2], v[3]);
                        *(u32x2*)(base + (size_t)row * 1024 + colt + bj * HALF + n * 16) = w;
                    }
            }
    }
};

struct EpiBf16Plain {
    static constexpr bool PERM = true, AFTER_DRAIN = false;
    bf16_t* O; int ldc;
    __device__ __forceinline__ void operator()(const f32x4 (&acc)[2][2][4][2], const Unit& u, int wr, int wc, int fr, int fq) const {
        const int row0 = u.pm * BM + wr * 64 + fr, col0 = u.pn * BM + wc * 32 + 8 * fq;
#pragma unroll
        for (int ai = 0; ai < 2; ++ai)
#pragma unroll
            for (int m = 0; m < 4; ++m) { bf16_t* rowp = O + (size_t)(row0 + ai * HALF + m * 16) * ldc + col0;
#pragma unroll
                for (int bj = 0; bj < 2; ++bj) { const f32x4 v0 = acc[ai][bj][m][0], v1 = acc[ai][bj][m][1];
                    u32x4 w; w.x = cvt_pk_bf16(v0[0], v0[1]); w.y = cvt_pk_bf16(v0[2], v0[3]); w.z = cvt_pk_bf16(v1[0], v1[1]); w.w = cvt_pk_bf16(v1[2], v1[3]);
                    *(u32x4*)(rowp + bj * HALF) = w; } }
    }
};

struct EpiProjC {
    static constexpr bool PERM = true, AFTER_DRAIN = false;
    bf16_t *QK, *VG; size_t qk_stride, vg_stride; const float *cosC, *sinC;
    __device__ __forceinline__ void operator()(const f32x4 (&acc)[2][2][4][2], const Unit& u, int wr, int wc, int fr, int fq) const {
        const int row0 = u.pm * BM + wr * 64 + fr;
        if (u.pn < 8) {
            const bool isk = u.pn >= 4; bf16_t* base = QK + (isk ? qk_stride : (size_t)0); const float sc = isk ? 0.0625f : 1.f;
            const int i0 = wc * 32 + 8 * fq, colb = (u.pn & 3) * 256 + i0;
#pragma unroll
            for (int ai = 0; ai < 2; ++ai)
#pragma unroll
                for (int m = 0; m < 4; ++m) {
                    const int row = row0 + ai * HALF + m * 16, sp = row & (kSeq - 1);
                    const f32x4 c0 = *(const f32x4*)(cosC + sp * 128 + i0), c1 = *(const f32x4*)(cosC + sp * 128 + i0 + 4);
                    const f32x4 s0 = *(const f32x4*)(sinC + sp * 128 + i0), s1 = *(const f32x4*)(sinC + sp * 128 + i0 + 4);
                    const f32x4 x1a = acc[ai][0][m][0], x1b = acc[ai][0][m][1], x2a = acc[ai][1][m][0], x2b = acc[ai][1][m][1];
                    const f32x4 o1a = (x1a * c0 - x2a * s0) * sc, o1b = (x1b * c1 - x2b * s1) * sc;
                    const f32x4 o2a = (x2a * c0 + x1a * s0) * sc, o2b = (x2b * c1 + x1b * s1) * sc;
                    bf16_t* rowp = base + (size_t)row * 1024 + colb;
                    u32x4 w; w.x = cvt_pk_bf16(o1a[0], o1a[1]); w.y = cvt_pk_bf16(o1a[2], o1a[3]); w.z = cvt_pk_bf16(o1b[0], o1b[1]); w.w = cvt_pk_bf16(o1b[2], o1b[3]);
                    *(u32x4*)rowp = w;
                    w.x = cvt_pk_bf16(o2a[0], o2a[1]); w.y = cvt_pk_bf16(o2a[2], o2a[3]); w.z = cvt_pk_bf16(o2b[0], o2b[1]); w.w = cvt_pk_bf16(o2b[2], o2b[3]);
                    *(u32x4*)(rowp + HALF) = w;
                }
        } else {
            bf16_t* base = VG + (u.pn >= 16 ? vg_stride : (size_t)0); const int col0 = ((u.pn - 8) & 7) * 256 + wc * 32 + 8 * fq;
#pragma unroll
            for (int ai = 0; ai < 2; ++ai)
#pragma unroll
                for (int m = 0; m < 4; ++m) { bf16_t* rowp = base + (size_t)(row0 + ai * HALF + m * 16) * 2048 + col0;
#pragma unroll
                    for (int bj = 0; bj < 2; ++bj) { const f32x4 v0 = acc[ai][bj][m][0], v1 = acc[ai][bj][m][1];
                        u32x4 w; w.x = cvt_pk_bf16(v0[0], v0[1]); w.y = cvt_pk_bf16(v0[2], v0[3]); w.z = cvt_pk_bf16(v1[0], v1[1]); w.w = cvt_pk_bf16(v1[2], v1[3]);
                        *(u32x4*)(rowp + bj * HALF) = w; } }
        }
    }
};

struct EpiResidual {
    static constexpr bool PERM = false, AFTER_DRAIN = false;
    const float* hin; float* hout; float alpha;
    __device__ __forceinline__ void operator()(const f32x4 (&acc)[2][2][4][2], const Unit& u, int wr, int wc, int fr, int fq) const {
        const int row0 = u.pm * BM + wr * 64 + fr, col0 = u.pn * BM + wc * 32 + 4 * fq;
#pragma unroll
        for (int ai = 0; ai < 2; ++ai)
#pragma unroll
            for (int m = 0; m < 4; ++m) { const size_t off = (size_t)(row0 + ai * HALF + m * 16) * 1024 + col0;
#pragma unroll
                for (int bj = 0; bj < 2; ++bj)
#pragma unroll
                    for (int n = 0; n < 2; ++n) { const f32x4 hv = *(const f32x4*)(hin + off + bj * HALF + n * 16);
                        *(f32x4*)(hout + off + bj * HALF + n * 16) = hv * alpha + acc[ai][bj][m][n]; } }
    }
};

struct EpiMoeGU {
    static constexpr bool PERM = true, AFTER_DRAIN = false;
    bf16_t* HID;
    __device__ __forceinline__ void operator()(const f32x4 (&acc)[2][2][4][2], const Unit& u, int wr, int wc, int fr, int fq) const {
        const int row0 = u.pm * BM + wr * 64 + fr, col0 = u.pn * 128 + wc * 32 + 8 * fq;
#pragma unroll
        for (int ai = 0; ai < 2; ++ai)
#pragma unroll
            for (int m = 0; m < 4; ++m) {
                f32x4 h[2];
#pragma unroll
                for (int n = 0; n < 2; ++n) { const f32x4 g = acc[ai][0][m][n], up = acc[ai][1][m][n];
#pragma unroll
                    for (int j = 0; j < 4; ++j) h[n][j] = g[j] / (1.f + __expf(-g[j])) * up[j]; }
                u32x4 w; w.x = cvt_pk_bf16(h[0][0], h[0][1]); w.y = cvt_pk_bf16(h[0][2], h[0][3]); w.z = cvt_pk_bf16(h[1][0], h[1][1]); w.w = cvt_pk_bf16(h[1][2], h[1][3]);
                *(u32x4*)(HID + (size_t)(row0 + ai * HALF + m * 16) * 256 + col0) = w;
            }
    }
};

struct EpiMoeDown {
    static constexpr bool PERM = true, AFTER_DRAIN = false;
    bf16_t* Y; const float* rowgate;
    __device__ __forceinline__ void operator()(const f32x4 (&acc)[2][2][4][2], const Unit& u, int wr, int wc, int fr, int fq) const {
        const int row0 = u.pm * BM + wr * 64 + fr, col0 = u.pn * BM + wc * 32 + 8 * fq;
#pragma unroll
        for (int ai = 0; ai < 2; ++ai)
#pragma unroll
            for (int m = 0; m < 4; ++m) { const int row = row0 + ai * HALF + m * 16; const float gt = rowgate[row]; bf16_t* rowp = Y + (size_t)row * 1024 + col0;
#pragma unroll
                for (int bj = 0; bj < 2; ++bj) { const f32x4 v0 = acc[ai][bj][m][0] * gt, v1 = acc[ai][bj][m][1] * gt;
                    u32x4 w; w.x = cvt_pk_bf16(v0[0], v0[1]); w.y = cvt_pk_bf16(v0[2], v0[3]); w.z = cvt_pk_bf16(v1[0], v1[1]); w.w = cvt_pk_bf16(v1[2], v1[3]);
                    *(u32x4*)(rowp + bj * HALF) = w; } }
    }
};

struct MoeOrder {
    const PG8_LAS int* tile_e; int ntiles, ncol, bmul, G, c;
    __device__ __forceinline__ bool next(int i, Unit& u) const {
        const int L = i * G + c; if (L >= ntiles * ncol) return false;
        const int ti = L / ncol, j = L - ti * ncol;
        u.pm = ti; u.pn = j; u.pb = __builtin_amdgcn_readfirstlane(tile_e[ti] * bmul + j); return true;
    }
    __device__ __forceinline__ void a_ready(const Unit&) const {}
    __device__ __forceinline__ void done(const Unit&) const {}
};
}

struct Params {
    const float* in[24]; float* out; unsigned char* ws;
    double invA[8]; double invC[128];
};
typedef const __attribute__((address_space(4))) Params* ParamsK;
__device__ __forceinline__ ParamsK fresh_params() { ParamsK q = (ParamsK)__builtin_amdgcn_kernarg_segment_ptr(); asm volatile("" : "+s"(q)); return q; }
struct Ctx {
    int tid, lane, wave, G, bid;
    LAS unsigned char* lds;
};
__device__ __forceinline__ Ctx make_ctx(LAS unsigned char* lds) {
    Ctx c; int tid = threadIdx.x; asm volatile("" : "+v"(tid)); int bid = blockIdx.x; asm volatile("" : "+s"(bid)); int G = gridDim.x; asm volatile("" : "+s"(G));
    asm volatile("" : "+s"(lds));
    c.tid = tid; c.lane = tid & 63; c.wave = __builtin_amdgcn_readfirstlane(tid >> 6); c.G = G; c.bid = bid; c.lds = lds; return c;
}

__device__ __forceinline__ void transpose_item(const float* W, int ldw, int k0, int n0, bf16_t* WT, int K, size_t dstrow0, LAS float* scr, int lane) {
#pragma unroll 8
    for (int i = 0; i < 32; ++i) { const int kk = 2 * i + (lane >> 5); scr[kk * 33 + (lane & 31)] = W[(size_t)(k0 + kk) * ldw + n0 + (lane & 31)]; }
    asm volatile("s_waitcnt lgkmcnt(0)" ::: "memory");
    const int c = lane & 7;
#pragma unroll
    for (int j = 0; j < 4; ++j) { const int n = (lane >> 3) + 8 * j; const LAS float* s = scr + (8 * c) * 33 + n;
        u32x4 o; o.x = pk2(s[0 * 33], s[1 * 33]); o.y = pk2(s[2 * 33], s[3 * 33]); o.z = pk2(s[4 * 33], s[5 * 33]); o.w = pk2(s[6 * 33], s[7 * 33]);
        *(u32x4*)(WT + (dstrow0 + n) * K + k0 + 8 * c) = o; }
    asm volatile("s_waitcnt lgkmcnt(0)" ::: "memory");
}
__device__ __forceinline__ void transpose_matrix(const Ctx& c, const float* W, int K, int ldw, int ncols, bf16_t* WT) {
    LAS float* scr = (LAS float*)(c.lds + c.wave * 8704);
    const int gw = c.bid * 8 + c.wave, NGW = c.G * 8, nblk = ncols / 32, items = (K / 64) * nblk;
    for (int it = gw; it < items; it += NGW) { const int kb = it / nblk, nb = it - kb * nblk; transpose_item(W, ldw, 64 * kb, 32 * nb, WT, K, (size_t)(32 * nb), scr, c.lane); }
}
__device__ __forceinline__ void convert_experts(LAS unsigned char* lds_, int layer) {
    const Ctx c = make_ctx(lds_); layer = __builtin_amdgcn_readfirstlane(layer); asm volatile("" : "+s"(layer));
    LAS float* scr = (LAS float*)(c.lds + c.wave * 8704);
    const int gw = c.bid * 8 + c.wave, NGW = c.G * 8;
    ParamsK q = fresh_params(); const float* Wg = q->in[21] + (size_t)layer * 64 * 1024 * 256; const float* Wu = q->in[22] + (size_t)layer * 64 * 1024 * 256; const float* Wd = q->in[23] + (size_t)layer * 64 * 256 * 1024;
    unsigned char* ws = q->ws;
    bf16_t* GU = (bf16_t*)(ws + OFF_WE_GU); bf16_t* D = (bf16_t*)(ws + OFF_WE_D);
    for (int it = gw; it < 64 * 384; it += NGW) {
        const int e = it / 384, r = it - e * 384;
        if (r < 256) { const int isup = r >> 7, rr = r & 127, kb = rr >> 3, nb = rr & 7, n0 = 32 * nb;
            const float* W = (isup ? Wu : Wg) + (size_t)e * 1024 * 256;
            transpose_item(W, 256, 64 * kb, n0, GU, 1024, (size_t)e * 512 + (n0 >> 7) * 256 + isup * 128 + (n0 & 127), scr, c.lane);
        } else { const int rr = r - 256, kb = rr >> 5, nb = rr & 31;
            transpose_item(Wd + (size_t)e * 256 * 1024, 1024, 64 * kb, 32 * nb, D, 256, (size_t)e * 1024 + 32 * nb, scr, c.lane); }
    }
}
__device__ __forceinline__ void rope_entry(double w, int pos, float& co, float& si) {
    const double w2 = w * w; double cs = 1.0, sn = w, tc = 1.0, ts = w;
#pragma unroll
    for (int k = 1; k <= 11; ++k) { tc = -tc * w2 / (double)((2 * k - 1) * (2 * k)); ts = -ts * w2 / (double)((2 * k) * (2 * k + 1)); cs += tc; sn += ts; }
    double rc = 1.0, rs = 0.0, bc = cs, bs = sn; unsigned pp = (unsigned)pos;
#pragma unroll 1
    for (int b = 0; b < 20; ++b) { const bool on = ((pp >> b) & 1u) != 0u; const double t = rc * bc - rs * bs, u2 = rc * bs + rs * bc; rc = on ? t : rc; rs = on ? u2 : rs; const double t2 = bc * bc - bs * bs; bs = 2.0 * bc * bs; bc = t2; }
    co = (float)rc; si = (float)rs;
}
__device__ __forceinline__ void phase_prologue(LAS unsigned char* lds_) {
    const Ctx c = make_ctx(lds_);
    unsigned char* ws = fresh_params()->ws;
    transpose_matrix(c, fresh_params()->in[6], 1024, 3072, 3072, (bf16_t*)(ws + OFF_WA_IN));
    transpose_matrix(c, fresh_params()->in[6] + (size_t)1024 * 3072, 1024, 3072, 3072, (bf16_t*)(ws + OFF_WA_IN) + (size_t)3072 * 1024);
    transpose_matrix(c, fresh_params()->in[7], 1024, 1024, 1024, (bf16_t*)(ws + OFF_WA_OUT));
    transpose_matrix(c, fresh_params()->in[7] + (size_t)1024 * 1024, 1024, 1024, 1024, (bf16_t*)(ws + OFF_WA_OUT) + (size_t)1024 * 1024);
    transpose_matrix(c, fresh_params()->in[8], 1024, 3088, 3072, (bf16_t*)(ws + OFF_WB_IN));
    transpose_matrix(c, fresh_params()->in[13], 1024, 1024, 1024, (bf16_t*)(ws + OFF_WB_OUT));
    transpose_matrix(c, fresh_params()->in[14], 1024, 6144, 6144, (bf16_t*)(ws + OFF_WC_IN));
    transpose_matrix(c, fresh_params()->in[16], 2048, 1024, 1024, (bf16_t*)(ws + OFF_WC_OUT));
    const int gt = c.bid * 512 + c.tid, NT = c.G * 512;
    { bf16_t* WR = (bf16_t*)(ws + OFF_WR);
      for (int i = gt; i < 4 * 80 * 1024; i += NT) { const int layer = i / (80 * 1024), r = i - layer * 80 * 1024, n = r >> 10, k = r & 1023;
          float w = 0.f; if (n < 8) w = fresh_params()->in[17][((size_t)layer * 1024 + k) * 8 + n]; else if (n < 72) w = fresh_params()->in[19][((size_t)layer * 1024 + k) * 64 + (n - 8)];
          const unsigned hi = f2bf(w); const float lo = w - __builtin_bit_cast(float, hi << 16);
          WR[((size_t)layer * 2 + 0) * 80 * 1024 + r] = (bf16_t)hi; WR[((size_t)layer * 2 + 1) * 80 * 1024 + r] = (bf16_t)f2bf(lo); } }
    { float* WG = (float*)(ws + OFF_WG); for (int i = gt; i < 16 * 1024; i += NT) { const int o = i >> 10, k = i & 1023; WG[i] = fresh_params()->in[8][(size_t)k * 3088 + 3072 + o]; } }
    { float* par = (float*)(ws + OFF_PAR);
      for (int i = gt; i < PAR_END; i += NT) { float v;
          if (i < PAR_LN1B) v = fresh_params()->in[2][i]; else if (i < PAR_LN2G) v = fresh_params()->in[3][i - PAR_LN1B]; else if (i < PAR_LN2B) v = fresh_params()->in[4][i - PAR_LN2G]; else if (i < PAR_GBIAS) v = fresh_params()->in[5][i - PAR_LN2B];
          else if (i < PAR_CONVW) v = fresh_params()->in[9][i - PAR_GBIAS]; else if (i < PAR_CONVB) v = fresh_params()->in[10][i - PAR_CONVW]; else if (i < PAR_BNG) v = fresh_params()->in[11][i - PAR_CONVB]; else if (i < PAR_CNG) v = fresh_params()->in[12][i - PAR_BNG];
          else if (i < PAR_RGB) v = fresh_params()->in[15][i - PAR_CNG]; else if (i < PAR_REB) v = fresh_params()->in[18][i - PAR_RGB]; else v = fresh_params()->in[20][i - PAR_REB];
          par[i] = v; } }
    { const int* pos = (const int*)fresh_params()->in[1]; float* cA = (float*)(ws + OFF_COSA); float* sA = (float*)(ws + OFF_SINA); float* cC = (float*)(ws + OFF_COSC); float* sC = (float*)(ws + OFF_SINC);
      for (int i = gt; i < SEQ * 136; i += NT) { const int s = i / 136, f = i - s * 136; float co, si;
          if (f < 8) { rope_entry(fresh_params()->invA[f], pos[s], co, si); cA[s * 8 + f] = co; sA[s * 8 + f] = si; }
          else { rope_entry(fresh_params()->invC[f - 8], pos[s], co, si); cC[s * 128 + f - 8] = co; sC[s * 128 + f - 8] = si; } } }
    { const f32x4* x4 = (const f32x4*)fresh_params()->in[0]; u32x2* hb = (u32x2*)(ws + OFF_HB);
      for (size_t i = gt; i < (size_t)NTOK * DM / 4; i += NT) { const f32x4 v = x4[i]; u32x2 w; w.x = pk2(v[0], v[1]); w.y = pk2(v[2], v[3]); hb[i] = w; } }
}

__device__ __forceinline__ void ln_apply(f32x4 (&v)[4], const f32x4 (&g)[4], const f32x4 (&b)[4]) {
    float s = 0.f;
#pragma unroll
    for (int j = 0; j < 4; ++j) s += (v[j][0] + v[j][1]) + (v[j][2] + v[j][3]);
    const float mean = wave_sum(s) * (1.f / DM); float s2 = 0.f;
#pragma unroll
    for (int j = 0; j < 4; ++j) { v[j] = v[j] - mean; s2 += (v[j][0] * v[j][0] + v[j][1] * v[j][1]) + (v[j][2] * v[j][2] + v[j][3] * v[j][3]); }
    const float rstd = 1.f / sqrtf(wave_sum(s2) * (1.f / DM) + LN_EPS);
#pragma unroll
    for (int j = 0; j < 4; ++j) v[j] = v[j] * rstd * g[j] + b[j];
}

__device__ __forceinline__ void phase_ln1_router(LAS unsigned char* lds_, int layer, bool mixed, bool do_router) {
    const Ctx c = make_ctx(lds_); layer = __builtin_amdgcn_readfirstlane(layer); asm volatile("" : "+s"(layer));
    unsigned char* ws = fresh_params()->ws;
    float* H = (float*)(ws + OFF_H); bf16_t* HB = (bf16_t*)(ws + OFF_HB);
    const float* src = mixed ? H : (layer == 0 ? fresh_params()->in[0] : H); const float scale = mixed ? 1.0f : DN_ALPHA;
    const float* par = (const float*)(ws + OFF_PAR); const float* lg = par + PAR_LN1G + layer * DM; const float* lb = par + PAR_LN1B + layer * DM;
    f32x4 g[4], b[4];
#pragma unroll
    for (int j = 0; j < 4; ++j) { g[j] = *(const f32x4*)(lg + 4 * c.lane + 256 * j); b[j] = *(const f32x4*)(lb + 4 * c.lane + 256 * j); }
    LAS int* hist = (LAS int*)(c.lds);
    LAS float* lgt = (LAS float*)(c.lds + 1024) + c.wave * (16 * 80);
    const bf16_t* WRh = (const bf16_t*)(ws + OFF_WR) + (size_t)(layer * 2 + 0) * 80 * 1024; const bf16_t* WRl = WRh + 80 * 1024;
    const int fr = c.lane & 15, fq = c.lane >> 4;
    for (int rb = c.bid; rb < NTOK / 128; rb += c.G) {
        const int row0 = rb * 128 + c.wave * 16;
        if (c.tid < 64) hist[c.tid] = 0;
        for (int r = 0; r < 16; ++r) {
            const size_t ro = (size_t)(row0 + r) * DM + 4 * c.lane; f32x4 v[4];
#pragma unroll
            for (int j = 0; j < 4; ++j) v[j] = *(const f32x4*)(src + ro + 256 * j) * scale;
            ln_apply(v, g, b);
#pragma unroll
            for (int j = 0; j < 4; ++j) { *(f32x4*)(H + ro + 256 * j) = v[j]; u32x2 w; w.x = pk2(v[j][0], v[j][1]); w.y = pk2(v[j][2], v[j][3]); *(u32x2*)(HB + ro + 256 * j) = w; }
        }
        __syncthreads();
        if (do_router) {
            f32x4 acc[5];
#pragma unroll
            for (int t = 0; t < 5; ++t) acc[t] = (f32x4){0.f, 0.f, 0.f, 0.f};
            const float* arow = H + (size_t)(row0 + fr) * DM + fq * 8;
            for (int ks = 0; ks < 32; ++ks) {
                const f32x4 a0 = *(const f32x4*)(arow + ks * 32), a1 = *(const f32x4*)(arow + ks * 32 + 4);
                bf16x8 ah, al;
#pragma unroll
                for (int j = 0; j < 4; ++j) { const unsigned h0 = f2bf(a0[j]), h1 = f2bf(a1[j]); ah[j] = (short)h0; ah[4 + j] = (short)h1;
                    al[j] = (short)f2bf(a0[j] - __builtin_bit_cast(float, h0 << 16)); al[4 + j] = (short)f2bf(a1[j] - __builtin_bit_cast(float, h1 << 16)); }
#pragma unroll
                for (int t = 0; t < 5; ++t) {
                    const bf16x8 bh = *(const bf16x8*)(WRh + (size_t)(t * 16 + fr) * 1024 + ks * 32 + fq * 8);
                    const bf16x8 bl = *(const bf16x8*)(WRl + (size_t)(t * 16 + fr) * 1024 + ks * 32 + fq * 8);
                    acc[t] = __builtin_amdgcn_mfma_f32_16x16x32_bf16(ah, bh, acc[t], 0, 0, 0);
                    acc[t] = __builtin_amdgcn_mfma_f32_16x16x32_bf16(al, bh, acc[t], 0, 0, 0);
                    acc[t] = __builtin_amdgcn_mfma_f32_16x16x32_bf16(ah, bl, acc[t], 0, 0, 0);
                }
            }
#pragma unroll
            for (int t = 0; t < 5; ++t) { const int n = t * 16 + fr; float bias = 0.f; if (n < 8) bias = par[PAR_RGB + layer * 8 + n]; else if (n < 72) bias = par[PAR_REB + layer * 64 + n - 8];
#pragma unroll
                for (int r = 0; r < 4; ++r) lgt[(4 * fq + r) * 80 + n] = acc[t][r] + bias; }
            __syncthreads();
            if (c.lane < 16) {
                const LAS float* L = lgt + c.lane * 80; const int tok = row0 + c.lane;
                int grp = 0; float gm = L[0];
#pragma unroll
                for (int i = 1; i < 8; ++i) { const float x = L[i]; if (x > gm) { gm = x; grp = i; } }
                float se = 0.f;
#pragma unroll
                for (int i = 0; i < 8; ++i) se += __expf(L[i] - gm);
                const float pg = 1.f / se;
                const LAS float* E = L + 8 + grp * 8;
                int i0 = 0; float v0 = E[0];
#pragma unroll
                for (int i = 1; i < 8; ++i) { const float x = E[i]; if (x > v0) { v0 = x; i0 = i; } }
                int i1 = -1; float v1 = -3.0e38f;
#pragma unroll
                for (int i = 0; i < 8; ++i) { const float x = E[i]; if (i != i0 && x > v1) { v1 = x; i1 = i; } }
                const float ex = __expf(v1 - v0), g0 = pg / (1.f + ex), g1 = pg * ex / (1.f + ex);
                const int e0 = grp * 8 + i0, e1 = grp * 8 + i1;
                int* EID = (int*)(ws + OFF_EID); float* GT = (float*)(ws + OFF_GATE);
                EID[tok * 2] = e0; EID[tok * 2 + 1] = e1; GT[tok * 2] = g0; GT[tok * 2 + 1] = g1;
                __hip_atomic_fetch_add(hist + e0, 1, __ATOMIC_RELAXED, __HIP_MEMORY_SCOPE_WORKGROUP);
                __hip_atomic_fetch_add(hist + e1, 1, __ATOMIC_RELAXED, __HIP_MEMORY_SCOPE_WORKGROUP);
            }
            __syncthreads();
            if (c.tid < 64) ((int*)(ws + OFF_CTL))[rb * 64 + c.tid] = hist[c.tid];
        }
        __syncthreads();
    }
}

__device__ __forceinline__ void phase_ln2(LAS unsigned char* lds_, int layer, bool last, bool with_moe, bool do_gates) {
    const Ctx c = make_ctx(lds_); layer = __builtin_amdgcn_readfirstlane(layer); asm volatile("" : "+s"(layer));
    unsigned char* ws = fresh_params()->ws;
    float* dst = last ? fresh_params()->out : (float*)(ws + OFF_H);
    const float* H = (const float*)(ws + OFF_H); bf16_t* HB = (bf16_t*)(ws + OFF_HB);
    const float* par = (const float*)(ws + OFF_PAR); const float* lg = par + PAR_LN2G + layer * DM; const float* lb = par + PAR_LN2B + layer * DM;
    f32x4 g[4], b[4];
#pragma unroll
    for (int j = 0; j < 4; ++j) { g[j] = *(const f32x4*)(lg + 4 * c.lane + 256 * j); b[j] = *(const f32x4*)(lb + 4 * c.lane + 256 * j); }
    const int* SLOT = (const int*)(ws + OFF_SLOT); const bf16_t* Y = (const bf16_t*)(ws + OFF_R + RM_YEXP);
    LAS float* wg = (LAS float*)c.lds;
    if (do_gates) { const float* WG = (const float*)(ws + OFF_WG); for (int i = c.tid; i < 16 * 1024 / 4; i += 512) ((LAS f32x4*)wg)[i] = ((const f32x4*)WG)[i]; __syncthreads(); }
    float* GATES = (float*)(ws + OFF_GATES);
    for (int row = c.bid * 8 + c.wave; row < NTOK; row += c.G * 8) {
        const size_t ro = (size_t)row * DM + 4 * c.lane; f32x4 v[4];
#pragma unroll
        for (int j = 0; j < 4; ++j) v[j] = *(const f32x4*)(H + ro + 256 * j) * DN_ALPHA;
        if (with_moe) {
            const int s0 = SLOT[row * 2], s1 = SLOT[row * 2 + 1];
            const bf16_t* y0 = Y + (size_t)s0 * DM + 4 * c.lane; const bf16_t* y1 = Y + (size_t)s1 * DM + 4 * c.lane;
#pragma unroll
            for (int j = 0; j < 4; ++j) { const u32x2 a = *(const u32x2*)(y0 + 256 * j), bb = *(const u32x2*)(y1 + 256 * j);
                v[j][0] += bflo(a.x) + bflo(bb.x); v[j][1] += bfhi(a.x) + bfhi(bb.x); v[j][2] += bflo(a.y) + bflo(bb.y); v[j][3] += bfhi(a.y) + bfhi(bb.y); }
        }
        ln_apply(v, g, b);
#pragma unroll
        for (int j = 0; j < 4; ++j) { *(f32x4*)(dst + ro + 256 * j) = v[j]; u32x2 w; w.x = pk2(v[j][0], v[j][1]); w.y = pk2(v[j][2], v[j][3]); *(u32x2*)(HB + ro + 256 * j) = w; }
        if (do_gates) {
            float mine = 0.f;
#pragma unroll
            for (int o = 0; o < 16; ++o) { float s = 0.f;
#pragma unroll
                for (int j = 0; j < 4; ++j) { const f32x4 w = *(const LAS f32x4*)(wg + o * 1024 + 4 * c.lane + 256 * j); s += (v[j][0] * w[0] + v[j][1] * w[1]) + (v[j][2] * w[2] + v[j][3] * w[3]); }
                s = wave_sum(s); if (c.lane == o) mine = s; }
            if (c.lane < 16) GATES[(size_t)row * 16 + c.lane] = mine + par[PAR_GBIAS + c.lane];
        }
    }
}

__device__ __forceinline__ void phase_moe_scan(LAS unsigned char* lds_) {
    const Ctx c = make_ctx(lds_);
    unsigned char* ws = fresh_params()->ws;
    const int* CNT = (const int*)(ws + OFF_CTL); const int* EID = (const int*)(ws + OFF_EID); const float* GT = (const float*)(ws + OFF_GATE);
    int* SLOT = (int*)(ws + OFF_SLOT); float* RG = (float*)(ws + OFF_ROWGATE);
    const bf16_t* HB = (const bf16_t*)(ws + OFF_HB); bf16_t* XB = (bf16_t*)(ws + OFF_R + RM_XB);
    LAS int* part = (LAS int*)c.lds;
    LAS int* tot = part + 1024;
    LAS int* bef = tot + 64;
    LAS int* pst = bef + 64;
    LAS int* eids = pst + 64;
    LAS int* dst = eids + 256;
    LAS int* misc = (LAS int*)(c.lds + LDS_MISC);
    { const int e = c.tid & 63, pt = c.tid >> 6; int sa = 0;
      for (int bb = pt * 32; bb < pt * 32 + 32; ++bb) sa += CNT[bb * 64 + e];
      part[pt * 64 + e] = sa; }
    __syncthreads();
    if (c.tid < 64) { int sa = 0;
#pragma unroll
        for (int pt = 0; pt < 8; ++pt) sa += part[pt * 64 + c.tid];
        tot[c.tid] = sa; }
    __syncthreads();
    if (c.tid == 0) { int pos = 0, nt = 0;
        for (int e = 0; e < 64; ++e) { pst[e] = pos; const int n = (tot[e] + 255) >> 8; for (int k = 0; k < n; ++k) misc[1 + nt++] = e; pos += n * 256; }
        misc[0] = nt; }
    __syncthreads();
    for (int rb = c.bid; rb < NTOK / 128; rb += c.G) {
        { const int e = c.tid & 63, pt = c.tid >> 6; int sb = 0;
          for (int bb = pt * 32; bb < pt * 32 + 32; ++bb) { const int v = CNT[bb * 64 + e]; if (bb < rb) sb += v; }
          part[512 + pt * 64 + e] = sb; }
        __syncthreads();
        if (c.tid < 64) { int sb = 0;
#pragma unroll
            for (int pt = 0; pt < 8; ++pt) sb += part[512 + pt * 64 + c.tid];
            bef[c.tid] = sb; }
        if (c.tid < 256) eids[c.tid] = EID[(rb * 128) * 2 + c.tid];
        __syncthreads();
        if (c.tid < 256) { const int e = eids[c.tid]; int rank = 0; for (int a = 0; a < c.tid; ++a) rank += (eids[a] == e) ? 1 : 0;
            const int d = pst[e] + bef[e] + rank; dst[c.tid] = d; SLOT[(rb * 128) * 2 + c.tid] = d; RG[d] = GT[(rb * 128) * 2 + c.tid]; }
        __syncthreads();
        for (int idx = c.tid; idx < 256 * 128; idx += 512) { const int a = idx >> 7, ch = idx & 127; const int tok = rb * 128 + (a >> 1);
            *(u32x4*)(XB + (size_t)dst[a] * DM + ch * 8) = *(const u32x4*)(HB + (size_t)tok * DM + ch * 8); }
        __syncthreads();
    }
}

__device__ __forceinline__ void phase_attn(LAS unsigned char* lds_) {
    const Ctx c = make_ctx(lds_);
    unsigned char* ws = fresh_params()->ws;
    const bf16_t* Qg = (const bf16_t*)(ws + OFF_R + RA_Q); const bf16_t* Kg = (const bf16_t*)(ws + OFF_R + RA_K); const bf16_t* Vg = (const bf16_t*)(ws + OFF_R + RA_V);
    bf16_t* OG = (bf16_t*)(ws + OFF_R + RA_OG); float* LSE = (float*)(ws + OFF_R + RA_LSE);
    LAS bf16_t* Ks = (LAS bf16_t*)c.lds; LAS bf16_t* Vs = Ks + 384 * 72;
    const int fr = c.lane & 15, fq = c.lane >> 4;
    for (int u = c.bid; u < NBATCH * 16 * 48; u += c.G) {
        const int bh = u / 48, sub = u - bh * 48, b = bh >> 4, h = bh & 15, g = sub >> 4, idx = sub & 15;
        const int dsh = 2 * g, d = 1 << dsh, nqb = 16 >> dsh, r = idx / nqb, qb = idx - r * nqb;
        const int lq0 = qb * 256, lk0 = lq0 - 128;
        const size_t tokbase = (size_t)b * SEQ;
        __syncthreads();
        for (int i = c.tid; i < 384 * 8; i += 512) { const int ri = i >> 3, ch = i & 7, l = lk0 + ri;
            if (l >= 0) { const size_t ga = (tokbase + (size_t)l * d + r) * DM + h * 64 + ch * 8;
                *(LAS u32x4*)(Ks + ri * 72 + ch * 8) = *(const u32x4*)(Kg + ga); *(LAS u32x4*)(Vs + ri * 72 + ch * 8) = *(const u32x4*)(Vg + ga); } }
        __syncthreads();
#pragma unroll 1
        for (int grp = 0; grp < 2; ++grp) {
            const int l0 = lq0 + c.wave * 32 + grp * 16;
            const size_t qtok = tokbase + (size_t)(l0 + fr) * d + r;
            const bf16x8 q0 = *(const bf16x8*)(Qg + qtok * DM + h * 64 + fq * 8), q1 = *(const bf16x8*)(Qg + qtok * DM + h * 64 + 32 + fq * 8);
            const int rb0 = l0 - 128 - lk0;
            const int jmin = (l0 - 128 < 0) ? ((128 - l0) >> 4) : 0;
            f32x4 s[9]; float mx = -3.0e38f;
#pragma unroll
            for (int jb = 0; jb < 9; ++jb) {
                if (jb >= jmin) {
                    const LAS bf16_t* kr = Ks + (rb0 + jb * 16 + fr) * 72 + fq * 8;
                    const bf16x8 k0 = *(const LAS bf16x8*)kr, k1 = *(const LAS bf16x8*)(kr + 32);
                    f32x4 a = {0.f, 0.f, 0.f, 0.f};
                    a = __builtin_amdgcn_mfma_f32_16x16x32_bf16(k0, q0, a, 0, 0, 0);
                    a = __builtin_amdgcn_mfma_f32_16x16x32_bf16(k1, q1, a, 0, 0, 0);
#pragma unroll
                    for (int rg = 0; rg < 4; ++rg) { const int rel = 128 + fr - (16 * jb + 4 * fq + rg); if (rel < 0 || rel > 128) a[rg] = -3.0e38f; mx = fmaxf(mx, a[rg]); }
                    s[jb] = a;
                } else s[jb] = (f32x4){-3.0e38f, -3.0e38f, -3.0e38f, -3.0e38f};
            }
            mx = fmaxf(mx, __shfl_xor(mx, 16)); mx = fmaxf(mx, __shfl_xor(mx, 32));
            float lsum = 0.f;
#pragma unroll
            for (int jb = 0; jb < 9; ++jb)
#pragma unroll
                for (int rg = 0; rg < 4; ++rg) { const float e = __expf(s[jb][rg] - mx); s[jb][rg] = e; lsum += e; }
            lsum += __shfl_xor(lsum, 16); lsum += __shfl_xor(lsum, 32);
            f32x4 o[4];
#pragma unroll
            for (int db = 0; db < 4; ++db) o[db] = (f32x4){0.f, 0.f, 0.f, 0.f};
            const int tq = (c.lane & 15) >> 2, tp = c.lane & 3;
#pragma unroll
            for (int i = 0; i < 5; ++i) {
                const int jA = 2 * i, jB = 2 * i + 1;
                bf16x8 pf;
                { const unsigned w0 = pk2(s[jA][0], s[jA][1]), w1 = pk2(s[jA][2], s[jA][3]); unsigned w2 = 0u, w3 = 0u;
                  if (jB < 9) { w2 = pk2(s[jB][0], s[jB][1]); w3 = pk2(s[jB][2], s[jB][3]); }
                  pf[0] = (short)(w0 & 0xffff); pf[1] = (short)(w0 >> 16); pf[2] = (short)(w1 & 0xffff); pf[3] = (short)(w1 >> 16);
                  pf[4] = (short)(w2 & 0xffff); pf[5] = (short)(w2 >> 16); pf[6] = (short)(w3 & 0xffff); pf[7] = (short)(w3 >> 16); }
                const int ja = (jA >= jmin) ? jA : 8, jbb = (jB < 9 && jB >= jmin) ? jB : 8;
                const LAS bf16_t* va = Vs + (rb0 + ja * 16 + 4 * fq + tq) * 72 + tp * 4;
                const LAS bf16_t* vb = Vs + (rb0 + jbb * 16 + 4 * fq + tq) * 72 + tp * 4;
#pragma unroll
                for (int db = 0; db < 4; ++db) {
                    const s16x4 x = __builtin_amdgcn_ds_read_tr16_b64_v4i16((LAS s16x4*)(va + db * 16));
                    const s16x4 y = __builtin_amdgcn_ds_read_tr16_b64_v4i16((LAS s16x4*)(vb + db * 16));
                    bf16x8 vf; vf[0] = x[0]; vf[1] = x[1]; vf[2] = x[2]; vf[3] = x[3]; vf[4] = y[0]; vf[5] = y[1]; vf[6] = y[2]; vf[7] = y[3];
                    o[db] = __builtin_amdgcn_mfma_f32_16x16x32_bf16(vf, pf, o[db], 0, 0, 0);
                }
            }
            const float inv = 1.f / lsum;
            bf16_t* op = OG + (size_t)g * NTOK * DM + qtok * DM + h * 64 + 4 * fq;
#pragma unroll
            for (int db = 0; db < 4; ++db) { u32x2 w; w.x = pk2(o[db][0] * inv, o[db][1] * inv); w.y = pk2(o[db][2] * inv, o[db][3] * inv); *(u32x2*)(op + db * 16) = w; }
            if (fq == 0) LSE[(size_t)g * NTOK * 16 + qtok * 16 + h] = mx + __logf(lsum);
        }
    }
}
__device__ __forceinline__ void phase_attn_combine(LAS unsigned char* lds_) {
    const Ctx c = make_ctx(lds_);
    unsigned char* ws = fresh_params()->ws;
    const bf16_t* OG = (const bf16_t*)(ws + OFF_R + RA_OG); const float* LSE = (const float*)(ws + OFF_R + RA_LSE); bf16_t* O = (bf16_t*)(ws + OFF_R + RA_Q);
    for (int row = c.bid * 8 + c.wave; row < NTOK; row += c.G * 8) {
        const int h = c.lane >> 2;
        const float l0 = LSE[(size_t)row * 16 + h], l1 = LSE[(size_t)NTOK * 16 + (size_t)row * 16 + h], l2 = LSE[(size_t)2 * NTOK * 16 + (size_t)row * 16 + h];
        const float m = fmaxf(l0, fmaxf(l1, l2)); float w0 = __expf(l0 - m), w1 = __expf(l1 - m), w2 = __expf(l2 - m); const float iv = 1.f / (w0 + w1 + w2); w0 *= iv; w1 *= iv; w2 *= iv;
        const size_t off = (size_t)row * DM + c.lane * 16;
#pragma unroll
        for (int hf = 0; hf < 2; ++hf) {
            const u32x4 a = *(const u32x4*)(OG + off + hf * 8), bq = *(const u32x4*)(OG + (size_t)NTOK * DM + off + hf * 8), cq = *(const u32x4*)(OG + (size_t)2 * NTOK * DM + off + hf * 8);
            u32x4 o;
#pragma unroll
            for (int k = 0; k < 4; ++k) { const float lo = w0 * bflo(a[k]) + w1 * bflo(bq[k]) + w2 * bflo(cq[k]), hi = w0 * bfhi(a[k]) + w1 * bfhi(bq[k]) + w2 * bfhi(cq[k]); o[k] = pk2(lo, hi); }
            *(u32x4*)(O + off + hf * 8) = o;
        }
    }
}

template <int DK, int DVS, bool ML> struct ScanLds {
    static constexpr int QS = 0, QROW = DK + 8;
    static constexpr int KS = QS + 64 * QROW * 2;
    static constexpr int KZT = KS + 64 * QROW * 2;
    static constexpr int VT = KZT + DK * 72 * 2;
    static constexpr int PS = VT + DVS * 72 * 2;
    static constexpr int RBT = PS + 64 * 72 * 2;
    static constexpr int SC = RBT + DVS * QROW * 2;
    static constexpr int OS = ML ? SC + 2048 : KS;
    static constexpr int END = ML ? OS + 64 * DVS * 4 : SC + 2048;
};
template <int DK, int DVS, bool ML>
__device__ __forceinline__ void phase_scan(LAS unsigned char* lds_) {
    const Ctx c = make_ctx(lds_);
    typedef ScanLds<DK, DVS, ML> L; static_assert(L::END <= LDS_BYTES, "scan LDS");
    constexpr int QROW = L::QROW, NCJ = DVS / 16, NRI = DK / 16, DVR = ML ? 32 : 64, NSL = ML ? 4 : 8, NH = ML ? 8 : 4;
    unsigned char* ws = fresh_params()->ws;
    LAS bf16_t* Qs = (LAS bf16_t*)(c.lds + L::QS); LAS bf16_t* Ksh = (LAS bf16_t*)(c.lds + L::KS); LAS bf16_t* Kzt = (LAS bf16_t*)(c.lds + L::KZT);
    LAS bf16_t* Vt = (LAS bf16_t*)(c.lds + L::VT); LAS bf16_t* Ps = (LAS bf16_t*)(c.lds + L::PS); LAS bf16_t* Rbt = (LAS bf16_t*)(c.lds + L::RBT);
    LAS float* sc = (LAS float*)(c.lds + L::SC); LAS float* Os = (LAS float*)(c.lds + L::OS);
    LAS float* cu = sc, *rb = sc + 64, *xi = sc + 128, *zeta = sc + 192, *em = sc + 256, *chi = sc + 320;
    const int fr = c.lane & 15, fq = c.lane >> 4, w = c.wave;
    for (int u = c.bid; u < NBATCH * NH * NSL; u += c.G) {
        const int b = u / (NH * NSL), h = (u / NSL) % NH, sl = u % NSL;
        __syncthreads();
        for (int i = c.tid; i < DVS * QROW / 2; i += 512) ((LAS unsigned*)Rbt)[i] = 0u;
        if (ML) { for (int i = c.tid; i < 16 * 72; i += 512) { const int rr = i / 72; Vt[(32 + rr) * 72 + (i - rr * 72)] = (rr == 0) ? (bf16_t)0x3F80 : (bf16_t)0; } }
        else if (c.tid < 64) { const float lgm = __logf(1.f - exp2f(-5.f - (float)h)); const int s = c.tid;
            cu[s] = -(float)s * lgm; rb[s] = -(float)s * lgm; xi[s] = __expf((float)(s + 1) * lgm); zeta[s] = __expf((float)(63 - s) * lgm); if (s == 0) chi[0] = __expf(64.f * lgm); }
        __syncthreads();
        f32x4 accR[(NRI >= 8 ? NRI / 8 : 1)][NCJ];
#pragma unroll
        for (int a = 0; a < (NRI >= 8 ? NRI / 8 : 1); ++a)
#pragma unroll
            for (int q = 0; q < NCJ; ++q) accR[a][q] = (f32x4){0.f, 0.f, 0.f, 0.f};
        float mprev = 0.f;
        for (int ch = 0; ch < 64; ++ch) {
            const size_t tok0 = (size_t)b * SEQ + (size_t)ch * 64;
            if (ML) {
                if (w == 0) {
                    const float* G = (const float*)(ws + OFF_GATES) + (tok0 + c.lane) * 16;
                    const float ig = G[h], fg = G[8 + h];
                    const float lf = fminf(fg, 0.f) - log1pf(__expf(-fabsf(fg)));
                    float a = lf;
#pragma unroll
                    for (int o = 1; o < 64; o <<= 1) { const float t = __shfl_up(a, o); if (c.lane >= o) a += t; }
                    const float uu = ig - a; float bm = uu;
#pragma unroll
                    for (int o = 1; o < 64; o <<= 1) { const float t = __shfl_up(bm, o); if (c.lane >= o) bm = fmaxf(bm, t); }
                    const float bt = fmaxf(mprev, bm), b63 = __shfl(bt, 63), a63 = __shfl(a, 63);
                    cu[c.lane] = uu; rb[c.lane] = bt; xi[c.lane] = __expf(mprev - bt); zeta[c.lane] = __expf(uu - b63); em[c.lane] = __expf(-(a + bt));
                    if (c.lane == 0) chi[0] = __expf(mprev - b63);
                    mprev = a63 + b63;
                }
                __syncthreads();
            }
            if (ML) {
                const bf16_t* PR = (const bf16_t*)(ws + OFF_R + RB_PROJ);
                const float* cw = (const float*)(ws + OFF_PAR) + PAR_CONVW; const float* cb = (const float*)(ws + OFF_PAR) + PAR_CONVB;
                for (int i = c.tid; i < 2 * 64 * 8; i += 512) {
                    const int isk = i >> 9, row = (i >> 3) & 63, cc = i & 7, ch0 = isk * 512 + h * 64 + cc * 8, spos = ch * 64 + row;
                    float y[8];
#pragma unroll
                    for (int e = 0; e < 8; ++e) y[e] = cb[ch0 + e];
#pragma unroll
                    for (int j = 0; j < 4; ++j) { if (spos - 3 + j >= 0) { const u32x4 x = *(const u32x4*)(PR + (tok0 + row - 3 + j) * 3072 + ch0);
                        const f32x4 w0 = *(const f32x4*)(cw + j * 1024 + ch0), w1 = *(const f32x4*)(cw + j * 1024 + ch0 + 4);
                        y[0] += w0[0] * bflo(x[0]); y[1] += w0[1] * bfhi(x[0]); y[2] += w0[2] * bflo(x[1]); y[3] += w0[3] * bfhi(x[1]);
                        y[4] += w1[0] * bflo(x[2]); y[5] += w1[1] * bfhi(x[2]); y[6] += w1[2] * bflo(x[3]); y[7] += w1[3] * bfhi(x[3]); } }
                    const float ksc = isk ? 0.125f : 1.f;
#pragma unroll
                    for (int e = 0; e < 8; ++e) y[e] = silu_f(y[e]) * ksc;
                    u32x4 o; o[0] = pk2(y[0], y[1]); o[1] = pk2(y[2], y[3]); o[2] = pk2(y[4], y[5]); o[3] = pk2(y[6], y[7]);
                    if (!isk) *(LAS u32x4*)(Qs + row * QROW + cc * 8) = o;
                    else { *(LAS u32x4*)(Ksh + row * QROW + cc * 8) = o; const float z = zeta[row];
#pragma unroll
                        for (int e = 0; e < 8; ++e) Kzt[(cc * 8 + e) * 72 + row] = (bf16_t)f2bf(y[e] * z); }
                }
                for (int i = c.tid; i < 64 * 4; i += 512) { const int row = i >> 2, cc = i & 3;
                    const u32x4 x = *(const u32x4*)(PR + (tok0 + row) * 3072 + 1024 + h * 128 + sl * 32 + cc * 8);
#pragma unroll
                    for (int e = 0; e < 4; ++e) { Vt[(cc * 8 + 2 * e) * 72 + row] = (bf16_t)(x[e] & 0xffff); Vt[(cc * 8 + 2 * e + 1) * 72 + row] = (bf16_t)(x[e] >> 16); } }
            } else {
                const bf16_t* Qg = (const bf16_t*)(ws + OFF_R + RC_Q); const bf16_t* Kg = (const bf16_t*)(ws + OFF_R + RC_K); const bf16_t* Vg = (const bf16_t*)(ws + OFF_R + RC_V);
                for (int i = c.tid; i < 64 * (DK / 8); i += 512) { const int row = i / (DK / 8), cc = i - row * (DK / 8);
                    *(LAS u32x4*)(Qs + row * QROW + cc * 8) = *(const u32x4*)(Qg + (tok0 + row) * DM + h * DK + cc * 8);
                    const u32x4 x = *(const u32x4*)(Kg + (tok0 + row) * DM + h * DK + cc * 8);
                    *(LAS u32x4*)(Ksh + row * QROW + cc * 8) = x; const float z = zeta[row];
#pragma unroll
                    for (int e = 0; e < 4; ++e) { Kzt[(cc * 8 + 2 * e) * 72 + row] = (bf16_t)f2bf(bflo(x[e]) * z); Kzt[(cc * 8 + 2 * e + 1) * 72 + row] = (bf16_t)f2bf(bfhi(x[e]) * z); } }
                for (int i = c.tid; i < 64 * 8; i += 512) { const int row = i >> 3, cc = i & 7;
                    const u32x4 x = *(const u32x4*)(Vg + (tok0 + row) * 2048 + h * 512 + sl * 64 + cc * 8);
#pragma unroll
                    for (int e = 0; e < 4; ++e) { Vt[(cc * 8 + 2 * e) * 72 + row] = (bf16_t)(x[e] & 0xffff); Vt[(cc * 8 + 2 * e + 1) * 72 + row] = (bf16_t)(x[e] >> 16); } }
            }
            __syncthreads();
            { const int ti = w >> 1, tj0 = (w & 1) * 2;
              f32x4 a0 = {0.f, 0.f, 0.f, 0.f}, a1 = {0.f, 0.f, 0.f, 0.f};
              if (tj0 <= ti) {
#pragma unroll
                  for (int ks = 0; ks < DK / 32; ++ks) { const bf16x8 qa = *(const LAS bf16x8*)(Qs + (16 * ti + fr) * QROW + ks * 32 + fq * 8);
                      const bf16x8 k0 = *(const LAS bf16x8*)(Ksh + (16 * tj0 + fr) * QROW + ks * 32 + fq * 8), k1 = *(const LAS bf16x8*)(Ksh + (16 * tj0 + 16 + fr) * QROW + ks * 32 + fq * 8);
                      a0 = __builtin_amdgcn_mfma_f32_16x16x32_bf16(qa, k0, a0, 0, 0, 0); a1 = __builtin_amdgcn_mfma_f32_16x16x32_bf16(qa, k1, a1, 0, 0, 0); } }
              const float cu0 = cu[16 * tj0 + fr], cu1 = cu[16 * tj0 + 16 + fr];
#pragma unroll
              for (int rg = 0; rg < 4; ++rg) { const int t = 16 * ti + 4 * fq + rg, s0 = 16 * tj0 + fr, s1 = s0 + 16; const float rt = rb[t];
                  Ps[t * 72 + s0] = (bf16_t)f2bf(s0 <= t ? a0[rg] * __expf(cu0 - rt) : 0.f);
                  Ps[t * 72 + s1] = (bf16_t)f2bf(s1 <= t ? a1[rg] * __expf(cu1 - rt) : 0.f); } }
            __syncthreads();
            { const int ti = w >> 1, c0 = (w & 1) ? (NCJ + 1) / 2 : 0, c1 = (w & 1) ? NCJ : (NCJ + 1) / 2;
              const bf16x8 pa0 = *(const LAS bf16x8*)(Ps + (16 * ti + fr) * 72 + fq * 8), pa1 = *(const LAS bf16x8*)(Ps + (16 * ti + fr) * 72 + 32 + fq * 8);
#pragma unroll
              for (int cj = 0; cj < NCJ; ++cj) { if (cj >= c0 && cj < c1) {
                  f32x4 o1 = {0.f, 0.f, 0.f, 0.f}, o2 = {0.f, 0.f, 0.f, 0.f};
                  o1 = __builtin_amdgcn_mfma_f32_16x16x32_bf16(pa0, *(const LAS bf16x8*)(Vt + (16 * cj + fr) * 72 + fq * 8), o1, 0, 0, 0);
                  o1 = __builtin_amdgcn_mfma_f32_16x16x32_bf16(pa1, *(const LAS bf16x8*)(Vt + (16 * cj + fr) * 72 + 32 + fq * 8), o1, 0, 0, 0);
#pragma unroll
                  for (int ks = 0; ks < DK / 32; ++ks)
                      o2 = __builtin_amdgcn_mfma_f32_16x16x32_bf16(*(const LAS bf16x8*)(Qs + (16 * ti + fr) * QROW + ks * 32 + fq * 8), *(const LAS bf16x8*)(Rbt + (16 * cj + fr) * QROW + ks * 32 + fq * 8), o2, 0, 0, 0);
#pragma unroll
                  for (int rg = 0; rg < 4; ++rg) { const int t = 16 * ti + 4 * fq + rg; Os[t * DVS + 16 * cj + fr] = o1[rg] + xi[t] * o2[rg]; } } } }
            __syncthreads();
            { const float cx = chi[0];
              if (NRI >= 8 || w < NRI) {
#pragma unroll
                  for (int a = 0; a < (NRI >= 8 ? NRI / 8 : 1); ++a) { const int ri = (NRI >= 8) ? w * (NRI / 8) + a : w;
                      const bf16x8 ka0 = *(const LAS bf16x8*)(Kzt + (16 * ri + fr) * 72 + fq * 8), ka1 = *(const LAS bf16x8*)(Kzt + (16 * ri + fr) * 72 + 32 + fq * 8);
#pragma unroll
                      for (int cj = 0; cj < NCJ; ++cj) { f32x4 r4 = accR[a][cj] * cx;
                          r4 = __builtin_amdgcn_mfma_f32_16x16x32_bf16(ka0, *(const LAS bf16x8*)(Vt + (16 * cj + fr) * 72 + fq * 8), r4, 0, 0, 0);
                          r4 = __builtin_amdgcn_mfma_f32_16x16x32_bf16(ka1, *(const LAS bf16x8*)(Vt + (16 * cj + fr) * 72 + 32 + fq * 8), r4, 0, 0, 0);
                          accR[a][cj] = r4;
                          u32x2 wv; wv.x = pk2(r4[0], r4[1]); wv.y = pk2(r4[2], r4[3]); *(LAS u32x2*)(Rbt + (16 * cj + fr) * QROW + 16 * ri + 4 * fq) = wv; } } }
              if (ML) { bf16_t* OR = (bf16_t*)(ws + OFF_R + RB_ORAW);
                  const int t = c.tid >> 3, c4 = (c.tid & 7) * 4; const float den = Os[t * DVS + 32], dn = 1.f / fmaxf(fabsf(den), em[t]);
                  const f32x4 x = *(const LAS f32x4*)(Os + t * DVS + c4); u32x2 wv; wv.x = pk2(x[0] * dn, x[1] * dn); wv.y = pk2(x[2] * dn, x[3] * dn);
                  *(u32x2*)(OR + (tok0 + t) * DM + h * 128 + sl * 32 + c4) = wv;
              } else { bf16_t* OR = (bf16_t*)(ws + OFF_R + RC_ORAW);
                  const int t = c.tid >> 3, c8 = (c.tid & 7) * 8; const f32x4 x0 = *(const LAS f32x4*)(Os + t * DVS + c8), x1 = *(const LAS f32x4*)(Os + t * DVS + c8 + 4);
                  u32x4 wv; wv[0] = pk2(x0[0], x0[1]); wv[1] = pk2(x0[2], x0[3]); wv[2] = pk2(x1[0], x1[1]); wv[3] = pk2(x1[2], x1[3]);
                  *(u32x4*)(OR + (tok0 + t) * 2048 + h * 512 + sl * 64 + c8) = wv; } }
            __syncthreads();
        }
    }
}

__device__ __forceinline__ void phase_norm_b(LAS unsigned char* lds_) {
    const Ctx c = make_ctx(lds_);
    unsigned char* ws = fresh_params()->ws;
    const bf16_t* OR = (const bf16_t*)(ws + OFF_R + RB_ORAW); const bf16_t* PR = (const bf16_t*)(ws + OFF_R + RB_PROJ); bf16_t* ON = (bf16_t*)(ws + OFF_R + RB_ONORM);
    const float* ng = (const float*)(ws + OFF_PAR) + PAR_BNG;
    float gv[16];
#pragma unroll
    for (int k = 0; k < 16; ++k) gv[k] = ng[c.lane * 16 + k];
    for (int row = c.bid * 8 + c.wave; row < NTOK; row += c.G * 8) {
        float x[16], gt[16];
#pragma unroll
        for (int hf = 0; hf < 2; ++hf) { const u32x4 a = *(const u32x4*)(OR + (size_t)row * DM + c.lane * 16 + hf * 8), gq = *(const u32x4*)(PR + (size_t)row * 3072 + 2048 + c.lane * 16 + hf * 8);
#pragma unroll
            for (int k = 0; k < 4; ++k) { x[hf * 8 + 2 * k] = bflo(a[k]); x[hf * 8 + 2 * k + 1] = bfhi(a[k]); gt[hf * 8 + 2 * k] = bflo(gq[k]); gt[hf * 8 + 2 * k + 1] = bfhi(gq[k]); } }
        float s = 0.f;
#pragma unroll
        for (int k = 0; k < 16; ++k) s += x[k];
        s += __shfl_xor(s, 1); s += __shfl_xor(s, 2); s += __shfl_xor(s, 4);
        const float mu = s * (1.f / 128.f); float q = 0.f;
#pragma unroll
        for (int k = 0; k < 16; ++k) { x[k] -= mu; q += x[k] * x[k]; }
        q += __shfl_xor(q, 1); q += __shfl_xor(q, 2); q += __shfl_xor(q, 4);
        const float rstd = 1.f / sqrtf(q * (1.f / 128.f) + LN_EPS);
        u32x4 o0, o1;
#pragma unroll
        for (int k = 0; k < 4; ++k) { o0[k] = pk2(x[2 * k] * rstd * gv[2 * k] * sigmoid_f(gt[2 * k]), x[2 * k + 1] * rstd * gv[2 * k + 1] * sigmoid_f(gt[2 * k + 1]));
            o1[k] = pk2(x[8 + 2 * k] * rstd * gv[8 + 2 * k] * sigmoid_f(gt[8 + 2 * k]), x[9 + 2 * k] * rstd * gv[9 + 2 * k] * sigmoid_f(gt[9 + 2 * k])); }
        *(u32x4*)(ON + (size_t)row * DM + c.lane * 16) = o0; *(u32x4*)(ON + (size_t)row * DM + c.lane * 16 + 8) = o1;
    }
}
__device__ __forceinline__ void phase_norm_c(LAS unsigned char* lds_) {
    const Ctx c = make_ctx(lds_);
    unsigned char* ws = fresh_params()->ws;
    const bf16_t* OR = (const bf16_t*)(ws + OFF_R + RC_ORAW); const bf16_t* GG = (const bf16_t*)(ws + OFF_R + RC_G); bf16_t* ON = (bf16_t*)(ws + OFF_R + RC_V);
    const float* ng = (const float*)(ws + OFF_PAR) + PAR_CNG;
    for (int row = c.bid * 8 + c.wave; row < NTOK; row += c.G * 8) {
        float x[32];
#pragma unroll
        for (int qd = 0; qd < 4; ++qd) { const u32x4 a = *(const u32x4*)(OR + (size_t)row * 2048 + c.lane * 32 + qd * 8);
#pragma unroll
            for (int k = 0; k < 4; ++k) { x[qd * 8 + 2 * k] = bflo(a[k]); x[qd * 8 + 2 * k + 1] = bfhi(a[k]); } }
        float s = 0.f;
#pragma unroll
        for (int k = 0; k < 32; ++k) s += x[k];
        s += __shfl_xor(s, 1); s += __shfl_xor(s, 2); s += __shfl_xor(s, 4); s += __shfl_xor(s, 8);
        const float mu = s * (1.f / 512.f); float q = 0.f;
#pragma unroll
        for (int k = 0; k < 32; ++k) { x[k] -= mu; q += x[k] * x[k]; }
        q += __shfl_xor(q, 1); q += __shfl_xor(q, 2); q += __shfl_xor(q, 4); q += __shfl_xor(q, 8);
        const float rstd = 1.f / sqrtf(q * (1.f / 512.f) + LN_EPS);
#pragma unroll
        for (int qd = 0; qd < 4; ++qd) { const u32x4 gq = *(const u32x4*)(GG + (size_t)row * 2048 + c.lane * 32 + qd * 8);
            const f32x4 g0 = *(const f32x4*)(ng + c.lane * 32 + qd * 8), g1 = *(const f32x4*)(ng + c.lane * 32 + qd * 8 + 4);
            u32x4 o;
#pragma unroll
            for (int k = 0; k < 4; ++k) { const float ga = (k < 2) ? g0[2 * k] : g1[2 * k - 4], gb = (k < 2) ? g0[2 * k + 1] : g1[2 * k - 3];
                o[k] = pk2(x[qd * 8 + 2 * k] * rstd * ga * silu_f(bflo(gq[k])), x[qd * 8 + 2 * k + 1] * rstd * gb * silu_f(bfhi(gq[k]))); }
            *(u32x4*)(ON + (size_t)row * 2048 + c.lane * 32 + qd * 8) = o; }
    }
}

#define WS_FRESH() unsigned char* ws = fresh_params()->ws
__device__ __forceinline__ void gemm_qkv_a(LAS unsigned char* lds_, int jj) { const Ctx c = make_ctx(lds_); jj = __builtin_amdgcn_readfirstlane(jj); asm volatile("" : "+s"(jj)); WS_FRESH();
    pg8::Gemm g{(const pg8::bf16_t*)(ws + OFF_HB), (const pg8::bf16_t*)(ws + OFF_WA_IN) + (size_t)jj * 3072 * 1024, NTOK, 3072, 1024}; pg8::StaticOrder S; S.init(NTOK, 3072, c.G, c.bid);
    pg8::EpiQkvA E{(bf16_t*)(ws + OFF_R + RA_Q), SZ_TOK1K / 2, (const float*)(ws + OFF_COSA), (const float*)(ws + OFF_SINA)};
    pg8::gemm_phase<pg8::EpiQkvA, pg8::StaticOrder, true, true>(c.lds, g, S, E, c.tid); }
__device__ __forceinline__ void gemm_proj_b(LAS unsigned char* lds_) { const Ctx c = make_ctx(lds_); WS_FRESH();
    pg8::Gemm g{(const pg8::bf16_t*)(ws + OFF_HB), (const pg8::bf16_t*)(ws + OFF_WB_IN), NTOK, 3072, 1024}; pg8::StaticOrder S; S.init(NTOK, 3072, c.G, c.bid);
    pg8::EpiBf16Plain E{(bf16_t*)(ws + OFF_R + RB_PROJ), 3072};
    pg8::gemm_phase<pg8::EpiBf16Plain, pg8::StaticOrder, true, true>(c.lds, g, S, E, c.tid); }
__device__ __forceinline__ void gemm_proj_c(LAS unsigned char* lds_) { const Ctx c = make_ctx(lds_); WS_FRESH();
    pg8::Gemm g{(const pg8::bf16_t*)(ws + OFF_HB), (const pg8::bf16_t*)(ws + OFF_WC_IN), NTOK, 6144, 1024}; pg8::StaticOrder S; S.init(NTOK, 6144, c.G, c.bid);
    pg8::EpiProjC E{(bf16_t*)(ws + OFF_R + RC_Q), (bf16_t*)(ws + OFF_R + RC_V), (RC_K - RC_Q) / 2, (RC_G - RC_V) / 2, (const float*)(ws + OFF_COSC), (const float*)(ws + OFF_SINC)};
    pg8::gemm_phase<pg8::EpiProjC, pg8::StaticOrder, true, true>(c.lds, g, S, E, c.tid); }
__device__ __forceinline__ void gemm_out(LAS unsigned char* lds_, int kind, int jj, bool first) { const Ctx c = make_ctx(lds_); kind = __builtin_amdgcn_readfirstlane(kind); asm volatile("" : "+s"(kind)); jj = __builtin_amdgcn_readfirstlane(jj); asm volatile("" : "+s"(jj)); WS_FRESH();
    const size_t aoff = OFF_R + (kind == 0 ? RA_Q : (kind == 1 ? RB_ONORM : RC_V));
    const size_t boff = kind == 0 ? OFF_WA_OUT + (size_t)jj * 1024 * 1024 * 2 : (kind == 1 ? OFF_WB_OUT : OFF_WC_OUT);
    pg8::Gemm g{(const pg8::bf16_t*)(ws + aoff), (const pg8::bf16_t*)(ws + boff), NTOK, 1024, kind == 2 ? 2048 : 1024}; pg8::StaticOrder S; S.init(NTOK, 1024, c.G, c.bid);
    pg8::EpiResidual E{first ? fresh_params()->in[0] : (const float*)(ws + OFF_H), (float*)(ws + OFF_H), DN_ALPHA};
    pg8::gemm_phase<pg8::EpiResidual, pg8::StaticOrder, true, true>(c.lds, g, S, E, c.tid); }
__device__ __forceinline__ void gemm_moe_gu(LAS unsigned char* lds_) { const Ctx c = make_ctx(lds_); WS_FRESH();
    const LAS int* misc = (const LAS int*)(c.lds + LDS_MISC); const int ntiles = __builtin_amdgcn_readfirstlane(misc[0]);
    pg8::Gemm g{(const pg8::bf16_t*)(ws + OFF_R + RM_XB), (const pg8::bf16_t*)(ws + OFF_WE_GU), 0, 0, 1024};
    pg8::MoeOrder S{misc + 1, ntiles, 2, 2, c.G, c.bid}; pg8::EpiMoeGU E{(bf16_t*)(ws + OFF_R + RM_HID)};
    pg8::gemm_phase<pg8::EpiMoeGU, pg8::MoeOrder, true, true>(c.lds, g, S, E, c.tid); }
__device__ __forceinline__ void gemm_moe_down(LAS unsigned char* lds_) { const Ctx c = make_ctx(lds_); WS_FRESH();
    const LAS int* misc = (const LAS int*)(c.lds + LDS_MISC); const int ntiles = __builtin_amdgcn_readfirstlane(misc[0]);
    pg8::Gemm g{(const pg8::bf16_t*)(ws + OFF_R + RM_HID), (const pg8::bf16_t*)(ws + OFF_WE_D), 0, 0, 256};
    pg8::MoeOrder S{misc + 1, ntiles, 4, 4, c.G, c.bid}; pg8::EpiMoeDown E{(bf16_t*)(ws + OFF_R + RM_YEXP), (const float*)(ws + OFF_ROWGATE)};
    pg8::gemm_phase<pg8::EpiMoeDown, pg8::MoeOrder, true, true>(c.lds, g, S, E, c.tid); }


#define XB_TMO      128
#define XB_XCNT(j)  (256  + 64 * (j))
#define XB_XSUB(j)  (1280 + 64 * (j))
#define XB_XGEN(j)  (2304 + 64 * (j))
#define XB_TOP      3328
#define XB_TOPGEN   3392
#define XCD_BAR_WORDS 3456
#define XB_SPIN_CAP (1u << 22)
__device__ __forceinline__ unsigned xb_ld(unsigned* p)              { return __hip_atomic_load(p, __ATOMIC_RELAXED, __HIP_MEMORY_SCOPE_AGENT); }
__device__ __forceinline__ unsigned xb_add(unsigned* p, unsigned v) { return __hip_atomic_fetch_add(p, v, __ATOMIC_RELAXED, __HIP_MEMORY_SCOPE_AGENT); }
__device__ __forceinline__ unsigned xb_xcc_id() { return (unsigned)__builtin_amdgcn_s_getreg((3 << 11) | 20) & 0xFu; }
#define XB_SPIN(cond, bar) do { unsigned _sp = 0; while (cond) { __builtin_amdgcn_s_sleep(1); \
    if ((++_sp & 255u) == 0u) { if (xb_ld(&(bar)[XB_TMO])) break; if (_sp > XB_SPIN_CAP) { atomicAdd(&(bar)[XB_TMO], 1u); break; } } } } while (0)
__device__ __forceinline__ void xcd_barrier_post(LAS unsigned char* lds) {
    unsigned* bar = (unsigned*)(fresh_params()->ws + OFF_BAR);
    if (threadIdx.x == 0) { volatile LAS unsigned* st = (volatile LAS unsigned*)(lds + LDS_BAR); st[0] = 0u; st[1] = 0u; (void)xb_add(&bar[XB_XCNT(xb_xcc_id())], 1u); }
    __syncthreads();
}
__device__ __forceinline__ void xcd_barrier_complete(unsigned* bar, unsigned x, unsigned& nloc, unsigned& nx) {
    const unsigned G = gridDim.x * gridDim.y * gridDim.z;
    unsigned sum, cnt, mine, sp = 0u;
    for (;;) {
        sum = 0u; cnt = 0u; mine = 0u;
#pragma unroll
        for (unsigned j = 0; j < 16; ++j) { const unsigned c = xb_ld(&bar[XB_XCNT(j)]); sum += c; cnt += (c > 0u) ? 1u : 0u; mine = (j == x) ? c : mine; }
        if (sum == G) break;
        __builtin_amdgcn_s_sleep(1);
        if ((++sp & 255u) == 0u) { if (xb_ld(&bar[XB_TMO])) break; if (sp > XB_SPIN_CAP) { atomicAdd(&bar[XB_TMO], 1u); break; } }
    }
    nloc = mine > 0u ? mine : 1u; nx = cnt > 0u ? cnt : 1u;
}
__device__ __forceinline__ void xcd_barrier(LAS unsigned char* lds) {
    unsigned* bar = (unsigned*)(fresh_params()->ws + OFF_BAR);
    asm volatile("s_waitcnt vmcnt(0)" ::: "memory");
    __syncthreads();
    if (threadIdx.x == 0) {
        const unsigned x = xb_xcc_id(); volatile LAS unsigned* st = (volatile LAS unsigned*)(lds + LDS_BAR);
        __builtin_amdgcn_s_waitcnt(0);
        unsigned nloc = st[0], nx = st[1];
        if (nloc == 0u) { xcd_barrier_complete(bar, x, nloc, nx); st[0] = nloc; st[1] = nx; }
        const unsigned old = xb_add(&bar[XB_XSUB(x)], 1u);
        const unsigned gen = old / nloc;
        if (old + 1u == (gen + 1u) * nloc) {
            __builtin_amdgcn_fence(__ATOMIC_RELEASE, "agent");
            asm volatile("s_waitcnt vmcnt(0)" ::: "memory");
            const unsigned og = xb_add(&bar[XB_TOP], 1u);
            const unsigned tg = og / nx;
            if (og + 1u == (tg + 1u) * nx) xb_add(&bar[XB_TOPGEN], 1u);
            else XB_SPIN(xb_ld(&bar[XB_TOPGEN]) == tg, bar);
            __builtin_amdgcn_fence(__ATOMIC_ACQUIRE, "agent");
            xb_add(&bar[XB_XGEN(x)], 1u);
            asm volatile("s_waitcnt vmcnt(0)" ::: "memory");
        } else {
            XB_SPIN(xb_ld(&bar[XB_XGEN(x)]) == gen, bar);
            __builtin_amdgcn_fence(__ATOMIC_ACQUIRE, "agent");
            asm volatile("s_waitcnt vmcnt(0)" ::: "memory");
        }
    }
    __syncthreads();
}
#ifdef USE_CG_SYNC
#define GRID_SYNC() grid.sync()
#else
#define GRID_SYNC() xcd_barrier(lds)
#endif

#ifdef DBL_SYNC
#define STAMP(type) GRID_SYNC()
#elif defined(PROBE_A)
#define STAMP(type) do { if (blockIdx.x == 0 && threadIdx.x == 0) { const unsigned long long t_ = __builtin_amdgcn_s_memrealtime(); unsigned long long* TS_ = (unsigned long long*)(fresh_params()->ws + OFF_CTL + 131072); TS_[32 + (type)] += t_ - TS_[0]; TS_[0] = t_; } } while (0)
#else
#define STAMP(type) do { } while (0)
#endif
__global__ void __launch_bounds__(512, 2) fwd_megakernel(Params p) {
    extern __shared__ __attribute__((aligned(16))) unsigned char lds_raw[];
    cg::grid_group grid = cg::this_grid();
    LAS unsigned char* lds = (LAS unsigned char*)lds_raw;
#ifdef PROBE_A
    if (blockIdx.x == 0 && threadIdx.x == 0) { unsigned long long* TS_ = (unsigned long long*)(fresh_params()->ws + OFF_CTL + 131072); for (int i = 0; i < 32; ++i) TS_[32 + i] = 0ull; TS_[0] = __builtin_amdgcn_s_memrealtime(); }
#endif

    xcd_barrier_post(lds);
    phase_prologue(lds);
#ifdef DBL_PRO
    grid.sync();
    phase_prologue(lds);
#endif
    grid.sync(); STAMP(0);

#pragma unroll 1
    for (int layer = 0; layer < DEPTH; ++layer) {
        const int kind = layer % 3, jj = layer / 3;
        const bool mix_on = (kind == 0) ? (EN_MIX_A != 0) : (kind == 1 ? (EN_MIX_B != 0) : (EN_MIX_C != 0));
        if (mix_on) {
            if (kind == 0) {
#if EN_MIX_A
                gemm_qkv_a(lds, jj);
#ifdef DBL_INPROJ
                GRID_SYNC();
                gemm_qkv_a(lds, jj);
#endif
                GRID_SYNC(); STAMP(1);
                phase_attn(lds);
#ifdef DBL_ATTN
                GRID_SYNC();
                phase_attn(lds);
#endif
                GRID_SYNC(); STAMP(2);
                phase_attn_combine(lds);
#ifdef DBL_NORMS
                GRID_SYNC();
                phase_attn_combine(lds);
#endif
                GRID_SYNC(); STAMP(3);
#endif
            } else if (kind == 1) {
#if EN_MIX_B
                gemm_proj_b(lds);
#ifdef DBL_INPROJ
                GRID_SYNC();
                gemm_proj_b(lds);
#endif
                GRID_SYNC(); STAMP(4);
                phase_scan<64, 48, true>(lds);
#ifdef DBL_SCANB
                GRID_SYNC();
                phase_scan<64, 48, true>(lds);
#endif
                GRID_SYNC(); STAMP(5);
                phase_norm_b(lds);
#ifdef DBL_NORMS
                GRID_SYNC();
                phase_norm_b(lds);
#endif
                GRID_SYNC(); STAMP(6);
#endif
            } else {
#if EN_MIX_C
                gemm_proj_c(lds);
#ifdef DBL_INPROJ
                GRID_SYNC();
                gemm_proj_c(lds);
#endif
                GRID_SYNC(); STAMP(7);
                phase_scan<256, 64, false>(lds);
#ifdef DBL_SCANC
                GRID_SYNC();
                phase_scan<256, 64, false>(lds);
#endif
                GRID_SYNC(); STAMP(8);
                phase_norm_c(lds);
#ifdef DBL_NORMS
                GRID_SYNC();
                phase_norm_c(lds);
#endif
                GRID_SYNC(); STAMP(9);
#endif
            }
            gemm_out(lds, kind, jj, layer == 0);
            GRID_SYNC(); STAMP(10);
        }
        phase_ln1_router(lds, layer, mix_on, EN_MOE != 0);
        GRID_SYNC(); STAMP(11);
#if EN_MOE
        convert_experts(lds, layer);
        __syncthreads();
        phase_moe_scan(lds);
#ifdef DBL_MOESCAN
        GRID_SYNC();
        convert_experts(lds, layer);
        __syncthreads();
        phase_moe_scan(lds);
#endif
        GRID_SYNC(); STAMP(12);
        gemm_moe_gu(lds);
#ifdef DBL_MOEGEMM
        GRID_SYNC();
        gemm_moe_gu(lds);
#endif
        GRID_SYNC(); STAMP(13);
        gemm_moe_down(lds);
#ifdef DBL_MOEGEMM
        GRID_SYNC();
        gemm_moe_down(lds);
#endif
        GRID_SYNC(); STAMP(14);
#endif
        phase_ln2(lds, layer, layer == DEPTH - 1, EN_MOE != 0, (layer + 1 < DEPTH) && ((layer + 1) % 3 == 1) && (EN_MIX_B != 0));
        GRID_SYNC(); STAMP(15);
    }
#ifdef PROBE_A
    GRID_SYNC();
    { ParamsK q = fresh_params(); const unsigned long long* TS_ = (const unsigned long long*)(q->ws + OFF_CTL + 131072);
      const float ta = (float)__hip_atomic_load(TS_ + 32 + PROBE_A, __ATOMIC_RELAXED, __HIP_MEMORY_SCOPE_AGENT) * 0.01f, tb = (float)__hip_atomic_load(TS_ + 32 + PROBE_B, __ATOMIC_RELAXED, __HIP_MEMORY_SCOPE_AGENT) * 0.01f;
      const float dl = sqrtf(tb * 1e-4f); float* o = q->out;
      for (size_t i = (size_t)blockIdx.x * 512 + threadIdx.x; i < (size_t)NTOK * DM; i += (size_t)gridDim.x * 512) o[i] = (i == 0) ? 20.f + 0.1f * ta : o[i] + dl; }
#endif
}

extern "C" void kernel_launch(void* const* d_in, const int* in_sizes, int n_in, void* d_out, int out_size, void* d_ws, size_t ws_size, hipStream_t stream) {
    static int grid = 0;
    if (grid == 0) {
        if (n_in != 24 || in_sizes[0] != NTOK * DM || out_size != NTOK * DM || ws_size < WS_END) {
            fprintf(stderr, "kernel_launch: built for 24 inputs, x/out of %d floats, >= %zu bytes of workspace; got n_in %d, in0 %d, out %d, ws %zu; nothing launched\n", NTOK * DM, (size_t)WS_END, n_in, n_in > 0 ? in_sizes[0] : -1, out_size, ws_size);
            grid = -1; return; }
        int dev = 0, cus = 0, per_cu = 0;
        if (hipGetDevice(&dev) != hipSuccess || hipDeviceGetAttribute(&cus, hipDeviceAttributeMultiprocessorCount, dev) != hipSuccess) { fprintf(stderr, "kernel_launch: device query failed\n"); grid = -1; return; }
        if (hipFuncSetAttribute((const void*)fwd_megakernel, hipFuncAttributeMaxDynamicSharedMemorySize, LDS_BYTES) != hipSuccess) { fprintf(stderr, "kernel_launch: hipFuncSetAttribute(%d B LDS) failed\n", LDS_BYTES); grid = -1; return; }
        if (hipOccupancyMaxActiveBlocksPerMultiprocessor(&per_cu, (const void*)fwd_megakernel, 512, LDS_BYTES) != hipSuccess || per_cu < 1) { fprintf(stderr, "kernel_launch: occupancy query says %d blocks per CU\n", per_cu); (void)hipGetLastError(); per_cu = 1; }
        grid = cus * (per_cu > 1 ? 1 : per_cu);
    }
    if (grid < 0) return;
    Params p{};
    for (int i = 0; i < 24; ++i) p.in[i] = (const float*)d_in[i];
    p.out = (float*)d_out; p.ws = (unsigned char*)d_ws;
    for (int i = 0; i < 8; ++i) p.invA[i] = pow(500000.0, -(double)(2 * i) / 16.0);
    for (int i = 0; i < 128; ++i) p.invC[i] = pow(10000.0, -(double)(2 * i) / 256.0);
    if (hipMemsetAsync((char*)d_ws + OFF_BAR, 0, 16384, stream) != hipSuccess) { fprintf(stderr, "kernel_launch: hipMemsetAsync of the barrier words failed\n"); return; }
    void* args[] = {&p};
    const hipError_t e = hipLaunchCooperativeKernel((const void*)fwd_megakernel, dim3(grid), dim3(512), args, LDS_BYTES, stream);
    if (e != hipSuccess) fprintf(stderr, "kernel_launch: cooperative launch failed: %s (grid %d, %d B LDS)\n", hipGetErrorString(e), grid, LDS_BYTES);
}
```

```cpp
#define EN_MIX_A 1
#define EN_MIX_B 1
#define EN_MIX_C 1
#define EN_MOE 1
#include <hip/hip_runtime.h>
#include <hip/hip_cooperative_groups.h>
#include <cstdio>
#include <cstdint>
#include <cmath>
namespace cg = cooperative_groups;

#ifndef EN_MIX_A
#define EN_MIX_A 1
#endif
#ifndef EN_MIX_B
#define EN_MIX_B 1
#endif
#ifndef EN_MIX_C
#define EN_MIX_C 1
#endif
#ifndef EN_MOE
#define EN_MOE 1
#endif

#define LAS __attribute__((address_space(3)))
typedef unsigned short bf16_t;
typedef short bf16x8 __attribute__((ext_vector_type(8)));
typedef short s16x4 __attribute__((ext_vector_type(4)));
typedef float f32x4 __attribute__((ext_vector_type(4)));
typedef float f32x2 __attribute__((ext_vector_type(2)));
typedef unsigned u32x4 __attribute__((ext_vector_type(4)));
typedef unsigned u32x2 __attribute__((ext_vector_type(2)));

constexpr int NTOK = 32768, DM = 1024, SEQ = 4096, NBATCH = 8, DEPTH = 4;
constexpr float DN_ALPHA = 1.6817928305074292f;
constexpr float LN_EPS = 1e-5f;
constexpr int MOE_MAXROWS = 81920;
constexpr int MOE_MAXTILES = 320;

constexpr size_t al256(size_t x) { return (x + 255) & ~(size_t)255; }
constexpr size_t OFF_CTL = 0, SZ_CTL = 1u << 20;
constexpr size_t OFF_COSA = OFF_CTL + SZ_CTL;
constexpr size_t OFF_SINA = OFF_COSA + (size_t)SEQ * 8 * 4;
constexpr size_t OFF_COSC = OFF_SINA + (size_t)SEQ * 8 * 4;
constexpr size_t OFF_SINC = OFF_COSC + (size_t)SEQ * 128 * 4;
constexpr size_t OFF_PAR = OFF_SINC + (size_t)SEQ * 128 * 4;
constexpr int PAR_LN1G = 0, PAR_LN1B = 4096, PAR_LN2G = 8192, PAR_LN2B = 12288, PAR_GBIAS = 16384, PAR_CONVW = 16400, PAR_CONVB = 20496, PAR_BNG = 21520, PAR_CNG = 22544, PAR_RGB = 24592, PAR_REB = 24624, PAR_END = 24880;
constexpr size_t OFF_WG = OFF_PAR + (size_t)25088 * 4;
constexpr size_t OFF_WR = OFF_WG + 16 * 1024 * 4;
constexpr size_t OFF_WA_IN = OFF_WR + (size_t)4 * 2 * 80 * 1024 * 2;
constexpr size_t OFF_WA_OUT = OFF_WA_IN + (size_t)2 * 3072 * 1024 * 2;
constexpr size_t OFF_WB_IN = OFF_WA_OUT + (size_t)2 * 1024 * 1024 * 2;
constexpr size_t OFF_WB_OUT = OFF_WB_IN + (size_t)3072 * 1024 * 2;
constexpr size_t OFF_WC_IN = OFF_WB_OUT + (size_t)1024 * 1024 * 2;
constexpr size_t OFF_WC_OUT = OFF_WC_IN + (size_t)6144 * 1024 * 2;
constexpr size_t OFF_WE_GU = OFF_WC_OUT + (size_t)1024 * 2048 * 2;
constexpr size_t OFF_WE_D = OFF_WE_GU + (size_t)64 * 512 * 1024 * 2;
constexpr size_t OFF_H = OFF_WE_D + (size_t)64 * 1024 * 256 * 2;
constexpr size_t OFF_HB = OFF_H + (size_t)NTOK * DM * 4;
constexpr size_t OFF_GATES = OFF_HB + (size_t)NTOK * DM * 2;
constexpr size_t OFF_EID = OFF_GATES + (size_t)NTOK * 16 * 4;
constexpr size_t OFF_GATE = OFF_EID + (size_t)NTOK * 2 * 4;
constexpr size_t OFF_SLOT = OFF_GATE + (size_t)NTOK * 2 * 4;
constexpr size_t OFF_ROWGATE = OFF_SLOT + (size_t)NTOK * 2 * 4;
constexpr size_t OFF_R = al256(OFF_ROWGATE + (size_t)MOE_MAXROWS * 4);
constexpr size_t SZ_TOK1K = (size_t)NTOK * 1024 * 2;
constexpr size_t RA_Q = 0, RA_K = SZ_TOK1K, RA_V = 2 * SZ_TOK1K, RA_OG = 3 * SZ_TOK1K, RA_LSE = 6 * SZ_TOK1K;
constexpr size_t RB_PROJ = 0, RB_ORAW = 3 * SZ_TOK1K, RB_ONORM = 4 * SZ_TOK1K;
constexpr size_t RC_Q = 0, RC_K = SZ_TOK1K, RC_V = 2 * SZ_TOK1K, RC_G = 4 * SZ_TOK1K, RC_ORAW = 6 * SZ_TOK1K;
constexpr size_t RM_XB = 0, RM_HID = (size_t)MOE_MAXROWS * 1024 * 2, RM_YEXP = RM_HID + (size_t)MOE_MAXROWS * 256 * 2;
constexpr size_t SZ_R = 8 * SZ_TOK1K;
constexpr size_t WS_END = OFF_R + SZ_R;
static_assert(RA_LSE + (size_t)3 * NTOK * 16 * 4 <= SZ_R && RM_YEXP + (size_t)MOE_MAXROWS * 1024 * 2 <= SZ_R, "region R");

constexpr int LDS_BYTES = 163840;
constexpr int LDS_MISC = 131072;
constexpr int LDS_BAR = LDS_BYTES - 256;
constexpr size_t OFF_BAR = OFF_CTL + 262144;

__device__ __forceinline__ unsigned f2bf(float f) { unsigned u = __builtin_bit_cast(unsigned, f); return (u + 0x7fffu + ((u >> 16) & 1u)) >> 16; }
__device__ __forceinline__ unsigned pk2(float lo, float hi) { return f2bf(lo) | (f2bf(hi) << 16); }
__device__ __forceinline__ float bf2f(unsigned short b) { return __builtin_bit_cast(float, (unsigned)b << 16); }
__device__ __forceinline__ float bflo(unsigned w) { return __builtin_bit_cast(float, w << 16); }
__device__ __forceinline__ float bfhi(unsigned w) { return __builtin_bit_cast(float, w & 0xffff0000u); }
__device__ __forceinline__ float wave_sum(float v) {
#pragma unroll
    for (int o = 1; o < 64; o <<= 1) v += __shfl_xor(v, o);
    return v;
}
__device__ __forceinline__ float silu_f(float x) { return x / (1.f + __expf(-x)); }
__device__ __forceinline__ float sigmoid_f(float x) { return 1.f / (1.f + __expf(-x)); }

namespace pg8 {
#define PG8_LAS __attribute__((address_space(3)))
typedef unsigned short bf16_t;
typedef short bf16x8 __attribute__((ext_vector_type(8)));
typedef float f32x4 __attribute__((ext_vector_type(4)));
typedef unsigned u32x4 __attribute__((ext_vector_type(4)));
constexpr int BM = 256, BK = 64, HALF = 128, HTB = HALF * BK * 2  , STAGE_BYTES = 8 * HTB, NXCD = 8, WGM = 8;

__host__ __device__ __forceinline__ int lds_byte(int r, int c) { const int st = (r >> 4) * 2 + (c >> 5), rr = r & 15, cc = c & 31, ob = rr * 64 + cc * 2; return st * 1024 + (ob ^ (((ob >> 9) & 1) << 5)); }
__host__ __device__ __forceinline__ void stage_rc(int b, int& R, int& C) { const int st = b / 1024, sb = b % 1024, swz = sb ^ (((sb >> 9) & 1) << 5); R = (st >> 1) * 16 + swz / 64; C = (st & 1) * 32 + (swz % 64) / 2; }
__host__ __device__ __forceinline__ int perm32(int rho) { const int n = rho >> 4, i = rho & 15; return 8 * (i >> 2) + 4 * n + (i & 3); }

struct Unit { int pm, pn, pb; };
struct Gemm { const bf16_t* A; const bf16_t* Bt; int M, N, K; };

struct StaticOrder {
    int nM, nN, nwg, G, c;
    __host__ __device__ void init(int M, int N, int G_, int c_) { nM = M / BM; nN = N / BM; nwg = nM * nN; G = G_; c = c_; }
    __host__ __device__ bool next(int i, Unit& u) const {
        const long L = (long)i * G + c; if (L >= nwg) return false;
        int wgid = (int)L; { const int q = nwg / NXCD, r = nwg % NXCD, xcd = wgid % NXCD, off = wgid / NXCD; wgid = (xcd < r ? xcd * (q + 1) : r * (q + 1) + (xcd - r) * q) + off; }
        const int nig = WGM * nN, gid = wgid / nig, fm = gid * WGM, gsz = (nM - fm) < WGM ? (nM - fm) : WGM;
        u.pm = fm + ((wgid % nig) % gsz); u.pn = (wgid % nig) / gsz; u.pb = u.pn; return true;
    }
    __device__ __forceinline__ void a_ready(const Unit&) const {}
    __device__ __forceinline__ void done(const Unit&) const {}
};
__device__ __forceinline__ unsigned cvt_pk_bf16(float lo, float hi) { unsigned r; asm volatile("v_cvt_pk_bf16_f32 %0, %1, %2" : "=v"(r) : "v"(lo), "v"(hi)); return r; }
typedef float f32x2 __attribute__((ext_vector_type(2)));
template <class Epi, class Sched, bool ALIGN_EPI = false, bool SP2 = false>
__device__ __forceinline__ void gemm_phase(PG8_LAS unsigned char* lds, const Gemm g, const Sched& S, const Epi& E, const int tid) {
    const int wid = __builtin_amdgcn_readfirstlane(tid >> 6), lane = tid & 63, wr = wid >> 2, wc = wid & 3, fr = lane & 15, fq = lane >> 4;
    const int K = g.K, nt = K / BK;
    unsigned voffA[2], voffB[2];
#pragma unroll
    for (int i = 0; i < 2; ++i) { int R, C; stage_rc(tid * 16 + i * 8192, R, C); const int Rb = Epi::PERM ? ((R & ~31) + perm32(R & 31)) : R;
        voffA[i] = (unsigned)(R * K + C) * 2u; voffB[i] = (unsigned)(Rb * K + C) * 2u; }
    const size_t kstep = (size_t)(BK * 2);
    const size_t hstep = (size_t)HALF * K * 2;
    const size_t tstep = 2 * hstep;
    const unsigned ldsw = (unsigned)wid * 1024u;
    const int aoff = lds_byte(wr * 64 + fr, fq * 8), boff = lds_byte(wc * 32 + fr, fq * 8);
#define PG8_SA(b, h) (((b) * 2 + (h)) * HTB)
#define PG8_SB(b, h) ((4 + (b) * 2 + (h)) * HTB)
#define PG8_STAGE(bufoff, gbase, voff) do { _Pragma("unroll") for (int _i = 0; _i < 2; ++_i) \
        __builtin_amdgcn_global_load_lds((const unsigned*)((const char*)(gbase) + (voff)[_i]), (PG8_LAS unsigned*)(lds + (bufoff) + ldsw + _i * 8192), 16, 0, 0); } while (0)
#define PG8_LDA(dst, b, h) do { _Pragma("unroll") for (int m = 0; m < 4; ++m) _Pragma("unroll") for (int k = 0; k < 2; ++k) dst[m][k] = *(const PG8_LAS bf16x8*)(lds + PG8_SA(b, h) + aoff + m * 2048 + k * 1024); } while (0)
#define PG8_LDB(dst, b, h) do { _Pragma("unroll") for (int n = 0; n < 2; ++n) _Pragma("unroll") for (int k = 0; k < 2; ++k) dst[n][k] = *(const PG8_LAS bf16x8*)(lds + PG8_SB(b, h) + boff + n * 2048 + k * 1024); } while (0)
#define PG8_MMA(ai, bj, At, Bt) do { __builtin_amdgcn_s_setprio(1); _Pragma("unroll") for (int m = 0; m < 4; ++m) _Pragma("unroll") for (int n = 0; n < 2; ++n) _Pragma("unroll") for (int k = 0; k < 2; ++k) \
        acc[ai][bj][m][n] = __builtin_amdgcn_mfma_f32_16x16x32_bf16(Bt[n][k], At[m][k], acc[ai][bj][m][n], 0, 0, 0); __builtin_amdgcn_s_setprio(0); } while (0)
#define PG8_WAIT_V(n) asm volatile("s_waitcnt vmcnt(" #n ")" ::: "memory")
#define PG8_WAIT_L(n) asm volatile("s_waitcnt lgkmcnt(" #n ")" ::: "memory")
#define PG8_BAR __builtin_amdgcn_s_barrier()
#define PG8_SCHED __builtin_amdgcn_sched_barrier(0)
    Unit cur, nxt; int ui = 0;
    if (!S.next(0, cur)) return;
    f32x4 acc[2][2][4][2];
#pragma unroll
    for (int a = 0; a < 2; ++a)
#pragma unroll
        for (int b = 0; b < 2; ++b)
#pragma unroll
            for (int m = 0; m < 4; ++m)
#pragma unroll
                for (int n = 0; n < 2; ++n) acc[a][b][m][n] = (f32x4){0.f, 0.f, 0.f, 0.f};
    bf16x8 At[4][2], B0[2][2], B1[2][2];
    const char* cA = (const char*)g.A + (size_t)cur.pm * tstep; const char* cB = (const char*)g.Bt + (size_t)cur.pb * tstep;
    S.a_ready(cur);
    if constexpr (SP2) {
        PG8_STAGE(PG8_SB(0, 0), cB, voffB); PG8_STAGE(PG8_SB(0, 1), cB + hstep, voffB); PG8_STAGE(PG8_SA(0, 0), cA, voffA); PG8_STAGE(PG8_SA(0, 1), cA + hstep, voffA);
        if (wr == 1) PG8_BAR;
        PG8_WAIT_V(2); PG8_BAR;
        PG8_STAGE(PG8_SB(1, 0), cB + kstep, voffB); PG8_STAGE(PG8_SA(1, 0), cA + kstep, voffA); PG8_STAGE(PG8_SB(1, 1), cB + hstep + kstep, voffB);
        PG8_WAIT_V(6); PG8_BAR;
    } else {
        PG8_STAGE(PG8_SB(0, 0), cB, voffB); PG8_STAGE(PG8_SA(0, 0), cA, voffA); PG8_STAGE(PG8_SB(0, 1), cB + hstep, voffB); PG8_STAGE(PG8_SA(0, 1), cA + hstep, voffA);
        if (wr == 1) PG8_BAR;
        PG8_WAIT_V(4); PG8_BAR;
        PG8_STAGE(PG8_SB(1, 0), cB + kstep, voffB); PG8_STAGE(PG8_SA(1, 0), cA + kstep, voffA); PG8_STAGE(PG8_SB(1, 1), cB + hstep + kstep, voffB);
        PG8_WAIT_V(6); PG8_BAR;
    }
    for (;;) {
        const bool has_next = S.next(ui + 1, nxt);
        const char* nA = has_next ? (const char*)g.A + (size_t)nxt.pm * tstep : cA; const char* nB = has_next ? (const char*)g.Bt + (size_t)nxt.pb * tstep : cB;
#pragma unroll 1
        for (int t = 0; t < nt; t += 2) {
            const bool last = (t == nt - 2);
            const char* a1 = cA + (size_t)(t + 1) * kstep;
            const char* a2 = last ? nA : cA + (size_t)(t + 2) * kstep; const char* b2 = last ? nB : cB + (size_t)(t + 2) * kstep;
            const char* a3 = a2 + kstep; const char* b3 = b2 + kstep;
            if (last && has_next) S.a_ready(nxt);
            if constexpr (SP2) {
            PG8_LDB(B0, 0, 0); PG8_LDB(B1, 0, 1); PG8_SCHED; PG8_LDA(At, 0, 0); PG8_STAGE(PG8_SA(1, 1), a1 + hstep, voffA);
            PG8_WAIT_V(8); PG8_WAIT_L(0); PG8_BAR; PG8_MMA(0, 0, At, B0); PG8_MMA(0, 1, At, B1); PG8_BAR; PG8_SCHED;
            PG8_LDA(At, 0, 1); PG8_STAGE(PG8_SB(0, 0), b2, voffB); PG8_STAGE(PG8_SB(0, 1), b2 + hstep, voffB); PG8_STAGE(PG8_SA(0, 0), a2, voffA);
            PG8_WAIT_V(8); PG8_WAIT_L(0); PG8_BAR; PG8_MMA(1, 0, At, B0); PG8_MMA(1, 1, At, B1); PG8_BAR; PG8_SCHED;
            PG8_LDB(B0, 1, 0); PG8_LDB(B1, 1, 1); PG8_SCHED; PG8_LDA(At, 1, 0); PG8_STAGE(PG8_SA(0, 1), a2 + hstep, voffA);
            PG8_WAIT_V(8); PG8_WAIT_L(0); PG8_BAR; PG8_MMA(0, 0, At, B0); PG8_MMA(0, 1, At, B1); PG8_BAR; PG8_SCHED;
            PG8_LDA(At, 1, 1); PG8_STAGE(PG8_SB(1, 0), b3, voffB); PG8_STAGE(PG8_SB(1, 1), b3 + hstep, voffB); PG8_STAGE(PG8_SA(1, 0), a3, voffA);
            PG8_WAIT_V(8); PG8_WAIT_L(0); PG8_BAR; PG8_MMA(1, 0, At, B0); PG8_MMA(1, 1, At, B1); PG8_BAR; PG8_SCHED;
            } else {
            PG8_LDB(B0, 0, 0); PG8_SCHED; PG8_LDA(At, 0, 0); PG8_STAGE(PG8_SA(1, 1), a1 + hstep, voffA);
            PG8_WAIT_L(8); PG8_BAR; PG8_WAIT_L(0); PG8_MMA(0, 0, At, B0); PG8_BAR; PG8_SCHED;
            PG8_LDB(B1, 0, 1); PG8_STAGE(PG8_SB(0, 0), b2, voffB);
            PG8_BAR; PG8_WAIT_L(0); PG8_MMA(0, 1, At, B1); PG8_BAR;
            PG8_LDA(At, 0, 1); PG8_STAGE(PG8_SA(0, 0), a2, voffA);
            PG8_BAR; PG8_WAIT_L(0); PG8_MMA(1, 0, At, B0); PG8_BAR; PG8_SCHED;
            PG8_STAGE(PG8_SB(0, 1), b2 + hstep, voffB);
            PG8_WAIT_V(6); PG8_BAR; PG8_MMA(1, 1, At, B1); PG8_BAR;
            PG8_LDB(B0, 1, 0); PG8_SCHED; PG8_LDA(At, 1, 0); PG8_STAGE(PG8_SA(0, 1), a2 + hstep, voffA);
            PG8_WAIT_L(8); PG8_BAR; PG8_WAIT_L(0); PG8_MMA(0, 0, At, B0); PG8_BAR; PG8_SCHED;
            PG8_LDB(B1, 1, 1); PG8_STAGE(PG8_SB(1, 0), b3, voffB);
            PG8_BAR; PG8_WAIT_L(0); PG8_MMA(0, 1, At, B1); PG8_BAR;
            PG8_LDA(At, 1, 1); PG8_STAGE(PG8_SA(1, 0), a3, voffA);
            PG8_BAR; PG8_WAIT_L(0); PG8_MMA(1, 0, At, B0); PG8_BAR; PG8_SCHED;
            PG8_STAGE(PG8_SB(1, 1), b3 + hstep, voffB);
            PG8_WAIT_V(6); PG8_BAR; PG8_MMA(1, 1, At, B1); PG8_BAR;
            }
        }
        if constexpr (ALIGN_EPI) { if (wr == 0) PG8_BAR; }
        if constexpr (!Epi::AFTER_DRAIN) { E(acc, cur, wr, wc, fr, fq); S.done(cur); }
        if (!has_next) break;
#pragma unroll
        for (int a = 0; a < 2; ++a)
#pragma unroll
            for (int b = 0; b < 2; ++b)
#pragma unroll
                for (int m = 0; m < 4; ++m)
#pragma unroll
                    for (int n = 0; n < 2; ++n) acc[a][b][m][n] = (f32x4){0.f, 0.f, 0.f, 0.f};
        cur = nxt; cA = nA; cB = nB; ++ui;
        if constexpr (ALIGN_EPI) { if (wr == 1) PG8_BAR; }
    }
    PG8_WAIT_V(0);
    if constexpr (!ALIGN_EPI) { if (wr == 0) PG8_BAR; }
    PG8_BAR;
    if constexpr (Epi::AFTER_DRAIN) { E.fused(acc, cur, wr, wc, fr, fq, lds, wid, lane); S.done(cur); }
#undef PG8_SA
#undef PG8_SB
#undef PG8_STAGE
#undef PG8_LDA
#undef PG8_LDB
#undef PG8_MMA
#undef PG8_WAIT_V
#undef PG8_WAIT_L
#undef PG8_BAR
#undef PG8_SCHED
}

typedef unsigned u32x2 __attribute__((ext_vector_type(2)));
constexpr int kSeq = 4096;

struct EpiQkvA {
    static constexpr bool PERM = false, AFTER_DRAIN = false;
    bf16_t* QKV; size_t stride; const float *cosA, *sinA;
    __device__ __forceinline__ void operator()(const f32x4 (&acc)[2][2][4][2], const Unit& u, int wr, int wc, int fr, int fq) const {
        const int sel = u.pn >> 2; bf16_t* base = QKV + (size_t)sel * stride;
        const float sc = sel == 0 ? 0.125f : 1.f;
        const int colt = (u.pn & 3) * 256 + wc * 32 + 4 * fq;
        const bool rot = (sel < 2) && ((wc & 1) == 0);
#pragma unroll
        for (int ai = 0; ai < 2; ++ai)
#pragma unroll
            for (int m = 0; m < 4; ++m) {
                const int row = u.pm * BM + ai * HALF + wr * 64 + m * 16 + fr;
                f32x4 cs = {1.f, 1.f, 1.f, 1.f}, sn = {0.f, 0.f, 0.f, 0.f};
                if (rot) { const int sp = row & (kSeq - 1); cs = *(const f32x4*)(cosA + sp * 8 + 4 * (fq & 1)); sn = *(const f32x4*)(sinA + sp * 8 + 4 * (fq & 1)); }
#pragma unroll
                for (int bj = 0; bj < 2; ++bj)
#pragma unroll
                    for (int n = 0; n < 2; ++n) {
                        f32x4 v = acc[ai][bj][m][n];
                        if (n == 0 && rot) {
                            f32x4 p; p[0] = __shfl_xor(v[0], 32); p[1] = __shfl_xor(v[1], 32); p[2] = __shfl_xor(v[2], 32); p[3] = __shfl_xor(v[3], 32);
                            v = (fq < 2) ? (v * cs - p * sn) : (v * cs + p * sn);
                        }
                        v = v * sc;
                        u32x2 w; w.x = cvt_pk_bf16(v[0], v[1]); w.y = cvt_pk_bf16(v[2], v[3]);
                        *(u32x2*)(base + (size_t)row * 1024 + colt + bj * HALF + n * 16) = w;
                    }
            }
    }
};

struct EpiBf16Plain {
    static constexpr bool PERM = true, AFTER_DRAIN = false;
    bf16_t* O; int ldc;
    __device__ __forceinline__ void operator()(const f32x4 (&acc)[2][2][4][2], const Unit& u, int wr, int wc, int fr, int fq) const {
        const int row0 = u.pm * BM + wr * 64 + fr, col0 = u.pn * BM + wc * 32 + 8 * fq;
#pragma unroll
        for (int ai = 0; ai < 2; ++ai)
#pragma unroll
            for (int m = 0; m < 4; ++m) { bf16_t* rowp = O + (size_t)(row0 + ai * HALF + m * 16) * ldc + col0;
#pragma unroll
                for (int bj = 0; bj < 2; ++bj) { const f32x4 v0 = acc[ai][bj][m][0], v1 = acc[ai][bj][m][1];
                    u32x4 w; w.x = cvt_pk_bf16(v0[0], v0[1]); w.y = cvt_pk_bf16(v0[2], v0[3]); w.z = cvt_pk_bf16(v1[0], v1[1]); w.w = cvt_pk_bf16(v1[2], v1[3]);
                    *(u32x4*)(rowp + bj * HALF) = w; } }
    }
};

struct EpiProjC {
    static constexpr bool PERM = true, AFTER_DRAIN = false;
    bf16_t *QK, *VG; size_t qk_stride, vg_stride; const float *cosC, *sinC;
    __device__ __forceinline__ void operator()(const f32x4 (&acc)[2][2][4][2], const Unit& u, int wr, int wc, int fr, int fq) const {
        const int row0 = u.pm * BM + wr * 64 + fr;
        if (u.pn < 8) {
            const bool isk = u.pn >= 4; bf16_t* base = QK + (isk ? qk_stride : (size_t)0); const float sc = isk ? 0.0625f : 1.f;
            const int i0 = wc * 32 + 8 * fq, colb = (u.pn & 3) * 256 + i0;
#pragma unroll
            for (int ai = 0; ai < 2; ++ai)
#pragma unroll
                for (int m = 0; m < 4; ++m) {
                    const int row = row0 + ai * HALF + m * 16, sp = row & (kSeq - 1);
                    const f32x4 c0 = *(const f32x4*)(cosC + sp * 128 + i0), c1 = *(const f32x4*)(cosC + sp * 128 + i0 + 4);
                    const f32x4 s0 = *(const f32x4*)(sinC + sp * 128 + i0), s1 = *(const f32x4*)(sinC + sp * 128 + i0 + 4);
                    const f32x4 x1a = acc[ai][0][m][0], x1b = acc[ai][0][m][1], x2a = acc[ai][1][m][0], x2b = acc[ai][1][m][1];
                    const f32x4 o1a = (x1a * c0 - x2a * s0) * sc, o1b = (x1b * c1 - x2b * s1) * sc;
                    const f32x4 o2a = (x2a * c0 + x1a * s0) * sc, o2b = (x2b * c1 + x1b * s1) * sc;
                    bf16_t* rowp = base + (size_t)row * 1024 + colb;
                    u32x4 w; w.x = cvt_pk_bf16(o1a[0], o1a[1]); w.y = cvt_pk_bf16(o1a[2], o1a[3]); w.z = cvt_pk_bf16(o1b[0], o1b[1]); w.w = cvt_pk_bf16(o1b[2], o1b[3]);
                    *(u32x4*)rowp = w;
                    w.x = cvt_pk_bf16(o2a[0], o2a[1]); w.y = cvt_pk_bf16(o2a[2], o2a[3]); w.z = cvt_pk_bf16(o2b[0], o2b[1]); w.w = cvt_pk_bf16(o2b[2], o2b[3]);
                    *(u32x4*)(rowp + HALF) = w;
                }
        } else {
            bf16_t* base = VG + (u.pn >= 16 ? vg_stride : (size_t)0); const int col0 = ((u.pn - 8) & 7) * 256 + wc * 32 + 8 * fq;
#pragma unroll
            for (int ai = 0; ai < 2; ++ai)
#pragma unroll
                for (int m = 0; m < 4; ++m) { bf16_t* rowp = base + (size_t)(row0 + ai * HALF + m * 16) * 2048 + col0;
#pragma unroll
                    for (int bj = 0; bj < 2; ++bj) { const f32x4 v0 = acc[ai][bj][m][0], v1 = acc[ai][bj][m][1];
                        u32x4 w; w.x = cvt_pk_bf16(v0[0], v0[1]); w.y = cvt_pk_bf16(v0[2], v0[3]); w.z = cvt_pk_bf16(v1[0], v1[1]); w.w = cvt_pk_bf16(v1[2], v1[3]);
                        *(u32x4*)(rowp + bj * HALF) = w; } }
        }
    }
};

struct EpiResidual {
    static constexpr bool PERM = false, AFTER_DRAIN = false;
    const float* hin; float* hout; float alpha;
    __device__ __forceinline__ void operator()(const f32x4 (&acc)[2][2][4][2], const Unit& u, int wr, int wc, int fr, int fq) const {
        const int row0 = u.pm * BM + wr * 64 + fr, col0 = u.pn * BM + wc * 32 + 4 * fq;
#pragma unroll
        for (int ai = 0; ai < 2; ++ai)
#pragma unroll
            for (int m = 0; m < 4; ++m) { const size_t off = (size_t)(row0 + ai * HALF + m * 16) * 1024 + col0;
#pragma unroll
                for (int bj = 0; bj < 2; ++bj)
#pragma unroll
                    for (int n = 0; n < 2; ++n) { const f32x4 hv = *(const f32x4*)(hin + off + bj * HALF + n * 16);
                        *(f32x4*)(hout + off + bj * HALF + n * 16) = hv * alpha + acc[ai][bj][m][n]; } }
    }
};

struct EpiMoeGU {
    static constexpr bool PERM = true, AFTER_DRAIN = false;
    bf16_t* HID;
    __device__ __forceinline__ void operator()(const f32x4 (&acc)[2][2][4][2], const Unit& u, int wr, int wc, int fr, int fq) const {
        const int row0 = u.pm * BM + wr * 64 + fr, col0 = u.pn * 128 + wc * 32 + 8 * fq;
#pragma unroll
        for (int ai = 0; ai < 2; ++ai)
#pragma unroll
            for (int m = 0; m < 4; ++m) {
                f32x4 h[2];
#pragma unroll
                for (int n = 0; n < 2; ++n) { const f32x4 g = acc[ai][0][m][n], up = acc[ai][1][m][n];
#pragma unroll
                    for (int j = 0; j < 4; ++j) h[n][j] = g[j] / (1.f + __expf(-g[j])) * up[j]; }
                u32x4 w; w.x = cvt_pk_bf16(h[0][0], h[0][1]); w.y = cvt_pk_bf16(h[0][2], h[0][3]); w.z = cvt_pk_bf16(h[1][0], h[1][1]); w.w = cvt_pk_bf16(h[1][2], h[1][3]);
                *(u32x4*)(HID + (size_t)(row0 + ai * HALF + m * 16) * 256 + col0) = w;
            }
    }
};

struct EpiMoeDown {
    static constexpr bool PERM = true, AFTER_DRAIN = false;
    bf16_t* Y; const float* rowgate;
    __device__ __forceinline__ void operator()(const f32x4 (&acc)[2][2][4][2], const Unit& u, int wr, int wc, int fr, int fq) const {
        const int row0 = u.pm * BM + wr * 64 + fr, col0 = u.pn * BM + wc * 32 + 8 * fq;
#pragma unroll
        for (int ai = 0; ai < 2; ++ai)
#pragma unroll
            for (int m = 0; m < 4; ++m) { const int row = row0 + ai * HALF + m * 16; const float gt = rowgate[row]; bf16_t* rowp = Y + (size_t)row * 1024 + col0;
#pragma unroll
                for (int bj = 0; bj < 2; ++bj) { const f32x4 v0 = acc[ai][bj][m][0] * gt, v1 = acc[ai][bj][m][1] * gt;
                    u32x4 w; w.x = cvt_pk_bf16(v0[0], v0[1]); w.y = cvt_pk_bf16(v0[2], v0[3]); w.z = cvt_pk_bf16(v1[0], v1[1]); w.w = cvt_pk_bf16(v1[2], v1[3]);
                    *(u32x4*)(rowp + bj * HALF) = w; } }
    }
};

struct MoeOrder {
    const PG8_LAS int* tile_e; int ntiles, ncol, bmul, G, c;
    __device__ __forceinline__ bool next(int i, Unit& u) const {
        const int L = i * G + c; if (L >= ntiles * ncol) return false;
        const int ti = L / ncol, j = L - ti * ncol;
        u.pm = ti; u.pn = j; u.pb = __builtin_amdgcn_readfirstlane(tile_e[ti] * bmul + j); return true;
    }
    __device__ __forceinline__ void a_ready(const Unit&) const {}
    __device__ __forceinline__ void done(const Unit&) const {}
};
}

struct Params {
    const float* in[24]; float* out; unsigned char* ws;
    double invA[8]; double invC[128];
};
typedef const __attribute__((address_space(4))) Params* ParamsK;
__device__ __forceinline__ ParamsK fresh_params() { ParamsK q = (ParamsK)__builtin_amdgcn_kernarg_segment_ptr(); asm volatile("" : "+s"(q)); return q; }
struct Ctx {
    int tid, lane, wave, G, bid;
    LAS unsigned char* lds;
};
__device__ __forceinline__ Ctx make_ctx(LAS unsigned char* lds) {
    Ctx c; int tid = threadIdx.x; asm volatile("" : "+v"(tid)); int bid = blockIdx.x; asm volatile("" : "+s"(bid)); int G = gridDim.x; asm volatile("" : "+s"(G));
    asm volatile("" : "+s"(lds));
    c.tid = tid; c.lane = tid & 63; c.wave = __builtin_amdgcn_readfirstlane(tid >> 6); c.G = G; c.bid = bid; c.lds = lds; return c;
}

__device__ __forceinline__ void transpose_item(const float* W, int ldw, int k0, int n0, bf16_t* WT, int K, size_t dstrow0, LAS float* scr, int lane) {
#pragma unroll 8
    for (int i = 0; i < 32; ++i) { const int kk = 2 * i + (lane >> 5); scr[kk * 33 + (lane & 31)] = W[(size_t)(k0 + kk) * ldw + n0 + (lane & 31)]; }
    asm volatile("s_waitcnt lgkmcnt(0)" ::: "memory");
    const int c = lane & 7;
#pragma unroll
    for (int j = 0; j < 4; ++j) { const int n = (lane >> 3) + 8 * j; const LAS float* s = scr + (8 * c) * 33 + n;
        u32x4 o; o.x = pk2(s[0 * 33], s[1 * 33]); o.y = pk2(s[2 * 33], s[3 * 33]); o.z = pk2(s[4 * 33], s[5 * 33]); o.w = pk2(s[6 * 33], s[7 * 33]);
        *(u32x4*)(WT + (dstrow0 + n) * K + k0 + 8 * c) = o; }
    asm volatile("s_waitcnt lgkmcnt(0)" ::: "memory");
}
__device__ __forceinline__ void transpose_matrix(const Ctx& c, const float* W, int K, int ldw, int ncols, bf16_t* WT) {
    LAS float* scr = (LAS float*)(c.lds + c.wave * 8704);
    const int gw = c.bid * 8 + c.wave, NGW = c.G * 8, nblk = ncols / 32, items = (K / 64) * nblk;
    for (int it = gw; it < items; it += NGW) { const int kb = it / nblk, nb = it - kb * nblk; transpose_item(W, ldw, 64 * kb, 32 * nb, WT, K, (size_t)(32 * nb), scr, c.lane); }
}
__device__ __forceinline__ void convert_experts(LAS unsigned char* lds_, int layer) {
    const Ctx c = make_ctx(lds_); layer = __builtin_amdgcn_readfirstlane(layer); asm volatile("" : "+s"(layer));
    LAS float* scr = (LAS float*)(c.lds + c.wave * 8704);
    const int gw = c.bid * 8 + c.wave, NGW = c.G * 8;
    ParamsK q = fresh_params(); const float* Wg = q->in[21] + (size_t)layer * 64 * 1024 * 256; const float* Wu = q->in[22] + (size_t)layer * 64 * 1024 * 256; const float* Wd = q->in[23] + (size_t)layer * 64 * 256 * 1024;
    unsigned char* ws = q->ws;
    bf16_t* GU = (bf16_t*)(ws + OFF_WE_GU); bf16_t* D = (bf16_t*)(ws + OFF_WE_D);
    for (int it = gw; it < 64 * 384; it += NGW) {
        const int e = it / 384, r = it - e * 384;
        if (r < 256) { const int isup = r >> 7, rr = r & 127, kb = rr >> 3, nb = rr & 7, n0 = 32 * nb;
            const float* W = (isup ? Wu : Wg) + (size_t)e * 1024 * 256;
            transpose_item(W, 256, 64 * kb, n0, GU, 1024, (size_t)e * 512 + (n0 >> 7) * 256 + isup * 128 + (n0 & 127), scr, c.lane);
        } else { const int rr = r - 256, kb = rr >> 5, nb = rr & 31;
            transpose_item(Wd + (size_t)e * 256 * 1024, 1024, 64 * kb, 32 * nb, D, 256, (size_t)e * 1024 + 32 * nb, scr, c.lane); }
    }
}
__device__ __forceinline__ void rope_entry(double w, int pos, float& co, float& si) {
    const double w2 = w * w; double cs = 1.0, sn = w, tc = 1.0, ts = w;
#pragma unroll
    for (int k = 1; k <= 11; ++k) { tc = -tc * w2 / (double)((2 * k - 1) * (2 * k)); ts = -ts * w2 / (double)((2 * k) * (2 * k + 1)); cs += tc; sn += ts; }
    double rc = 1.0, rs = 0.0, bc = cs, bs = sn; unsigned pp = (unsigned)pos;
#pragma unroll 1
    for (int b = 0; b < 20; ++b) { const bool on = ((pp >> b) & 1u) != 0u; const double t = rc * bc - rs * bs, u2 = rc * bs + rs * bc; rc = on ? t : rc; rs = on ? u2 : rs; const double t2 = bc * bc - bs * bs; bs = 2.0 * bc * bs; bc = t2; }
    co = (float)rc; si = (float)rs;
}
__device__ __forceinline__ void phase_prologue(LAS unsigned char* lds_) {
    const Ctx c = make_ctx(lds_);
    unsigned char* ws = fresh_params()->ws;
    transpose_matrix(c, fresh_params()->in[6], 1024, 3072, 3072, (bf16_t*)(ws + OFF_WA_IN));
    transpose_matrix(c, fresh_params()->in[6] + (size_t)1024 * 3072, 1024, 3072, 3072, (bf16_t*)(ws + OFF_WA_IN) + (size_t)3072 * 1024);
    transpose_matrix(c, fresh_params()->in[7], 1024, 1024, 1024, (bf16_t*)(ws + OFF_WA_OUT));
    transpose_matrix(c, fresh_params()->in[7] + (size_t)1024 * 1024, 1024, 1024, 1024, (bf16_t*)(ws + OFF_WA_OUT) + (size_t)1024 * 1024);
    transpose_matrix(c, fresh_params()->in[8], 1024, 3088, 3072, (bf16_t*)(ws + OFF_WB_IN));
    transpose_matrix(c, fresh_params()->in[13], 1024, 1024, 1024, (bf16_t*)(ws + OFF_WB_OUT));
    transpose_matrix(c, fresh_params()->in[14], 1024, 6144, 6144, (bf16_t*)(ws + OFF_WC_IN));
    transpose_matrix(c, fresh_params()->in[16], 2048, 1024, 1024, (bf16_t*)(ws + OFF_WC_OUT));
    const int gt = c.bid * 512 + c.tid, NT = c.G * 512;
    { bf16_t* WR = (bf16_t*)(ws + OFF_WR);
      for (int i = gt; i < 4 * 80 * 1024; i += NT) { const int layer = i / (80 * 1024), r = i - layer * 80 * 1024, n = r >> 10, k = r & 1023;
          float w = 0.f; if (n < 8) w = fresh_params()->in[17][((size_t)layer * 1024 + k) * 8 + n]; else if (n < 72) w = fresh_params()->in[19][((size_t)layer * 1024 + k) * 64 + (n - 8)];
          const unsigned hi = f2bf(w); const float lo = w - __builtin_bit_cast(float, hi << 16);
          WR[((size_t)layer * 2 + 0) * 80 * 1024 + r] = (bf16_t)hi; WR[((size_t)layer * 2 + 1) * 80 * 1024 + r] = (bf16_t)f2bf(lo); } }
    { float* WG = (float*)(ws + OFF_WG); for (int i = gt; i < 16 * 1024; i += NT) { const int o = i >> 10, k = i & 1023; WG[i] = fresh_params()->in[8][(size_t)k * 3088 + 3072 + o]; } }
    { float* par = (float*)(ws + OFF_PAR);
      for (int i = gt; i < PAR_END; i += NT) { float v;
          if (i < PAR_LN1B) v = fresh_params()->in[2][i]; else if (i < PAR_LN2G) v = fresh_params()->in[3][i - PAR_LN1B]; else if (i < PAR_LN2B) v = fresh_params()->in[4][i - PAR_LN2G]; else if (i < PAR_GBIAS) v = fresh_params()->in[5][i - PAR_LN2B];
          else if (i < PAR_CONVW) v = fresh_params()->in[9][i - PAR_GBIAS]; else if (i < PAR_CONVB) v = fresh_params()->in[10][i - PAR_CONVW]; else if (i < PAR_BNG) v = fresh_params()->in[11][i - PAR_CONVB]; else if (i < PAR_CNG) v = fresh_params()->in[12][i - PAR_BNG];
          else if (i < PAR_RGB) v = fresh_params()->in[15][i - PAR_CNG]; else if (i < PAR_REB) v = fresh_params()->in[18][i - PAR_RGB]; else v = fresh_params()->in[20][i - PAR_REB];
          par[i] = v; } }
    { const int* pos = (const int*)fresh_params()->in[1]; float* cA = (float*)(ws + OFF_COSA); float* sA = (float*)(ws + OFF_SINA); float* cC = (float*)(ws + OFF_COSC); float* sC = (float*)(ws + OFF_SINC);
      for (int i = gt; i < SEQ * 136; i += NT) { const int s = i / 136, f = i - s * 136; float co, si;
          if (f < 8) { rope_entry(fresh_params()->invA[f], pos[s], co, si); cA[s * 8 + f] = co; sA[s * 8 + f] = si; }
          else { rope_entry(fresh_params()->invC[f - 8], pos[s], co, si); cC[s * 128 + f - 8] = co; sC[s * 128 + f - 8] = si; } } }
    { const f32x4* x4 = (const f32x4*)fresh_params()->in[0]; u32x2* hb = (u32x2*)(ws + OFF_HB);
      for (size_t i = gt; i < (size_t)NTOK * DM / 4; i += NT) { const f32x4 v = x4[i]; u32x2 w; w.x = pk2(v[0], v[1]); w.y = pk2(v[2], v[3]); hb[i] = w; } }
}

__device__ __forceinline__ void ln_apply(f32x4 (&v)[4], const f32x4 (&g)[4], const f32x4 (&b)[4]) {
    float s = 0.f;
#pragma unroll
    for (int j = 0; j < 4; ++j) s += (v[j][0] + v[j][1]) + (v[j][2] + v[j][3]);
    const float mean = wave_sum(s) * (1.f / DM); float s2 = 0.f;
#pragma unroll
    for (int j = 0; j < 4; ++j) { v[j] = v[j] - mean; s2 += (v[j][0] * v[j][0] + v[j][1] * v[j][1]) + (v[j][2] * v[j][2] + v[j][3] * v[j][3]); }
    const float rstd = 1.f / sqrtf(wave_sum(s2) * (1.f / DM) + LN_EPS);
#pragma unroll
    for (int j = 0; j < 4; ++j) v[j] = v[j] * rstd * g[j] + b[j];
}

__device__ __forceinline__ void phase_ln1_router(LAS unsigned char* lds_, int layer, bool mixed, bool do_router) {
    const Ctx c = make_ctx(lds_); layer = __builtin_amdgcn_readfirstlane(layer); asm volatile("" : "+s"(layer));
    unsigned char* ws = fresh_params()->ws;
    float* H = (float*)(ws + OFF_H); bf16_t* HB = (bf16_t*)(ws + OFF_HB);
    const float* src = mixed ? H : (layer == 0 ? fresh_params()->in[0] : H); const float scale = mixed ? 1.0f : DN_ALPHA;
    const float* par = (const float*)(ws + OFF_PAR); const float* lg = par + PAR_LN1G + layer * DM; const float* lb = par + PAR_LN1B + layer * DM;
    f32x4 g[4], b[4];
#pragma unroll
    for (int j = 0; j < 4; ++j) { g[j] = *(const f32x4*)(lg + 4 * c.lane + 256 * j); b[j] = *(const f32x4*)(lb + 4 * c.lane + 256 * j); }
    LAS int* hist = (LAS int*)(c.lds);
    LAS float* lgt = (LAS float*)(c.lds + 1024) + c.wave * (16 * 80);
    const bf16_t* WRh = (const bf16_t*)(ws + OFF_WR) + (size_t)(layer * 2 + 0) * 80 * 1024; const bf16_t* WRl = WRh + 80 * 1024;
    const int fr = c.lane & 15, fq = c.lane >> 4;
    for (int rb = c.bid; rb < NTOK / 128; rb += c.G) {
        const int row0 = rb * 128 + c.wave * 16;
        if (c.tid < 64) hist[c.tid] = 0;
        for (int r = 0; r < 16; ++r) {
            const size_t ro = (size_t)(row0 + r) * DM + 4 * c.lane; f32x4 v[4];
#pragma unroll
            for (int j = 0; j < 4; ++j) v[j] = *(const f32x4*)(src + ro + 256 * j) * scale;
            ln_apply(v, g, b);
#pragma unroll
            for (int j = 0; j < 4; ++j) { *(f32x4*)(H + ro + 256 * j) = v[j]; u32x2 w; w.x = pk2(v[j][0], v[j][1]); w.y = pk2(v[j][2], v[j][3]); *(u32x2*)(HB + ro + 256 * j) = w; }
        }
        __syncthreads();
        if (do_router) {
            f32x4 acc[5];
#pragma unroll
            for (int t = 0; t < 5; ++t) acc[t] = (f32x4){0.f, 0.f, 0.f, 0.f};
            const float* arow = H + (size_t)(row0 + fr) * DM + fq * 8;
            for (int ks = 0; ks < 32; ++ks) {
                const f32x4 a0 = *(const f32x4*)(arow + ks * 32), a1 = *(const f32x4*)(arow + ks * 32 + 4);
                bf16x8 ah, al;
#pragma unroll
                for (int j = 0; j < 4; ++j) { const unsigned h0 = f2bf(a0[j]), h1 = f2bf(a1[j]); ah[j] = (short)h0; ah[4 + j] = (short)h1;
                    al[j] = (short)f2bf(a0[j] - __builtin_bit_cast(float, h0 << 16)); al[4 + j] = (short)f2bf(a1[j] - __builtin_bit_cast(float, h1 << 16)); }
#pragma unroll
                for (int t = 0; t < 5; ++t) {
                    const bf16x8 bh = *(const bf16x8*)(WRh + (size_t)(t * 16 + fr) * 1024 + ks * 32 + fq * 8);
                    const bf16x8 bl = *(const bf16x8*)(WRl + (size_t)(t * 16 + fr) * 1024 + ks * 32 + fq * 8);
                    acc[t] = __builtin_amdgcn_mfma_f32_16x16x32_bf16(ah, bh, acc[t], 0, 0, 0);
                    acc[t] = __builtin_amdgcn_mfma_f32_16x16x32_bf16(al, bh, acc[t], 0, 0, 0);
                    acc[t] = __builtin_amdgcn_mfma_f32_16x16x32_bf16(ah, bl, acc[t], 0, 0, 0);
                }
            }
#pragma unroll
            for (int t = 0; t < 5; ++t) { const int n = t * 16 + fr; float bias = 0.f; if (n < 8) bias = par[PAR_RGB + layer * 8 + n]; else if (n < 72) bias = par[PAR_REB + layer * 64 + n - 8];
#pragma unroll
                for (int r = 0; r < 4; ++r) lgt[(4 * fq + r) * 80 + n] = acc[t][r] + bias; }
            __syncthreads();
            if (c.lane < 16) {
                const LAS float* L = lgt + c.lane * 80; const int tok = row0 + c.lane;
                int grp = 0; float gm = L[0];
#pragma unroll
                for (int i = 1; i < 8; ++i) { const float x = L[i]; if (x > gm) { gm = x; grp = i; } }
                float se = 0.f;
#pragma unroll
                for (int i = 0; i < 8; ++i) se += __expf(L[i] - gm);
                const float pg = 1.f / se;
                const LAS float* E = L + 8 + grp * 8;
                int i0 = 0; float v0 = E[0];
#pragma unroll
                for (int i = 1; i < 8; ++i) { const float x = E[i]; if (x > v0) { v0 = x; i0 = i; } }
                int i1 = -1; float v1 = -3.0e38f;
#pragma unroll
                for (int i = 0; i < 8; ++i) { const float x = E[i]; if (i != i0 && x > v1) { v1 = x; i1 = i; } }
                const float ex = __expf(v1 - v0), g0 = pg / (1.f + ex), g1 = pg * ex / (1.f + ex);
                const int e0 = grp * 8 + i0, e1 = grp * 8 + i1;
                int* EID = (int*)(ws + OFF_EID); float* GT = (float*)(ws + OFF_GATE);
                EID[tok * 2] = e0; EID[tok * 2 + 1] = e1; GT[tok * 2] = g0; GT[tok * 2 + 1] = g1;
                __hip_atomic_fetch_add(hist + e0, 1, __ATOMIC_RELAXED, __HIP_MEMORY_SCOPE_WORKGROUP);
                __hip_atomic_fetch_add(hist + e1, 1, __ATOMIC_RELAXED, __HIP_MEMORY_SCOPE_WORKGROUP);
            }
            __syncthreads();
            if (c.tid < 64) ((int*)(ws + OFF_CTL))[rb * 64 + c.tid] = hist[c.tid];
        }
        __syncthreads();
    }
}

__device__ __forceinline__ void phase_ln2(LAS unsigned char* lds_, int layer, bool last, bool with_moe, bool do_gates) {
    const Ctx c = make_ctx(lds_); layer = __builtin_amdgcn_readfirstlane(layer); asm volatile("" : "+s"(layer));
    unsigned char* ws = fresh_params()->ws;
    float* dst = last ? fresh_params()->out : (float*)(ws + OFF_H);
    const float* H = (const float*)(ws + OFF_H); bf16_t* HB = (bf16_t*)(ws + OFF_HB);
    const float* par = (const float*)(ws + OFF_PAR); const float* lg = par + PAR_LN2G + layer * DM; const float* lb = par + PAR_LN2B + layer * DM;
    f32x4 g[4], b[4];
#pragma unroll
    for (int j = 0; j < 4; ++j) { g[j] = *(const f32x4*)(lg + 4 * c.lane + 256 * j); b[j] = *(const f32x4*)(lb + 4 * c.lane + 256 * j); }
    const int* SLOT = (const int*)(ws + OFF_SLOT); const bf16_t* Y = (const bf16_t*)(ws + OFF_R + RM_YEXP);
    LAS float* wg = (LAS float*)c.lds;
    if (do_gates) { const float* WG = (const float*)(ws + OFF_WG); for (int i = c.tid; i < 16 * 1024 / 4; i += 512) ((LAS f32x4*)wg)[i] = ((const f32x4*)WG)[i]; __syncthreads(); }
    float* GATES = (float*)(ws + OFF_GATES);
    for (int row = c.bid * 8 + c.wave; row < NTOK; row += c.G * 8) {
        const size_t ro = (size_t)row * DM + 4 * c.lane; f32x4 v[4];
#pragma unroll
        for (int j = 0; j < 4; ++j) v[j] = *(const f32x4*)(H + ro + 256 * j) * DN_ALPHA;
        if (with_moe) {
            const int s0 = SLOT[row * 2], s1 = SLOT[row * 2 + 1];
            const bf16_t* y0 = Y + (size_t)s0 * DM + 4 * c.lane; const bf16_t* y1 = Y + (size_t)s1 * DM + 4 * c.lane;
#pragma unroll
            for (int j = 0; j < 4; ++j) { const u32x2 a = *(const u32x2*)(y0 + 256 * j), bb = *(const u32x2*)(y1 + 256 * j);
                v[j][0] += bflo(a.x) + bflo(bb.x); v[j][1] += bfhi(a.x) + bfhi(bb.x); v[j][2] += bflo(a.y) + bflo(bb.y); v[j][3] += bfhi(a.y) + bfhi(bb.y); }
        }
        ln_apply(v, g, b);
#pragma unroll
        for (int j = 0; j < 4; ++j) { *(f32x4*)(dst + ro + 256 * j) = v[j]; u32x2 w; w.x = pk2(v[j][0], v[j][1]); w.y = pk2(v[j][2], v[j][3]); *(u32x2*)(HB + ro + 256 * j) = w; }
        if (do_gates) {
            float mine = 0.f;
#pragma unroll
            for (int o = 0; o < 16; ++o) { float s = 0.f;
#pragma unroll
                for (int j = 0; j < 4; ++j) { const f32x4 w = *(const LAS f32x4*)(wg + o * 1024 + 4 * c.lane + 256 * j); s += (v[j][0] * w[0] + v[j][1] * w[1]) + (v[j][2] * w[2] + v[j][3] * w[3]); }
                s = wave_sum(s); if (c.lane == o) mine = s; }
            if (c.lane < 16) GATES[(size_t)row * 16 + c.lane] = mine + par[PAR_GBIAS + c.lane];
        }
    }
}

__device__ __forceinline__ void phase_moe_scan(LAS unsigned char* lds_) {
    const Ctx c = make_ctx(lds_);
    unsigned char* ws = fresh_params()->ws;
    const int* CNT = (const int*)(ws + OFF_CTL); const int* EID = (const int*)(ws + OFF_EID); const float* GT = (const float*)(ws + OFF_GATE);
    int* SLOT = (int*)(ws + OFF_SLOT); float* RG = (float*)(ws + OFF_ROWGATE);
    const bf16_t* HB = (const bf16_t*)(ws + OFF_HB); bf16_t* XB = (bf16_t*)(ws + OFF_R + RM_XB);
    LAS int* part = (LAS int*)c.lds;
    LAS int* tot = part + 1024;
    LAS int* bef = tot + 64;
    LAS int* pst = bef + 64;
    LAS int* eids = pst + 64;
    LAS int* dst = eids + 256;
    LAS int* misc = (LAS int*)(c.lds + LDS_MISC);
    { const int e = c.tid & 63, pt = c.tid >> 6; int sa = 0;
      for (int bb = pt * 32; bb < pt * 32 + 32; ++bb) sa += CNT[bb * 64 + e];
      part[pt * 64 + e] = sa; }
    __syncthreads();
    if (c.tid < 64) { int sa = 0;
#pragma unroll
        for (int pt = 0; pt < 8; ++pt) sa += part[pt * 64 + c.tid];
        tot[c.tid] = sa; }
    __syncthreads();
    if (c.tid == 0) { int pos = 0, nt = 0;
        for (int e = 0; e < 64; ++e) { pst[e] = pos; const int n = (tot[e] + 255) >> 8; for (int k = 0; k < n; ++k) misc[1 + nt++] = e; pos += n * 256; }
        misc[0] = nt; }
    __syncthreads();
    for (int rb = c.bid; rb < NTOK / 128; rb += c.G) {
        { const int e = c.tid & 63, pt = c.tid >> 6; int sb = 0;
          for (int bb = pt * 32; bb < pt * 32 + 32; ++bb) { const int v = CNT[bb * 64 + e]; if (bb < rb) sb += v; }
          part[512 + pt * 64 + e] = sb; }
        __syncthreads();
        if (c.tid < 64) { int sb = 0;
#pragma unroll
            for (int pt = 0; pt < 8; ++pt) sb += part[512 + pt * 64 + c.tid];
            bef[c.tid] = sb; }
        if (c.tid < 256) eids[c.tid] = EID[(rb * 128) * 2 + c.tid];
        __syncthreads();
        if (c.tid < 256) { const int e = eids[c.tid]; int rank = 0; for (int a = 0; a < c.tid; ++a) rank += (eids[a] == e) ? 1 : 0;
            const int d = pst[e] + bef[e] + rank; dst[c.tid] = d; SLOT[(rb * 128) * 2 + c.tid] = d; RG[d] = GT[(rb * 128) * 2 + c.tid]; }
        __syncthreads();
        for (int idx = c.tid; idx < 256 * 128; idx += 512) { const int a = idx >> 7, ch = idx & 127; const int tok = rb * 128 + (a >> 1);
            *(u32x4*)(XB + (size_t)dst[a] * DM + ch * 8) = *(const u32x4*)(HB + (size_t)tok * DM + ch * 8); }
        __syncthreads();
    }
}

#define LDS_BARRIER() do { asm volatile("s_waitcnt lgkmcnt(0)" ::: "memory"); __builtin_amdgcn_s_barrier(); asm volatile("" ::: "memory"); } while (0)
__device__ __forceinline__ void phase_attn(LAS unsigned char* lds_) {
    const Ctx c = make_ctx(lds_);
    unsigned char* ws = fresh_params()->ws;
    const bf16_t* Qg = (const bf16_t*)(ws + OFF_R + RA_Q); const bf16_t* Kg = (const bf16_t*)(ws + OFF_R + RA_K); const bf16_t* Vg = (const bf16_t*)(ws + OFF_R + RA_V);
    bf16_t* OG = (bf16_t*)(ws + OFF_R + RA_OG); float* LSE = (float*)(ws + OFF_R + RA_LSE);
    LAS bf16_t* Ks = (LAS bf16_t*)c.lds; LAS bf16_t* Vs = Ks + 384 * 72;
    const int fr = c.lane & 15, fq = c.lane >> 4;
    const int tq = (c.lane & 15) >> 2, tp = c.lane & 3;
    constexpr int NU = NBATCH * 16 * 48;
    u32x4 kreg[6], vreg[6];
#define ATT_DECODE(U) const int bh_ = (U) / 48, sub_ = (U) - bh_ * 48, b = bh_ >> 4, h = bh_ & 15, g = sub_ >> 4, idx_ = sub_ & 15; \
        const int dsh = 2 * g, nqb_ = 16 >> dsh, r = idx_ / nqb_, qb_ = idx_ - r * nqb_; const int lq0 = qb_ * 256, lk0 = lq0 - 128; const size_t tokbase = (size_t)b * SEQ;
#define ATT_LOAD(U) do { ATT_DECODE(U) \
        _Pragma("unroll") for (int k = 0; k < 6; ++k) { const int i_ = c.tid + k * 512, ri_ = i_ >> 3, ch_ = i_ & 7, l_ = lk0 + ri_; \
            if (l_ >= 0) { const size_t ga_ = (tokbase + ((size_t)l_ << dsh) + r) * DM + h * 64 + ch_ * 8; kreg[k] = *(const u32x4*)(Kg + ga_); vreg[k] = *(const u32x4*)(Vg + ga_); } \
            else { kreg[k] = (u32x4){0u, 0u, 0u, 0u}; vreg[k] = (u32x4){0u, 0u, 0u, 0u}; } } } while (0)
    if (c.bid < NU) ATT_LOAD(c.bid);
    for (int u = c.bid; u < NU; u += c.G) {
        ATT_DECODE(u)
        bf16x8 qf[2][2];
#pragma unroll
        for (int grp = 0; grp < 2; ++grp) { const size_t qtok = tokbase + ((size_t)(lq0 + c.wave * 32 + grp * 16 + fr) << dsh) + r;
            qf[grp][0] = *(const bf16x8*)(Qg + qtok * DM + h * 64 + fq * 8); qf[grp][1] = *(const bf16x8*)(Qg + qtok * DM + h * 64 + 32 + fq * 8); }
        LDS_BARRIER();
#pragma unroll
        for (int k = 0; k < 6; ++k) { const int i_ = c.tid + k * 512, ri_ = i_ >> 3, ch_ = i_ & 7; *(LAS u32x4*)(Ks + ri_ * 72 + ch_ * 8) = kreg[k]; *(LAS u32x4*)(Vs + ri_ * 72 + ch_ * 8) = vreg[k]; }
        if (u + c.G < NU) ATT_LOAD(u + c.G);
        LDS_BARRIER();
#pragma unroll
        for (int grp = 0; grp < 2; ++grp) {
            const int l0 = lq0 + c.wave * 32 + grp * 16;
            const size_t qtok = tokbase + ((size_t)(l0 + fr) << dsh) + r;
            const bf16x8 q0 = qf[grp][0], q1 = qf[grp][1];
            const int rb0 = l0 - 128 - lk0;
            const int jmin = (l0 - 128 < 0) ? ((128 - l0) >> 4) : 0;
            f32x4 s[9]; float mx = -3.0e38f;
#pragma unroll
            for (int jb = 0; jb < 9; ++jb) {
                if (jb >= jmin) {
                    const LAS bf16_t* kr = Ks + (rb0 + jb * 16 + fr) * 72 + fq * 8;
                    const bf16x8 k0 = *(const LAS bf16x8*)kr, k1 = *(const LAS bf16x8*)(kr + 32);
                    f32x4 a = {0.f, 0.f, 0.f, 0.f};
                    a = __builtin_amdgcn_mfma_f32_16x16x32_bf16(k0, q0, a, 0, 0, 0);
                    a = __builtin_amdgcn_mfma_f32_16x16x32_bf16(k1, q1, a, 0, 0, 0);
#pragma unroll
                    for (int rg = 0; rg < 4; ++rg) { const int rel = 128 + fr - (16 * jb + 4 * fq + rg); if (rel < 0 || rel > 128) a[rg] = -3.0e38f; mx = fmaxf(mx, a[rg]); }
                    s[jb] = a;
                } else s[jb] = (f32x4){-3.0e38f, -3.0e38f, -3.0e38f, -3.0e38f};
            }
            mx = fmaxf(mx, __shfl_xor(mx, 16)); mx = fmaxf(mx, __shfl_xor(mx, 32));
            float lsum = 0.f;
#pragma unroll
            for (int jb = 0; jb < 9; ++jb)
#pragma unroll
                for (int rg = 0; rg < 4; ++rg) { const float e = __expf(s[jb][rg] - mx); s[jb][rg] = e; lsum += e; }
            lsum += __shfl_xor(lsum, 16); lsum += __shfl_xor(lsum, 32);
            f32x4 o[4];
#pragma unroll
            for (int db = 0; db < 4; ++db) o[db] = (f32x4){0.f, 0.f, 0.f, 0.f};
#pragma unroll
            for (int i = 0; i < 5; ++i) {
                const int jA = 2 * i, jB = 2 * i + 1;
                bf16x8 pf;
                { const unsigned w0 = pk2(s[jA][0], s[jA][1]), w1 = pk2(s[jA][2], s[jA][3]); unsigned w2 = 0u, w3 = 0u;
                  if (jB < 9) { w2 = pk2(s[jB][0], s[jB][1]); w3 = pk2(s[jB][2], s[jB][3]); }
                  pf[0] = (short)(w0 & 0xffff); pf[1] = (short)(w0 >> 16); pf[2] = (short)(w1 & 0xffff); pf[3] = (short)(w1 >> 16);
                  pf[4] = (short)(w2 & 0xffff); pf[5] = (short)(w2 >> 16); pf[6] = (short)(w3 & 0xffff); pf[7] = (short)(w3 >> 16); }
                const int ja = (jA >= jmin) ? jA : 8, jbb = (jB < 9 && jB >= jmin) ? jB : 8;
                const LAS bf16_t* va = Vs + (rb0 + ja * 16 + 4 * fq + tq) * 72 + tp * 4;
                const LAS bf16_t* vb = Vs + (rb0 + jbb * 16 + 4 * fq + tq) * 72 + tp * 4;
#pragma unroll
                for (int db = 0; db < 4; ++db) {
                    const s16x4 x = __builtin_amdgcn_ds_read_tr16_b64_v4i16((LAS s16x4*)(va + db * 16));
                    const s16x4 y = __builtin_amdgcn_ds_read_tr16_b64_v4i16((LAS s16x4*)(vb + db * 16));
                    bf16x8 vf; vf[0] = x[0]; vf[1] = x[1]; vf[2] = x[2]; vf[3] = x[3]; vf[4] = y[0]; vf[5] = y[1]; vf[6] = y[2]; vf[7] = y[3];
                    o[db] = __builtin_amdgcn_mfma_f32_16x16x32_bf16(vf, pf, o[db], 0, 0, 0);
                }
            }
            const float inv = 1.f / lsum;
            bf16_t* op = OG + (size_t)g * NTOK * DM + qtok * DM + h * 64 + 4 * fq;
#pragma unroll
            for (int db = 0; db < 4; ++db) { u32x2 w; w.x = pk2(o[db][0] * inv, o[db][1] * inv); w.y = pk2(o[db][2] * inv, o[db][3] * inv); *(u32x2*)(op + db * 16) = w; }
            if (fq == 0) LSE[(size_t)g * NTOK * 16 + qtok * 16 + h] = mx + __logf(lsum);
        }
    }
#undef ATT_LOAD
#undef ATT_DECODE
}
__device__ __forceinline__ void phase_attn_combine(LAS unsigned char* lds_) {
    const Ctx c = make_ctx(lds_);
    unsigned char* ws = fresh_params()->ws;
    const bf16_t* OG = (const bf16_t*)(ws + OFF_R + RA_OG); const float* LSE = (const float*)(ws + OFF_R + RA_LSE); bf16_t* O = (bf16_t*)(ws + OFF_R + RA_Q);
    for (int row = c.bid * 8 + c.wave; row < NTOK; row += c.G * 8) {
        const int h = c.lane >> 2;
        const float l0 = LSE[(size_t)row * 16 + h], l1 = LSE[(size_t)NTOK * 16 + (size_t)row * 16 + h], l2 = LSE[(size_t)2 * NTOK * 16 + (size_t)row * 16 + h];
        const float m = fmaxf(l0, fmaxf(l1, l2)); float w0 = __expf(l0 - m), w1 = __expf(l1 - m), w2 = __expf(l2 - m); const float iv = 1.f / (w0 + w1 + w2); w0 *= iv; w1 *= iv; w2 *= iv;
        const size_t off = (size_t)row * DM + c.lane * 16;
#pragma unroll
        for (int hf = 0; hf < 2; ++hf) {
            const u32x4 a = *(const u32x4*)(OG + off + hf * 8), bq = *(const u32x4*)(OG + (size_t)NTOK * DM + off + hf * 8), cq = *(const u32x4*)(OG + (size_t)2 * NTOK * DM + off + hf * 8);
            u32x4 o;
#pragma unroll
            for (int k = 0; k < 4; ++k) { const float lo = w0 * bflo(a[k]) + w1 * bflo(bq[k]) + w2 * bflo(cq[k]), hi = w0 * bfhi(a[k]) + w1 * bfhi(bq[k]) + w2 * bfhi(cq[k]); o[k] = pk2(lo, hi); }
            *(u32x4*)(O + off + hf * 8) = o;
        }
    }
}

template <int DK, int DVS, bool ML> struct ScanLds {
    static constexpr int QROW = DK + 8, VROW = DVS + 8;
    static constexpr int QS = 0;
    static constexpr int KS = QS + 64 * QROW * 2;
    static constexpr int VS = KS + 64 * QROW * 2;
    static constexpr int VZ = VS + 64 * VROW * 2;
    static constexpr int PS = VZ + 64 * VROW * 2;
    static constexpr int RBT = PS + 64 * 72 * 2;
    static constexpr int OS = RBT + DVS * QROW * 2;
    static constexpr int SC = OS + 64 * DVS * 4;
    static constexpr int END = SC + 2 * 6 * 64 * 4;
};
template <int DK, int DVS, bool ML>
__device__ __forceinline__ void phase_scan(LAS unsigned char* lds_) {
    const Ctx c = make_ctx(lds_);
    typedef ScanLds<DK, DVS, ML> L; static_assert(L::END <= LDS_BAR, "scan LDS");
    constexpr int QROW = L::QROW, VROW = L::VROW, NCJ = DVS / 16, NRI = DK / 16, NSL = ML ? 4 : 8, NH = ML ? 8 : 4, NRA = (NRI >= 8 ? NRI / 8 : 1);
    constexpr int QCH = 64 * (DK / 8) / 512;
    unsigned char* ws = fresh_params()->ws;
    LAS bf16_t* Qs = (LAS bf16_t*)(c.lds + L::QS); LAS bf16_t* Ksh = (LAS bf16_t*)(c.lds + L::KS); LAS bf16_t* Vs = (LAS bf16_t*)(c.lds + L::VS); LAS bf16_t* Vz = (LAS bf16_t*)(c.lds + L::VZ);
    LAS bf16_t* Ps = (LAS bf16_t*)(c.lds + L::PS); LAS bf16_t* Rbt = (LAS bf16_t*)(c.lds + L::RBT);
    LAS float* Os = (LAS float*)(c.lds + L::OS); LAS float* scb = (LAS float*)(c.lds + L::SC);
    const int fr = c.lane & 15, fq = c.lane >> 4, w = c.wave, tq = (c.lane & 15) >> 2, tp = c.lane & 3;
    for (int u = c.bid; u < NBATCH * NH * NSL; u += c.G) {
        const int b = u / (NH * NSL), h = (u / NSL) % NH, sl = u % NSL;
        __syncthreads();
        for (int i = c.tid; i < DVS * QROW / 2; i += 512) ((LAS unsigned*)Rbt)[i] = 0u;
        for (int i = c.tid; i < 64 * 72 / 2; i += 512) ((LAS unsigned*)Ps)[i] = 0u;
        if (ML) { for (int i = c.tid; i < 64 * VROW; i += 512) { const int cc = i % VROW; Vs[i] = (cc == 32) ? (bf16_t)0x3F80 : (bf16_t)0; Vz[i] = (bf16_t)0; } }
        else if (c.tid < 128) { const float lgm = __logf(1.f - exp2f(-5.f - (float)h)); const int s = c.tid & 63; LAS float* sc = scb + (c.tid >> 6) * 384;
            sc[s] = -(float)s * lgm; sc[64 + s] = -(float)s * lgm; sc[128 + s] = __expf((float)(s + 1) * lgm); sc[192 + s] = __expf((float)(63 - s) * lgm); sc[256 + s] = 0.f; if (s == 0) sc[320] = __expf(64.f * lgm); }
        f32x4 accR[NRA][NCJ];
#pragma unroll
        for (int a = 0; a < NRA; ++a)
#pragma unroll
            for (int q = 0; q < NCJ; ++q) accR[a][q] = (f32x4){0.f, 0.f, 0.f, 0.f};
        float mprev = 0.f;
        const bf16_t* PR = (const bf16_t*)(ws + OFF_R + RB_PROJ);
        const bf16_t* Qg = (const bf16_t*)(ws + OFF_R + RC_Q); const bf16_t* Kg = (const bf16_t*)(ws + OFF_R + RC_K); const bf16_t* Vg = (const bf16_t*)(ws + OFF_R + RC_V);
        const int mrow = (c.tid >> 3) & 63, mcc = c.tid & 7;
        float cwr[2][4][8], cbr[2][8];
        if (ML) { const float* cw = (const float*)(ws + OFF_PAR) + PAR_CONVW; const float* cb = (const float*)(ws + OFF_PAR) + PAR_CONVB;
#pragma unroll
            for (int it = 0; it < 2; ++it) { const int ch0 = it * 512 + h * 64 + mcc * 8;
#pragma unroll
                for (int e = 0; e < 8; ++e) cbr[it][e] = cb[ch0 + e];
#pragma unroll
                for (int j = 0; j < 4; ++j)
#pragma unroll
                    for (int e = 0; e < 8; ++e) cwr[it][j][e] = cw[j * 1024 + ch0 + e]; } }
        u32x4 xr[2][4], qr[QCH > 0 ? QCH : 1], kr[QCH > 0 ? QCH : 1], vr; float gi = 0.f, gf = 0.f;
#define SCAN_LOAD(CH) do { const size_t tok0_ = (size_t)b * SEQ + (size_t)(CH) * 64; \
        if (ML) { _Pragma("unroll") for (int it = 0; it < 2; ++it) { const int ch0 = it * 512 + h * 64 + mcc * 8; \
                _Pragma("unroll") for (int j = 0; j < 4; ++j) { if ((CH) * 64 + mrow - 3 + j >= 0) xr[it][j] = *(const u32x4*)(PR + (tok0_ + mrow - 3 + j) * 3072 + ch0); else xr[it][j] = (u32x4){0u, 0u, 0u, 0u}; } } \
            if (c.tid < 256) vr = *(const u32x4*)(PR + (tok0_ + (c.tid >> 2)) * 3072 + 1024 + h * 128 + sl * 32 + (c.tid & 3) * 8); \
            if (w == 0) { const float* G_ = (const float*)(ws + OFF_GATES) + (tok0_ + c.lane) * 16; gi = G_[h]; gf = G_[8 + h]; } \
        } else { _Pragma("unroll") for (int k = 0; k < QCH; ++k) { const int i_ = c.tid + k * 512, row_ = i_ / (DK / 8), cc_ = i_ - row_ * (DK / 8); \
                qr[k] = *(const u32x4*)(Qg + (tok0_ + row_) * DM + h * DK + cc_ * 8); kr[k] = *(const u32x4*)(Kg + (tok0_ + row_) * DM + h * DK + cc_ * 8); } \
            vr = *(const u32x4*)(Vg + (tok0_ + (c.tid >> 3)) * 2048 + h * 512 + sl * 64 + (c.tid & 7) * 8); } } while (0)
#define SCAN_STORE(NB) do { \
        if (ML) { _Pragma("unroll") for (int it = 0; it < 2; ++it) { float y[8]; \
                _Pragma("unroll") for (int e = 0; e < 8; ++e) y[e] = cbr[it][e]; \
                _Pragma("unroll") for (int j = 0; j < 4; ++j) { const u32x4 x = xr[it][j]; \
                    y[0] += cwr[it][j][0] * bflo(x[0]); y[1] += cwr[it][j][1] * bfhi(x[0]); y[2] += cwr[it][j][2] * bflo(x[1]); y[3] += cwr[it][j][3] * bfhi(x[1]); \
                    y[4] += cwr[it][j][4] * bflo(x[2]); y[5] += cwr[it][j][5] * bfhi(x[2]); y[6] += cwr[it][j][6] * bflo(x[3]); y[7] += cwr[it][j][7] * bfhi(x[3]); } \
                const float ksc = it ? 0.125f : 1.f; \
                _Pragma("unroll") for (int e = 0; e < 8; ++e) y[e] = silu_f(y[e]) * ksc; \
                u32x4 o; o[0] = pk2(y[0], y[1]); o[1] = pk2(y[2], y[3]); o[2] = pk2(y[4], y[5]); o[3] = pk2(y[6], y[7]); \
                *(LAS u32x4*)((it ? Ksh : Qs) + mrow * QROW + mcc * 8) = o; } \
            if (c.tid < 256) *(LAS u32x4*)(Vs + (c.tid >> 2) * VROW + (c.tid & 3) * 8) = vr; \
            if (w == 0) { LAS float* sc = scb + (NB) * 384; \
                const float lf = fminf(gf, 0.f) - log1pf(__expf(-fabsf(gf))); float a = lf; \
                _Pragma("unroll") for (int o = 1; o < 64; o <<= 1) { const float t = __shfl_up(a, o); if (c.lane >= o) a += t; } \
                const float uu = gi - a; float bm = uu; \
                _Pragma("unroll") for (int o = 1; o < 64; o <<= 1) { const float t = __shfl_up(bm, o); if (c.lane >= o) bm = fmaxf(bm, t); } \
                const float bt = fmaxf(mprev, bm), b63 = __shfl(bt, 63), a63 = __shfl(a, 63); \
                sc[c.lane] = uu; sc[64 + c.lane] = bt; sc[128 + c.lane] = __expf(mprev - bt); sc[192 + c.lane] = __expf(uu - b63); sc[256 + c.lane] = __expf(-(a + bt)); \
                if (c.lane == 0) sc[320] = __expf(mprev - b63); \
                mprev = a63 + b63; } \
        } else { _Pragma("unroll") for (int k = 0; k < QCH; ++k) { const int i_ = c.tid + k * 512, row_ = i_ / (DK / 8), cc_ = i_ - row_ * (DK / 8); \
                *(LAS u32x4*)(Qs + row_ * QROW + cc_ * 8) = qr[k]; *(LAS u32x4*)(Ksh + row_ * QROW + cc_ * 8) = kr[k]; } \
            *(LAS u32x4*)(Vs + (c.tid >> 3) * VROW + (c.tid & 7) * 8) = vr; } } while (0)

        SCAN_LOAD(0);
        LDS_BARRIER();
        SCAN_STORE(0);
        LDS_BARRIER();
        for (int ch = 0; ch < 64; ++ch) {
            const size_t tok0 = (size_t)b * SEQ + (size_t)ch * 64;
            LAS float* sc = scb + (ch & 1) * 384;
            LAS float* cu = sc, *rb = sc + 64, *xi = sc + 128, *zeta = sc + 192, *em = sc + 256, *chi = sc + 320;
            if (ch < 63) SCAN_LOAD(ch + 1);
            { constexpr int VCH = (ML ? 32 : 64) / 8;
              if (c.tid < 64 * VCH) { const int row = c.tid / VCH, cc = c.tid - row * VCH; const float z = zeta[row];
                  const u32x4 x = *(const LAS u32x4*)(Vs + row * VROW + cc * 8); u32x4 o;
#pragma unroll
                  for (int e = 0; e < 4; ++e) o[e] = pk2(bflo(x[e]) * z, bfhi(x[e]) * z);
                  *(LAS u32x4*)(Vz + row * VROW + cc * 8) = o; }
              if (ML && c.tid < 64) Vz[c.tid * VROW + 32] = (bf16_t)f2bf(zeta[c.tid]); }
#pragma unroll
            for (int rep = 0; rep < 2; ++rep) {
                const int n = w + 8 * rep;
                if (n < 10) {
                    const int ti = (n >= 6) ? 3 : ((n >= 3) ? 2 : ((n >= 1) ? 1 : 0)), tj = n - ti * (ti + 1) / 2;
                    f32x4 a0 = {0.f, 0.f, 0.f, 0.f};
#pragma unroll
                    for (int ks = 0; ks < DK / 32; ++ks)
                        a0 = __builtin_amdgcn_mfma_f32_16x16x32_bf16(*(const LAS bf16x8*)(Qs + (16 * ti + fr) * QROW + ks * 32 + fq * 8), *(const LAS bf16x8*)(Ksh + (16 * tj + fr) * QROW + ks * 32 + fq * 8), a0, 0, 0, 0);
                    const float cu0 = cu[16 * tj + fr]; const int s0 = 16 * tj + fr;
#pragma unroll
                    for (int rg = 0; rg < 4; ++rg) { const int t = 16 * ti + 4 * fq + rg; Ps[t * 72 + s0] = (bf16_t)f2bf(s0 <= t ? a0[rg] * __expf(cu0 - rb[t]) : 0.f); }
                }
            }
            LDS_BARRIER();
            { const int ti = w >> 1, c0 = (w & 1) ? (NCJ + 1) / 2 : 0, c1 = (w & 1) ? NCJ : (NCJ + 1) / 2;
              const bf16x8 pa0 = *(const LAS bf16x8*)(Ps + (16 * ti + fr) * 72 + fq * 8), pa1 = *(const LAS bf16x8*)(Ps + (16 * ti + fr) * 72 + 32 + fq * 8);
#pragma unroll
              for (int cj = 0; cj < NCJ; ++cj) { if (cj >= c0 && cj < c1) {
                  f32x4 o1 = {0.f, 0.f, 0.f, 0.f}, o2 = {0.f, 0.f, 0.f, 0.f};
#pragma unroll
                  for (int ks = 0; ks < 2; ++ks) { const LAS bf16_t* vp = Vs + (32 * ks + 8 * fq + tq) * VROW + 16 * cj + 4 * tp;
                      const s16x4 x = __builtin_amdgcn_ds_read_tr16_b64_v4i16((LAS s16x4*)vp), y = __builtin_amdgcn_ds_read_tr16_b64_v4i16((LAS s16x4*)(vp + 4 * VROW));
                      bf16x8 vf; vf[0] = x[0]; vf[1] = x[1]; vf[2] = x[2]; vf[3] = x[3]; vf[4] = y[0]; vf[5] = y[1]; vf[6] = y[2]; vf[7] = y[3];
                      o1 = __builtin_amdgcn_mfma_f32_16x16x32_bf16(ks ? pa1 : pa0, vf, o1, 0, 0, 0); }
#pragma unroll
                  for (int ks = 0; ks < DK / 32; ++ks)
                      o2 = __builtin_amdgcn_mfma_f32_16x16x32_bf16(*(const LAS bf16x8*)(Qs + (16 * ti + fr) * QROW + ks * 32 + fq * 8), *(const LAS bf16x8*)(Rbt + (16 * cj + fr) * QROW + ks * 32 + fq * 8), o2, 0, 0, 0);
#pragma unroll
                  for (int rg = 0; rg < 4; ++rg) { const int t = 16 * ti + 4 * fq + rg; Os[t * DVS + 16 * cj + fr] = o1[rg] + xi[t] * o2[rg]; } } } }
            { const float cx = chi[0];
              if (NRI >= 8 || w < NRI) {
#pragma unroll
                  for (int a = 0; a < NRA; ++a) { const int ri = (NRI >= 8) ? w * NRA + a : w;
                      bf16x8 kf[2];
#pragma unroll
                      for (int ks = 0; ks < 2; ++ks) { const LAS bf16_t* kp = Ksh + (32 * ks + 8 * fq + tq) * QROW + 16 * ri + 4 * tp;
                          const s16x4 x = __builtin_amdgcn_ds_read_tr16_b64_v4i16((LAS s16x4*)kp), y = __builtin_amdgcn_ds_read_tr16_b64_v4i16((LAS s16x4*)(kp + 4 * QROW));
                          kf[ks][0] = x[0]; kf[ks][1] = x[1]; kf[ks][2] = x[2]; kf[ks][3] = x[3]; kf[ks][4] = y[0]; kf[ks][5] = y[1]; kf[ks][6] = y[2]; kf[ks][7] = y[3]; }
#pragma unroll
                      for (int cj = 0; cj < NCJ; ++cj) { f32x4 r4 = accR[a][cj] * cx;
#pragma unroll
                          for (int ks = 0; ks < 2; ++ks) { const LAS bf16_t* vp = Vz + (32 * ks + 8 * fq + tq) * VROW + 16 * cj + 4 * tp;
                              const s16x4 x = __builtin_amdgcn_ds_read_tr16_b64_v4i16((LAS s16x4*)vp), y = __builtin_amdgcn_ds_read_tr16_b64_v4i16((LAS s16x4*)(vp + 4 * VROW));
                              bf16x8 vf; vf[0] = x[0]; vf[1] = x[1]; vf[2] = x[2]; vf[3] = x[3]; vf[4] = y[0]; vf[5] = y[1]; vf[6] = y[2]; vf[7] = y[3];
                              r4 = __builtin_amdgcn_mfma_f32_16x16x32_bf16(kf[ks], vf, r4, 0, 0, 0); }
                          accR[a][cj] = r4; } } } }
            LDS_BARRIER();
            if (NRI >= 8 || w < NRI) {
#pragma unroll
                for (int a = 0; a < NRA; ++a) { const int ri = (NRI >= 8) ? w * NRA + a : w;
#pragma unroll
                    for (int cj = 0; cj < NCJ; ++cj) { const f32x4 r4 = accR[a][cj];
                        u32x2 wv; wv.x = pk2(r4[0], r4[1]); wv.y = pk2(r4[2], r4[3]); *(LAS u32x2*)(Rbt + (16 * cj + fr) * QROW + 16 * ri + 4 * fq) = wv; } } }
            if (ML) { bf16_t* OR = (bf16_t*)(ws + OFF_R + RB_ORAW);
                const int t = c.tid >> 3, c4 = (c.tid & 7) * 4; const float den = Os[t * DVS + 32], dn = 1.f / fmaxf(fabsf(den), em[t]);
                const f32x4 x = *(const LAS f32x4*)(Os + t * DVS + c4); u32x2 wv; wv.x = pk2(x[0] * dn, x[1] * dn); wv.y = pk2(x[2] * dn, x[3] * dn);
                *(u32x2*)(OR + (tok0 + t) * DM + h * 128 + sl * 32 + c4) = wv;
            } else { bf16_t* OR = (bf16_t*)(ws + OFF_R + RC_ORAW);
                const int t = c.tid >> 3, c8 = (c.tid & 7) * 8; const f32x4 x0 = *(const LAS f32x4*)(Os + t * DVS + c8), x1 = *(const LAS f32x4*)(Os + t * DVS + c8 + 4);
                u32x4 wv; wv[0] = pk2(x0[0], x0[1]); wv[1] = pk2(x0[2], x0[3]); wv[2] = pk2(x1[0], x1[1]); wv[3] = pk2(x1[2], x1[3]);
                *(u32x4*)(OR + (tok0 + t) * 2048 + h * 512 + sl * 64 + c8) = wv; }
            if (ch < 63) SCAN_STORE((ch + 1) & 1);
            LDS_BARRIER();
        }
#undef SCAN_LOAD
#undef SCAN_STORE
    }
}

__device__ __forceinline__ void phase_norm_b(LAS unsigned char* lds_) {
    const Ctx c = make_ctx(lds_);
    unsigned char* ws = fresh_params()->ws;
    const bf16_t* OR = (const bf16_t*)(ws + OFF_R + RB_ORAW); const bf16_t* PR = (const bf16_t*)(ws + OFF_R + RB_PROJ); bf16_t* ON = (bf16_t*)(ws + OFF_R + RB_ONORM);
    const float* ng = (const float*)(ws + OFF_PAR) + PAR_BNG;
    float gv[16];
#pragma unroll
    for (int k = 0; k < 16; ++k) gv[k] = ng[c.lane * 16 + k];
    for (int row = c.bid * 8 + c.wave; row < NTOK; row += c.G * 8) {
        float x[16], gt[16];
#pragma unroll
        for (int hf = 0; hf < 2; ++hf) { const u32x4 a = *(const u32x4*)(OR + (size_t)row * DM + c.lane * 16 + hf * 8), gq = *(const u32x4*)(PR + (size_t)row * 3072 + 2048 + c.lane * 16 + hf * 8);
#pragma unroll
            for (int k = 0; k < 4; ++k) { x[hf * 8 + 2 * k] = bflo(a[k]); x[hf * 8 + 2 * k + 1] = bfhi(a[k]); gt[hf * 8 + 2 * k] = bflo(gq[k]); gt[hf * 8 + 2 * k + 1] = bfhi(gq[k]); } }
        float s = 0.f;
#pragma unroll
        for (int k = 0; k < 16; ++k) s += x[k];
        s += __shfl_xor(s, 1); s += __shfl_xor(s, 2); s += __shfl_xor(s, 4);
        const float mu = s * (1.f / 128.f); float q = 0.f;
#pragma unroll
        for (int k = 0; k < 16; ++k) { x[k] -= mu; q += x[k] * x[k]; }
        q += __shfl_xor(q, 1); q += __shfl_xor(q, 2); q += __shfl_xor(q, 4);
        const float rstd = 1.f / sqrtf(q * (1.f / 128.f) + LN_EPS);
        u32x4 o0, o1;
#pragma unroll
        for (int k = 0; k < 4; ++k) { o0[k] = pk2(x[2 * k] * rstd * gv[2 * k] * sigmoid_f(gt[2 * k]), x[2 * k + 1] * rstd * gv[2 * k + 1] * sigmoid_f(gt[2 * k + 1]));
            o1[k] = pk2(x[8 + 2 * k] * rstd * gv[8 + 2 * k] * sigmoid_f(gt[8 + 2 * k]), x[9 + 2 * k] * rstd * gv[9 + 2 * k] * sigmoid_f(gt[9 + 2 * k])); }
        *(u32x4*)(ON + (size_t)row * DM + c.lane * 16) = o0; *(u32x4*)(ON + (size_t)row * DM + c.lane * 16 + 8) = o1;
    }
}
__device__ __forceinline__ void phase_norm_c(LAS unsigned char* lds_) {
    const Ctx c = make_ctx(lds_);
    unsigned char* ws = fresh_params()->ws;
    const bf16_t* OR = (const bf16_t*)(ws + OFF_R + RC_ORAW); const bf16_t* GG = (const bf16_t*)(ws + OFF_R + RC_G); bf16_t* ON = (bf16_t*)(ws + OFF_R + RC_V);
    const float* ng = (const float*)(ws + OFF_PAR) + PAR_CNG;
    for (int row = c.bid * 8 + c.wave; row < NTOK; row += c.G * 8) {
        float x[32];
#pragma unroll
        for (int qd = 0; qd < 4; ++qd) { const u32x4 a = *(const u32x4*)(OR + (size_t)row * 2048 + c.lane * 32 + qd * 8);
#pragma unroll
            for (int k = 0; k < 4; ++k) { x[qd * 8 + 2 * k] = bflo(a[k]); x[qd * 8 + 2 * k + 1] = bfhi(a[k]); } }
        float s = 0.f;
#pragma unroll
        for (int k = 0; k < 32; ++k) s += x[k];
        s += __shfl_xor(s, 1); s += __shfl_xor(s, 2); s += __shfl_xor(s, 4); s += __shfl_xor(s, 8);
        const float mu = s * (1.f / 512.f); float q = 0.f;
#pragma unroll
        for (int k = 0; k < 32; ++k) { x[k] -= mu; q += x[k] * x[k]; }
        q += __shfl_xor(q, 1); q += __shfl_xor(q, 2); q += __shfl_xor(q, 4); q += __shfl_xor(q, 8);
        const float rstd = 1.f / sqrtf(q * (1.f / 512.f) + LN_EPS);
#pragma unroll
        for (int qd = 0; qd < 4; ++qd) { const u32x4 gq = *(const u32x4*)(GG + (size_t)row * 2048 + c.lane * 32 + qd * 8);
            const f32x4 g0 = *(const f32x4*)(ng + c.lane * 32 + qd * 8), g1 = *(const f32x4*)(ng + c.lane * 32 + qd * 8 + 4);
            u32x4 o;
#pragma unroll
            for (int k = 0; k < 4; ++k) { const float ga = (k < 2) ? g0[2 * k] : g1[2 * k - 4], gb = (k < 2) ? g0[2 * k + 1] : g1[2 * k - 3];
                o[k] = pk2(x[qd * 8 + 2 * k] * rstd * ga * silu_f(bflo(gq[k])), x[qd * 8 + 2 * k + 1] * rstd * gb * silu_f(bfhi(gq[k]))); }
            *(u32x4*)(ON + (size_t)row * 2048 + c.lane * 32 + qd * 8) = o; }
    }
}

#define WS_FRESH() unsigned char* ws = fresh_params()->ws
__device__ __forceinline__ void gemm_qkv_a(LAS unsigned char* lds_, int jj) { const Ctx c = make_ctx(lds_); jj = __builtin_amdgcn_readfirstlane(jj); asm volatile("" : "+s"(jj)); WS_FRESH();
    pg8::Gemm g{(const pg8::bf16_t*)(ws + OFF_HB), (const pg8::bf16_t*)(ws + OFF_WA_IN) + (size_t)jj * 3072 * 1024, NTOK, 3072, 1024}; pg8::StaticOrder S; S.init(NTOK, 3072, c.G, c.bid);
    pg8::EpiQkvA E{(bf16_t*)(ws + OFF_R + RA_Q), SZ_TOK1K / 2, (const float*)(ws + OFF_COSA), (const float*)(ws + OFF_SINA)};
    pg8::gemm_phase<pg8::EpiQkvA, pg8::StaticOrder, true, true>(c.lds, g, S, E, c.tid); }
__device__ __forceinline__ void gemm_proj_b(LAS unsigned char* lds_) { const Ctx c = make_ctx(lds_); WS_FRESH();
    pg8::Gemm g{(const pg8::bf16_t*)(ws + OFF_HB), (const pg8::bf16_t*)(ws + OFF_WB_IN), NTOK, 3072, 1024}; pg8::StaticOrder S; S.init(NTOK, 3072, c.G, c.bid);
    pg8::EpiBf16Plain E{(bf16_t*)(ws + OFF_R + RB_PROJ), 3072};
    pg8::gemm_phase<pg8::EpiBf16Plain, pg8::StaticOrder, true, true>(c.lds, g, S, E, c.tid); }
__device__ __forceinline__ void gemm_proj_c(LAS unsigned char* lds_) { const Ctx c = make_ctx(lds_); WS_FRESH();
    pg8::Gemm g{(const pg8::bf16_t*)(ws + OFF_HB), (const pg8::bf16_t*)(ws + OFF_WC_IN), NTOK, 6144, 1024}; pg8::StaticOrder S; S.init(NTOK, 6144, c.G, c.bid);
    pg8::EpiProjC E{(bf16_t*)(ws + OFF_R + RC_Q), (bf16_t*)(ws + OFF_R + RC_V), (RC_K - RC_Q) / 2, (RC_G - RC_V) / 2, (const float*)(ws + OFF_COSC), (const float*)(ws + OFF_SINC)};
    pg8::gemm_phase<pg8::EpiProjC, pg8::StaticOrder, true, true>(c.lds, g, S, E, c.tid); }
__device__ __forceinline__ void gemm_out(LAS unsigned char* lds_, int kind, int jj, bool first) { const Ctx c = make_ctx(lds_); kind = __builtin_amdgcn_readfirstlane(kind); asm volatile("" : "+s"(kind)); jj = __builtin_amdgcn_readfirstlane(jj); asm volatile("" : "+s"(jj)); WS_FRESH();
    const size_t aoff = OFF_R + (kind == 0 ? RA_Q : (kind == 1 ? RB_ONORM : RC_V));
    const size_t boff = kind == 0 ? OFF_WA_OUT + (size_t)jj * 1024 * 1024 * 2 : (kind == 1 ? OFF_WB_OUT : OFF_WC_OUT);
    pg8::Gemm g{(const pg8::bf16_t*)(ws + aoff), (const pg8::bf16_t*)(ws + boff), NTOK, 1024, kind == 2 ? 2048 : 1024}; pg8::StaticOrder S; S.init(NTOK, 1024, c.G, c.bid);
    pg8::EpiResidual E{first ? fresh_params()->in[0] : (const float*)(ws + OFF_H), (float*)(ws + OFF_H), DN_ALPHA};
    pg8::gemm_phase<pg8::EpiResidual, pg8::StaticOrder, true, true>(c.lds, g, S, E, c.tid); }
__device__ __forceinline__ void gemm_moe_gu(LAS unsigned char* lds_) { const Ctx c = make_ctx(lds_); WS_FRESH();
    const LAS int* misc = (const LAS int*)(c.lds + LDS_MISC); const int ntiles = __builtin_amdgcn_readfirstlane(misc[0]);
    pg8::Gemm g{(const pg8::bf16_t*)(ws + OFF_R + RM_XB), (const pg8::bf16_t*)(ws + OFF_WE_GU), 0, 0, 1024};
    pg8::MoeOrder S{misc + 1, ntiles, 2, 2, c.G, c.bid}; pg8::EpiMoeGU E{(bf16_t*)(ws + OFF_R + RM_HID)};
    pg8::gemm_phase<pg8::EpiMoeGU, pg8::MoeOrder, true, true>(c.lds, g, S, E, c.tid); }
__device__ __forceinline__ void gemm_moe_down(LAS unsigned char* lds_) { const Ctx c = make_ctx(lds_); WS_FRESH();
    const LAS int* misc = (const LAS int*)(c.lds + LDS_MISC); const int ntiles = __builtin_amdgcn_readfirstlane(misc[0]);
    pg8::Gemm g{(const pg8::bf16_t*)(ws + OFF_R + RM_HID), (const pg8::bf16_t*)(ws + OFF_WE_D), 0, 0, 256};
    pg8::MoeOrder S{misc + 1, ntiles, 4, 4, c.G, c.bid}; pg8::EpiMoeDown E{(bf16_t*)(ws + OFF_R + RM_YEXP), (const float*)(ws + OFF_ROWGATE)};
    pg8::gemm_phase<pg8::EpiMoeDown, pg8::MoeOrder, true, true>(c.lds, g, S, E, c.tid); }


#define XB_TMO      128
#define XB_XCNT(j)  (256  + 64 * (j))
#define XB_XSUB(j)  (1280 + 64 * (j))
#define XB_XGEN(j)  (2304 + 64 * (j))
#define XB_TOP      3328
#define XB_TOPGEN   3392
#define XCD_BAR_WORDS 3456
#define XB_SPIN_CAP (1u << 22)
__device__ __forceinline__ unsigned xb_ld(unsigned* p)              { return __hip_atomic_load(p, __ATOMIC_RELAXED, __HIP_MEMORY_SCOPE_AGENT); }
__device__ __forceinline__ unsigned xb_add(unsigned* p, unsigned v) { return __hip_atomic_fetch_add(p, v, __ATOMIC_RELAXED, __HIP_MEMORY_SCOPE_AGENT); }
__device__ __forceinline__ unsigned xb_xcc_id() { return (unsigned)__builtin_amdgcn_s_getreg((3 << 11) | 20) & 0xFu; }
#define XB_SPIN(cond, bar) do { unsigned _sp = 0; while (cond) { __builtin_amdgcn_s_sleep(1); \
    if ((++_sp & 255u) == 0u) { if (xb_ld(&(bar)[XB_TMO])) break; if (_sp > XB_SPIN_CAP) { atomicAdd(&(bar)[XB_TMO], 1u); break; } } } } while (0)
__device__ __forceinline__ void xcd_barrier_post(LAS unsigned char* lds) {
    unsigned* bar = (unsigned*)(fresh_params()->ws + OFF_BAR);
    if (threadIdx.x == 0) { volatile LAS unsigned* st = (volatile LAS unsigned*)(lds + LDS_BAR); st[0] = 0u; st[1] = 0u; (void)xb_add(&bar[XB_XCNT(xb_xcc_id())], 1u); }
    __syncthreads();
}
__device__ __forceinline__ void xcd_barrier_complete(unsigned* bar, unsigned x, unsigned& nloc, unsigned& nx) {
    const unsigned G = gridDim.x * gridDim.y * gridDim.z;
    unsigned sum, cnt, mine, sp = 0u;
    for (;;) {
        sum = 0u; cnt = 0u; mine = 0u;
#pragma unroll
        for (unsigned j = 0; j < 16; ++j) { const unsigned c = xb_ld(&bar[XB_XCNT(j)]); sum += c; cnt += (c > 0u) ? 1u : 0u; mine = (j == x) ? c : mine; }
        if (sum == G) break;
        __builtin_amdgcn_s_sleep(1);
        if ((++sp & 255u) == 0u) { if (xb_ld(&bar[XB_TMO])) break; if (sp > XB_SPIN_CAP) { atomicAdd(&bar[XB_TMO], 1u); break; } }
    }
    nloc = mine > 0u ? mine : 1u; nx = cnt > 0u ? cnt : 1u;
}
__device__ __forceinline__ void xcd_barrier(LAS unsigned char* lds) {
    unsigned* bar = (unsigned*)(fresh_params()->ws + OFF_BAR);
    asm volatile("s_waitcnt vmcnt(0)" ::: "memory");
    __syncthreads();
    if (threadIdx.x == 0) {
        const unsigned x = xb_xcc_id(); volatile LAS unsigned* st = (volatile LAS unsigned*)(lds + LDS_BAR);
        __builtin_amdgcn_s_waitcnt(0);
        unsigned nloc = st[0], nx = st[1];
        if (nloc == 0u) { xcd_barrier_complete(bar, x, nloc, nx); st[0] = nloc; st[1] = nx; }
        const unsigned old = xb_add(&bar[XB_XSUB(x)], 1u);
        const unsigned gen = old / nloc;
        if (old + 1u == (gen + 1u) * nloc) {
            __builtin_amdgcn_fence(__ATOMIC_RELEASE, "agent");
            asm volatile("s_waitcnt vmcnt(0)" ::: "memory");
            const unsigned og = xb_add(&bar[XB_TOP], 1u);
            const unsigned tg = og / nx;
            if (og + 1u == (tg + 1u) * nx) xb_add(&bar[XB_TOPGEN], 1u);
            else XB_SPIN(xb_ld(&bar[XB_TOPGEN]) == tg, bar);
            __builtin_amdgcn_fence(__ATOMIC_ACQUIRE, "agent");
            xb_add(&bar[XB_XGEN(x)], 1u);
            asm volatile("s_waitcnt vmcnt(0)" ::: "memory");
        } else {
            XB_SPIN(xb_ld(&bar[XB_XGEN(x)]) == gen, bar);
            __builtin_amdgcn_fence(__ATOMIC_ACQUIRE, "agent");
            asm volatile("s_waitcnt vmcnt(0)" ::: "memory");
        }
    }
    __syncthreads();
}
#ifdef USE_CG_SYNC
#define GRID_SYNC() grid.sync()
#else
#define GRID_SYNC() xcd_barrier(lds)
#endif

#ifdef DBL_SYNC
#define STAMP(type) GRID_SYNC()
#elif defined(PROBE_A)
#define STAMP(type) do { if (blockIdx.x == 0 && threadIdx.x == 0) { const unsigned long long t_ = __builtin_amdgcn_s_memrealtime(); unsigned long long* TS_ = (unsigned long long*)(fresh_params()->ws + OFF_CTL + 131072); TS_[32 + (type)] += t_ - TS_[0]; TS_[0] = t_; } } while (0)
#else
#define STAMP(type) do { } while (0)
#endif
__global__ void __launch_bounds__(512, 2) fwd_megakernel(Params p) {
    extern __shared__ __attribute__((aligned(16))) unsigned char lds_raw[];
    cg::grid_group grid = cg::this_grid();
    LAS unsigned char* lds = (LAS unsigned char*)lds_raw;
#ifdef PROBE_A
    if (blockIdx.x == 0 && threadIdx.x == 0) { unsigned long long* TS_ = (unsigned long long*)(fresh_params()->ws + OFF_CTL + 131072); for (int i = 0; i < 32; ++i) TS_[32 + i] = 0ull; TS_[0] = __builtin_amdgcn_s_memrealtime(); }
#endif

    xcd_barrier_post(lds);
    phase_prologue(lds);
#ifdef DBL_PRO
    grid.sync();
    phase_prologue(lds);
#endif
    grid.sync(); STAMP(0);

#pragma unroll 1
    for (int layer = 0; layer < DEPTH; ++layer) {
        const int kind = layer % 3, jj = layer / 3;
        const bool mix_on = (kind == 0) ? (EN_MIX_A != 0) : (kind == 1 ? (EN_MIX_B != 0) : (EN_MIX_C != 0));
        if (mix_on) {
            if (kind == 0) {
#if EN_MIX_A
                gemm_qkv_a(lds, jj);
#ifdef DBL_INPROJ
                GRID_SYNC();
                gemm_qkv_a(lds, jj);
#endif
                GRID_SYNC(); STAMP(1);
                phase_attn(lds);
#ifdef DBL_ATTN
                GRID_SYNC();
                phase_attn(lds);
#endif
                GRID_SYNC(); STAMP(2);
                phase_attn_combine(lds);
#ifdef DBL_NORMS
                GRID_SYNC();
                phase_attn_combine(lds);
#endif
                GRID_SYNC(); STAMP(3);
#endif
            } else if (kind == 1) {
#if EN_MIX_B
                gemm_proj_b(lds);
#ifdef DBL_INPROJ
                GRID_SYNC();
                gemm_proj_b(lds);
#endif
                GRID_SYNC(); STAMP(4);
                phase_scan<64, 48, true>(lds);
#ifdef DBL_SCANB
                GRID_SYNC();
                phase_scan<64, 48, true>(lds);
#endif
                GRID_SYNC(); STAMP(5);
                phase_norm_b(lds);
#ifdef DBL_NORMS
                GRID_SYNC();
                phase_norm_b(lds);
#endif
                GRID_SYNC(); STAMP(6);
#endif
            } else {
#if EN_MIX_C
                gemm_proj_c(lds);
#ifdef DBL_INPROJ
                GRID_SYNC();
                gemm_proj_c(lds);
#endif
                GRID_SYNC(); STAMP(7);
                phase_scan<256, 64, false>(lds);
#ifdef DBL_SCANC
                GRID_SYNC();
                phase_scan<256, 64, false>(lds);
#endif
                GRID_SYNC(); STAMP(8);
                phase_norm_c(lds);
#ifdef DBL_NORMS
                GRID_SYNC();
                phase_norm_c(lds);
#endif
                GRID_SYNC(); STAMP(9);
#endif
            }
            gemm_out(lds, kind, jj, layer == 0);
            GRID_SYNC(); STAMP(10);
        }
        phase_ln1_router(lds, layer, mix_on, EN_MOE != 0);
        GRID_SYNC(); STAMP(11);
#if EN_MOE
        convert_experts(lds, layer);
        __syncthreads();
        phase_moe_scan(lds);
#ifdef DBL_MOESCAN
        GRID_SYNC();
        convert_experts(lds, layer);
        __syncthreads();
        phase_moe_scan(lds);
#endif
        GRID_SYNC(); STAMP(12);
        gemm_moe_gu(lds);
#ifdef DBL_MOEGEMM
        GRID_SYNC();
        gemm_moe_gu(lds);
#endif
        GRID_SYNC(); STAMP(13);
        gemm_moe_down(lds);
#ifdef DBL_MOEGEMM
        GRID_SYNC();
        gemm_moe_down(lds);
#endif
        GRID_SYNC(); STAMP(14);
#endif
        phase_ln2(lds, layer, layer == DEPTH - 1, EN_MOE != 0, (layer + 1 < DEPTH) && ((layer + 1) % 3 == 1) && (EN_MIX_B != 0));
        GRID_SYNC(); STAMP(15);
    }
#ifdef PROBE_A
    GRID_SYNC();
    { ParamsK q = fresh_params(); const unsigned long long* TS_ = (const unsigned long long*)(q->ws + OFF_CTL + 131072);
      const float ta = (float)__hip_atomic_load(TS_ + 32 + PROBE_A, __ATOMIC_RELAXED, __HIP_MEMORY_SCOPE_AGENT) * 0.01f, tb = (float)__hip_atomic_load(TS_ + 32 + PROBE_B, __ATOMIC_RELAXED, __HIP_MEMORY_SCOPE_AGENT) * 0.01f;
      const float dl = sqrtf(tb * 1e-4f); float* o = q->out;
      for (size_t i = (size_t)blockIdx.x * 512 + threadIdx.x; i < (size_t)NTOK * DM; i += (size_t)gridDim.x * 512) o[i] = (i == 0) ? 20.f + 0.1f * ta : o[i] + dl; }
#endif
}

extern "C" void kernel_launch(void* const* d_in, const int* in_sizes, int n_in, void* d_out, int out_size, void* d_ws, size_t ws_size, hipStream_t stream) {
    static int grid = 0;
    if (grid == 0) {
        if (n_in != 24 || in_sizes[0] != NTOK * DM || out_size != NTOK * DM || ws_size < WS_END) {
            fprintf(stderr, "kernel_launch: built for 24 inputs, x/out of %d floats, >= %zu bytes of workspace; got n_in %d, in0 %d, out %d, ws %zu; nothing launched\n", NTOK * DM, (size_t)WS_END, n_in, n_in > 0 ? in_sizes[0] : -1, out_size, ws_size);
            grid = -1; return; }
        int dev = 0, cus = 0, per_cu = 0;
        if (hipGetDevice(&dev) != hipSuccess || hipDeviceGetAttribute(&cus, hipDeviceAttributeMultiprocessorCount, dev) != hipSuccess) { fprintf(stderr, "kernel_launch: device query failed\n"); grid = -1; return; }
        if (hipFuncSetAttribute((const void*)fwd_megakernel, hipFuncAttributeMaxDynamicSharedMemorySize, LDS_BYTES) != hipSuccess) { fprintf(stderr, "kernel_launch: hipFuncSetAttribute(%d B LDS) failed\n", LDS_BYTES); grid = -1; return; }
        if (hipOccupancyMaxActiveBlocksPerMultiprocessor(&per_cu, (const void*)fwd_megakernel, 512, LDS_BYTES) != hipSuccess || per_cu < 1) { fprintf(stderr, "kernel_launch: occupancy query says %d blocks per CU\n", per_cu); (void)hipGetLastError(); per_cu = 1; }
        grid = cus * (per_cu > 1 ? 1 : per_cu);
    }
    if (grid < 0) return;
    Params p{};
    for (int i = 0; i < 24; ++i) p.in[i] = (const float*)d_in[i];
    p.out = (float*)d_out; p.ws = (unsigned char*)d_ws;
    for (int i = 0; i < 8; ++i) p.invA[i] = pow(500000.0, -(double)(2 * i) / 16.0);
    for (int i = 0; i < 128; ++i) p.invC[i] = pow(10000.0, -(double)(2 * i) / 256.0);
    if (hipMemsetAsync((char*)d_ws + OFF_BAR, 0, 16384, stream) != hipSuccess) { fprintf(stderr, "kernel_launch: hipMemsetAsync of the barrier words failed\n"); return; }
    void* args[] = {&p};
    const hipError_t e = hipLaunchCooperativeKernel((const void*)fwd_megakernel, dim3(grid), dim3(512), args, LDS_BYTES, stream);
    if (e != hipSuccess) fprintf(stderr, "kernel_launch: cooperative launch failed: %s (grid %d, %d B LDS)\n", hipGetErrorString(e), grid, LDS_BYTES);
}
```

```cpp
#define EN_MIX_A 1
#define EN_MIX_B 1
#define EN_MIX_C 1
#define EN_MOE 1
#include <hip/hip_runtime.h>
#include <hip/hip_cooperative_groups.h>
#include <cstdio>
#include <cstdint>
#include <cmath>
namespace cg = cooperative_groups;

#ifndef EN_MIX_A
#define EN_MIX_A 1
#endif
#ifndef EN_MIX_B
#define EN_MIX_B 1
#endif
#ifndef EN_MIX_C
#define EN_MIX_C 1
#endif
#ifndef EN_MOE
#define EN_MOE 1
#endif

#define LAS __attribute__((address_space(3)))
typedef unsigned short bf16_t;
typedef short bf16x8 __attribute__((ext_vector_type(8)));
typedef short s16x4 __attribute__((ext_vector_type(4)));
typedef float f32x4 __attribute__((ext_vector_type(4)));
typedef float f32x2 __attribute__((ext_vector_type(2)));
typedef unsigned u32x4 __attribute__((ext_vector_type(4)));
typedef unsigned u32x2 __attribute__((ext_vector_type(2)));

constexpr int NTOK = 32768, DM = 1024, SEQ = 4096, NBATCH = 8, DEPTH = 4;
constexpr float DN_ALPHA = 1.6817928305074292f;
constexpr float LN_EPS = 1e-5f;
constexpr int MOE_MAXROWS = 81920;
constexpr int MOE_MAXTILES = 320;

constexpr size_t al256(size_t x) { return (x + 255) & ~(size_t)255; }
constexpr size_t OFF_CTL = 0, SZ_CTL = 1u << 20;
constexpr size_t OFF_COSA = OFF_CTL + SZ_CTL;
constexpr size_t OFF_SINA = OFF_COSA + (size_t)SEQ * 8 * 4;
constexpr size_t OFF_COSC = OFF_SINA + (size_t)SEQ * 8 * 4;
constexpr size_t OFF_SINC = OFF_COSC + (size_t)SEQ * 128 * 4;
constexpr size_t OFF_PAR = OFF_SINC + (size_t)SEQ * 128 * 4;
constexpr int PAR_LN1G = 0, PAR_LN1B = 4096, PAR_LN2G = 8192, PAR_LN2B = 12288, PAR_GBIAS = 16384, PAR_CONVW = 16400, PAR_CONVB = 20496, PAR_BNG = 21520, PAR_CNG = 22544, PAR_RGB = 24592, PAR_REB = 24624, PAR_END = 24880;
constexpr size_t OFF_WG = OFF_PAR + (size_t)25088 * 4;
constexpr size_t OFF_WR = OFF_WG + 16 * 1024 * 4;
constexpr size_t OFF_WA_IN = OFF_WR + (size_t)4 * 2 * 80 * 1024 * 2;
constexpr size_t OFF_WA_OUT = OFF_WA_IN + (size_t)2 * 3072 * 1024 * 2;
constexpr size_t OFF_WB_IN = OFF_WA_OUT + (size_t)2 * 1024 * 1024 * 2;
constexpr size_t OFF_WB_OUT = OFF_WB_IN + (size_t)3072 * 1024 * 2;
constexpr size_t OFF_WC_IN = OFF_WB_OUT + (size_t)1024 * 1024 * 2;
constexpr size_t OFF_WC_OUT = OFF_WC_IN + (size_t)6144 * 1024 * 2;
constexpr size_t OFF_WE_GU = OFF_WC_OUT + (size_t)1024 * 2048 * 2;
constexpr size_t OFF_WE_D = OFF_WE_GU + (size_t)64 * 512 * 1024 * 2;
constexpr size_t OFF_H = OFF_WE_D + (size_t)64 * 1024 * 256 * 2;
constexpr size_t OFF_HB = OFF_H + (size_t)NTOK * DM * 4;
constexpr size_t OFF_GATES = OFF_HB + (size_t)NTOK * DM * 2;
constexpr size_t OFF_EID = OFF_GATES + (size_t)NTOK * 16 * 4;
constexpr size_t OFF_GATE = OFF_EID + (size_t)NTOK * 2 * 4;
constexpr size_t OFF_SLOT = OFF_GATE + (size_t)NTOK * 2 * 4;
constexpr size_t OFF_ROWGATE = OFF_SLOT + (size_t)NTOK * 2 * 4;
constexpr size_t OFF_ROWTOK = OFF_ROWGATE + (size_t)MOE_MAXROWS * 4;
constexpr size_t OFF_R = al256(OFF_ROWTOK + (size_t)MOE_MAXROWS * 4);
constexpr size_t SZ_TOK1K = (size_t)NTOK * 1024 * 2;
constexpr size_t RA_Q = 0, RA_K = SZ_TOK1K, RA_V = 2 * SZ_TOK1K, RA_OG = 3 * SZ_TOK1K, RA_LSE = 6 * SZ_TOK1K;
constexpr size_t RB_PROJ = 0, RB_ORAW = 3 * SZ_TOK1K, RB_ONORM = 4 * SZ_TOK1K;
constexpr size_t RC_Q = 0, RC_K = SZ_TOK1K, RC_V = 2 * SZ_TOK1K, RC_G = 4 * SZ_TOK1K, RC_ORAW = 6 * SZ_TOK1K;
constexpr size_t RM_XB = 0, RM_HID = (size_t)MOE_MAXROWS * 1024 * 2, RM_YEXP = RM_HID + (size_t)MOE_MAXROWS * 256 * 2;
constexpr size_t SZ_R = 8 * SZ_TOK1K;
constexpr size_t WS_END = OFF_R + SZ_R;
static_assert(RA_LSE + (size_t)3 * NTOK * 16 * 4 <= SZ_R && RM_YEXP + (size_t)MOE_MAXROWS * 1024 * 2 <= SZ_R, "region R");

constexpr int LDS_BYTES = 163840;
constexpr int LDS_MISC = 131072;
constexpr int LDS_BAR = LDS_BYTES - 256;
constexpr size_t OFF_BAR = OFF_CTL + 262144;

__device__ __forceinline__ unsigned f2bf(float f) { unsigned u = __builtin_bit_cast(unsigned, f); return (u + 0x7fffu + ((u >> 16) & 1u)) >> 16; }
typedef __bf16 bf16x2_t __attribute__((ext_vector_type(2)));
__device__ __forceinline__ unsigned pk2(float lo, float hi) { const f32x2 v = {lo, hi}; return __builtin_bit_cast(unsigned, __builtin_convertvector(v, bf16x2_t)); }
__device__ __forceinline__ float bf2f(unsigned short b) { return __builtin_bit_cast(float, (unsigned)b << 16); }
__device__ __forceinline__ float bflo(unsigned w) { return __builtin_bit_cast(float, w << 16); }
__device__ __forceinline__ float bfhi(unsigned w) { return __builtin_bit_cast(float, w & 0xffff0000u); }
__device__ __forceinline__ float wave_sum(float v) {
#pragma unroll
    for (int o = 1; o < 64; o <<= 1) v += __shfl_xor(v, o);
    return v;
}
__device__ __forceinline__ float silu_f(float x) { return x / (1.f + __expf(-x)); }
__device__ __forceinline__ float sigmoid_f(float x) { return 1.f / (1.f + __expf(-x)); }

namespace pg8 {
#define PG8_LAS __attribute__((address_space(3)))
typedef unsigned short bf16_t;
typedef short bf16x8 __attribute__((ext_vector_type(8)));
typedef float f32x4 __attribute__((ext_vector_type(4)));
typedef unsigned u32x4 __attribute__((ext_vector_type(4)));
constexpr int BM = 256, BK = 64, HALF = 128, HTB = HALF * BK * 2  , STAGE_BYTES = 8 * HTB, NXCD = 8, WGM = 8;

__host__ __device__ __forceinline__ int lds_byte(int r, int c) { const int st = (r >> 4) * 2 + (c >> 5), rr = r & 15, cc = c & 31, ob = rr * 64 + cc * 2; return st * 1024 + (ob ^ (((ob >> 9) & 1) << 5)); }
__host__ __device__ __forceinline__ void stage_rc(int b, int& R, int& C) { const int st = b / 1024, sb = b % 1024, swz = sb ^ (((sb >> 9) & 1) << 5); R = (st >> 1) * 16 + swz / 64; C = (st & 1) * 32 + (swz % 64) / 2; }
__host__ __device__ __forceinline__ int perm32(int rho) { const int n = rho >> 4, i = rho & 15; return 8 * (i >> 2) + 4 * n + (i & 3); }

struct Unit { int pm, pn, pb; };
struct Gemm { const bf16_t* A; const bf16_t* Bt; int M, N, K; const PG8_LAS int* rowtab; };

struct StaticOrder {
    int nM, nN, nwg, G, c;
    __host__ __device__ void init(int M, int N, int G_, int c_) { nM = M / BM; nN = N / BM; nwg = nM * nN; G = G_; c = c_; }
    __host__ __device__ bool next(int i, Unit& u) const {
        const long L = (long)i * G + c; if (L >= nwg) return false;
        int wgid = (int)L; { const int q = nwg / NXCD, r = nwg % NXCD, xcd = wgid % NXCD, off = wgid / NXCD; wgid = (xcd < r ? xcd * (q + 1) : r * (q + 1) + (xcd - r) * q) + off; }
        const int nig = WGM * nN, gid = wgid / nig, fm = gid * WGM, gsz = (nM - fm) < WGM ? (nM - fm) : WGM;
        u.pm = fm + ((wgid % nig) % gsz); u.pn = (wgid % nig) / gsz; u.pb = u.pn; return true;
    }
    __device__ __forceinline__ void a_ready(const Unit&) const {}
    __device__ __forceinline__ void done(const Unit&) const {}
};
__device__ __forceinline__ unsigned cvt_pk_bf16(float lo, float hi) { unsigned r; asm volatile("v_cvt_pk_bf16_f32 %0, %1, %2" : "=v"(r) : "v"(lo), "v"(hi)); return r; }
typedef float f32x2 __attribute__((ext_vector_type(2)));
template <class Epi, class Sched, bool ALIGN_EPI = false, bool SP2 = false, bool GATHER = false>
__device__ __forceinline__ void gemm_phase(PG8_LAS unsigned char* lds, const Gemm g, const Sched& S, const Epi& E, const int tid) {
    const int wid = __builtin_amdgcn_readfirstlane(tid >> 6), lane = tid & 63, wr = wid >> 2, wc = wid & 3, fr = lane & 15, fq = lane >> 4;
    const int K = g.K, nt = K / BK;
    unsigned voffA[2], voffB[2];
#pragma unroll
    for (int i = 0; i < 2; ++i) { int R, C; stage_rc(tid * 16 + i * 8192, R, C); const int Rb = Epi::PERM ? ((R & ~31) + perm32(R & 31)) : R;
        voffA[i] = (unsigned)(R * K + C) * 2u; voffB[i] = (unsigned)(Rb * K + C) * 2u; }
    const size_t kstep = (size_t)(BK * 2);
    const size_t hstep = (size_t)HALF * K * 2;
    const size_t tstep = 2 * hstep;
    const unsigned ldsw = (unsigned)wid * 1024u;
    const int aoff = lds_byte(wr * 64 + fr, fq * 8), boff = lds_byte(wc * 32 + fr, fq * 8);
#define PG8_SA(b, h) (((b) * 2 + (h)) * HTB)
#define PG8_SB(b, h) ((4 + (b) * 2 + (h)) * HTB)
#define PG8_STAGE(bufoff, gbase, voff) do { _Pragma("unroll") for (int _i = 0; _i < 2; ++_i) \
        __builtin_amdgcn_global_load_lds((const unsigned*)((const char*)(gbase) + (voff)[_i]), (PG8_LAS unsigned*)(lds + (bufoff) + ldsw + _i * 8192), 16, 0, 0); } while (0)
#define PG8_STAGE_A(bufoff, aptr, h, nx) do { if constexpr (GATHER) { if (nx) PG8_STAGE(bufoff, aptr, voffN[h]); else PG8_STAGE(bufoff, aptr, voffC[h]); } else PG8_STAGE(bufoff, (aptr) + ((h) ? hstep : (size_t)0), voffA); } while (0)
#define PG8_GATHER_VOFF(dst, uidx) do { _Pragma("unroll") for (int _h = 0; _h < 2; ++_h) _Pragma("unroll") for (int _i = 0; _i < 2; ++_i) { int R_, C_; stage_rc(tid * 16 + _i * 8192, R_, C_); \
        dst[_h][_i] = ((unsigned)g.rowtab[(uidx) * 256 + _h * 128 + R_] * (unsigned)K + (unsigned)C_) * 2u; } } while (0)
#define PG8_LDA(dst, b, h) do { _Pragma("unroll") for (int m = 0; m < 4; ++m) _Pragma("unroll") for (int k = 0; k < 2; ++k) dst[m][k] = *(const PG8_LAS bf16x8*)(lds + PG8_SA(b, h) + aoff + m * 2048 + k * 1024); } while (0)
#define PG8_LDB(dst, b, h) do { _Pragma("unroll") for (int n = 0; n < 2; ++n) _Pragma("unroll") for (int k = 0; k < 2; ++k) dst[n][k] = *(const PG8_LAS bf16x8*)(lds + PG8_SB(b, h) + boff + n * 2048 + k * 1024); } while (0)
#define PG8_MMA(ai, bj, At, Bt) do { __builtin_amdgcn_s_setprio(1); _Pragma("unroll") for (int m = 0; m < 4; ++m) _Pragma("unroll") for (int n = 0; n < 2; ++n) _Pragma("unroll") for (int k = 0; k < 2; ++k) \
        acc[ai][bj][m][n] = __builtin_amdgcn_mfma_f32_16x16x32_bf16(Bt[n][k], At[m][k], acc[ai][bj][m][n], 0, 0, 0); __builtin_amdgcn_s_setprio(0); } while (0)
#define PG8_WAIT_V(n) asm volatile("s_waitcnt vmcnt(" #n ")" ::: "memory")
#define PG8_WAIT_L(n) asm volatile("s_waitcnt lgkmcnt(" #n ")" ::: "memory")
#define PG8_BAR __builtin_amdgcn_s_barrier()
#define PG8_SCHED __builtin_amdgcn_sched_barrier(0)
    Unit cur, nxt; int ui = 0;
    if (!S.next(0, cur)) return;
    unsigned voffC[2][2], voffN[2][2];
    if constexpr (GATHER) { PG8_GATHER_VOFF(voffC, 0); }
    f32x4 acc[2][2][4][2];
#pragma unroll
    for (int a = 0; a < 2; ++a)
#pragma unroll
        for (int b = 0; b < 2; ++b)
#pragma unroll
            for (int m = 0; m < 4; ++m)
#pragma unroll
                for (int n = 0; n < 2; ++n) acc[a][b][m][n] = (f32x4){0.f, 0.f, 0.f, 0.f};
    bf16x8 At[4][2], B0[2][2], B1[2][2];
    const char* cA = (const char*)g.A + (GATHER ? (size_t)0 : (size_t)cur.pm * tstep); const char* cB = (const char*)g.Bt + (size_t)cur.pb * tstep;
    S.a_ready(cur);
    if constexpr (SP2) {
        PG8_STAGE(PG8_SB(0, 0), cB, voffB); PG8_STAGE(PG8_SB(0, 1), cB + hstep, voffB); PG8_STAGE_A(PG8_SA(0, 0), cA, 0, false); PG8_STAGE_A(PG8_SA(0, 1), cA, 1, false);
        if (wr == 1) PG8_BAR;
        PG8_WAIT_V(2); PG8_BAR;
        PG8_STAGE(PG8_SB(1, 0), cB + kstep, voffB); PG8_STAGE_A(PG8_SA(1, 0), cA + kstep, 0, false); PG8_STAGE(PG8_SB(1, 1), cB + hstep + kstep, voffB);
        PG8_WAIT_V(6); PG8_BAR;
    } else {
        PG8_STAGE(PG8_SB(0, 0), cB, voffB); PG8_STAGE(PG8_SA(0, 0), cA, voffA); PG8_STAGE(PG8_SB(0, 1), cB + hstep, voffB); PG8_STAGE(PG8_SA(0, 1), cA + hstep, voffA);
        if (wr == 1) PG8_BAR;
        PG8_WAIT_V(4); PG8_BAR;
        PG8_STAGE(PG8_SB(1, 0), cB + kstep, voffB); PG8_STAGE(PG8_SA(1, 0), cA + kstep, voffA); PG8_STAGE(PG8_SB(1, 1), cB + hstep + kstep, voffB);
        PG8_WAIT_V(6); PG8_BAR;
    }
    for (;;) {
        const bool has_next = S.next(ui + 1, nxt);
        if constexpr (GATHER) { if (has_next) { PG8_GATHER_VOFF(voffN, ui + 1); } else { voffN[0][0] = voffC[0][0]; voffN[0][1] = voffC[0][1]; voffN[1][0] = voffC[1][0]; voffN[1][1] = voffC[1][1]; } }
        const char* nA = (has_next && !GATHER) ? (const char*)g.A + (size_t)nxt.pm * tstep : cA; const char* nB = has_next ? (const char*)g.Bt + (size_t)nxt.pb * tstep : cB;
#pragma unroll 1
        for (int t = 0; t < nt; t += 2) {
            const bool last = (t == nt - 2);
            const char* a1 = cA + (size_t)(t + 1) * kstep;
            const char* a2 = last ? nA : cA + (size_t)(t + 2) * kstep; const char* b2 = last ? nB : cB + (size_t)(t + 2) * kstep;
            const char* a3 = a2 + kstep; const char* b3 = b2 + kstep;
            if (last && has_next) S.a_ready(nxt);
            if constexpr (SP2) {
            PG8_LDB(B0, 0, 0); PG8_LDB(B1, 0, 1); PG8_SCHED; PG8_LDA(At, 0, 0); PG8_STAGE_A(PG8_SA(1, 1), a1, 1, false);
            PG8_WAIT_V(8); PG8_WAIT_L(0); PG8_BAR; PG8_MMA(0, 0, At, B0); PG8_MMA(0, 1, At, B1); PG8_BAR; PG8_SCHED;
            PG8_LDA(At, 0, 1); PG8_STAGE(PG8_SB(0, 0), b2, voffB); PG8_STAGE(PG8_SB(0, 1), b2 + hstep, voffB); PG8_STAGE_A(PG8_SA(0, 0), a2, 0, last);
            PG8_WAIT_V(8); PG8_WAIT_L(0); PG8_BAR; PG8_MMA(1, 0, At, B0); PG8_MMA(1, 1, At, B1); PG8_BAR; PG8_SCHED;
            PG8_LDB(B0, 1, 0); PG8_LDB(B1, 1, 1); PG8_SCHED; PG8_LDA(At, 1, 0); PG8_STAGE_A(PG8_SA(0, 1), a2, 1, last);
            PG8_WAIT_V(8); PG8_WAIT_L(0); PG8_BAR; PG8_MMA(0, 0, At, B0); PG8_MMA(0, 1, At, B1); PG8_BAR; PG8_SCHED;
            PG8_LDA(At, 1, 1); PG8_STAGE(PG8_SB(1, 0), b3, voffB); PG8_STAGE(PG8_SB(1, 1), b3 + hstep, voffB); PG8_STAGE_A(PG8_SA(1, 0), a3, 0, last);
            PG8_WAIT_V(8); PG8_WAIT_L(0); PG8_BAR; PG8_MMA(1, 0, At, B0); PG8_MMA(1, 1, At, B1); PG8_BAR; PG8_SCHED;
            } else {
            PG8_LDB(B0, 0, 0); PG8_SCHED; PG8_LDA(At, 0, 0); PG8_STAGE(PG8_SA(1, 1), a1 + hstep, voffA);
            PG8_WAIT_L(8); PG8_BAR; PG8_WAIT_L(0); PG8_MMA(0, 0, At, B0); PG8_BAR; PG8_SCHED;
            PG8_LDB(B1, 0, 1); PG8_STAGE(PG8_SB(0, 0), b2, voffB);
            PG8_BAR; PG8_WAIT_L(0); PG8_MMA(0, 1, At, B1); PG8_BAR;
            PG8_LDA(At, 0, 1); PG8_STAGE(PG8_SA(0, 0), a2, voffA);
            PG8_BAR; PG8_WAIT_L(0); PG8_MMA(1, 0, At, B0); PG8_BAR; PG8_SCHED;
            PG8_STAGE(PG8_SB(0, 1), b2 + hstep, voffB);
            PG8_WAIT_V(6); PG8_BAR; PG8_MMA(1, 1, At, B1); PG8_BAR;
            PG8_LDB(B0, 1, 0); PG8_SCHED; PG8_LDA(At, 1, 0); PG8_STAGE(PG8_SA(0, 1), a2 + hstep, voffA);
            PG8_WAIT_L(8); PG8_BAR; PG8_WAIT_L(0); PG8_MMA(0, 0, At, B0); PG8_BAR; PG8_SCHED;
            PG8_LDB(B1, 1, 1); PG8_STAGE(PG8_SB(1, 0), b3, voffB);
            PG8_BAR; PG8_WAIT_L(0); PG8_MMA(0, 1, At, B1); PG8_BAR;
            PG8_LDA(At, 1, 1); PG8_STAGE(PG8_SA(1, 0), a3, voffA);
            PG8_BAR; PG8_WAIT_L(0); PG8_MMA(1, 0, At, B0); PG8_BAR; PG8_SCHED;
            PG8_STAGE(PG8_SB(1, 1), b3 + hstep, voffB);
            PG8_WAIT_V(6); PG8_BAR; PG8_MMA(1, 1, At, B1); PG8_BAR;
            }
        }
        if constexpr (ALIGN_EPI) { if (wr == 0) PG8_BAR; }
        if constexpr (!Epi::AFTER_DRAIN) { E(acc, cur, wr, wc, fr, fq); S.done(cur); }
        if (!has_next) break;
#pragma unroll
        for (int a = 0; a < 2; ++a)
#pragma unroll
            for (int b = 0; b < 2; ++b)
#pragma unroll
                for (int m = 0; m < 4; ++m)
#pragma unroll
                    for (int n = 0; n < 2; ++n) acc[a][b][m][n] = (f32x4){0.f, 0.f, 0.f, 0.f};
        cur = nxt; cA = nA; cB = nB; ++ui;
        if constexpr (GATHER) { voffC[0][0] = voffN[0][0]; voffC[0][1] = voffN[0][1]; voffC[1][0] = voffN[1][0]; voffC[1][1] = voffN[1][1]; }
        if constexpr (ALIGN_EPI) { if (wr == 1) PG8_BAR; }
    }
    PG8_WAIT_V(0);
    if constexpr (!ALIGN_EPI) { if (wr == 0) PG8_BAR; }
    PG8_BAR;
    if constexpr (Epi::AFTER_DRAIN) { E.fused(acc, cur, wr, wc, fr, fq, lds, wid, lane); S.done(cur); }
#undef PG8_SA
#undef PG8_SB
#undef PG8_STAGE
#undef PG8_STAGE_A
#undef PG8_GATHER_VOFF
#undef PG8_LDA
#undef PG8_LDB
#undef PG8_MMA
#undef PG8_WAIT_V
#undef PG8_WAIT_L
#undef PG8_BAR
#undef PG8_SCHED
}

typedef unsigned u32x2 __attribute__((ext_vector_type(2)));
constexpr int kSeq = 4096;

struct EpiQkvA {
    static constexpr bool PERM = true, AFTER_DRAIN = false;
    bf16_t* QKV; size_t stride; const float *cosA, *sinA;
    __device__ __forceinline__ void operator()(const f32x4 (&acc)[2][2][4][2], const Unit& u, int wr, int wc, int fr, int fq) const {
        const int sel = u.pn >> 2; bf16_t* base = QKV + (size_t)sel * stride;
        const float sc = sel == 0 ? 0.18033688011112042f : 1.f;
        const bool rot = (sel < 2) && ((wc & 1) == 0);
#pragma unroll
        for (int ai = 0; ai < 2; ++ai)
#pragma unroll
            for (int m = 0; m < 4; ++m) {
                const int row = u.pm * BM + ai * HALF + wr * 64 + m * 16 + fr, bb = row >> 12, tt = row & (kSeq - 1);
                f32x4 cs[2], sn[2];
                if (rot) { cs[0] = *(const f32x4*)(cosA + tt * 8); cs[1] = *(const f32x4*)(cosA + tt * 8 + 4); sn[0] = *(const f32x4*)(sinA + tt * 8); sn[1] = *(const f32x4*)(sinA + tt * 8 + 4); }
#pragma unroll
                for (int bj = 0; bj < 2; ++bj) {
                    f32x4 v[2] = {acc[ai][bj][m][0], acc[ai][bj][m][1]};
                    if (rot) {
#pragma unroll
                        for (int n = 0; n < 2; ++n) { f32x4 p; p[0] = __shfl_xor(v[n][0], 16); p[1] = __shfl_xor(v[n][1], 16); p[2] = __shfl_xor(v[n][2], 16); p[3] = __shfl_xor(v[n][3], 16);
                            if (fq == 0) v[n] = v[n] * cs[n] - p * sn[n]; else if (fq == 1) v[n] = v[n] * cs[n] + p * sn[n]; }
                    }
                    const int col = (u.pn & 3) * 256 + bj * HALF + wc * 32 + 8 * fq, hh = col >> 6, dim = col & 63;
                    u32x4 w; w.x = cvt_pk_bf16(v[0][0] * sc, v[0][1] * sc); w.y = cvt_pk_bf16(v[0][2] * sc, v[0][3] * sc); w.z = cvt_pk_bf16(v[1][0] * sc, v[1][1] * sc); w.w = cvt_pk_bf16(v[1][2] * sc, v[1][3] * sc);
                    *(u32x4*)(base + ((((size_t)(bb * 16 + hh) * 16 + (tt & 15)) * 256 + (tt >> 4)) * 64 + dim)) = w;
                }
            }
    }
};

struct EpiBf16Plain {
    static constexpr bool PERM = true, AFTER_DRAIN = false;
    bf16_t* O; int ldc;
    __device__ __forceinline__ void operator()(const f32x4 (&acc)[2][2][4][2], const Unit& u, int wr, int wc, int fr, int fq) const {
        const int row0 = u.pm * BM + wr * 64 + fr, col0 = u.pn * BM + wc * 32 + 8 * fq;
#pragma unroll
        for (int ai = 0; ai < 2; ++ai)
#pragma unroll
            for (int m = 0; m < 4; ++m) { bf16_t* rowp = O + (size_t)(row0 + ai * HALF + m * 16) * ldc + col0;
#pragma unroll
                for (int bj = 0; bj < 2; ++bj) { const f32x4 v0 = acc[ai][bj][m][0], v1 = acc[ai][bj][m][1];
                    u32x4 w; w.x = cvt_pk_bf16(v0[0], v0[1]); w.y = cvt_pk_bf16(v0[2], v0[3]); w.z = cvt_pk_bf16(v1[0], v1[1]); w.w = cvt_pk_bf16(v1[2], v1[3]);
                    *(u32x4*)(rowp + bj * HALF) = w; } }
    }
};

struct EpiProjC {
    static constexpr bool PERM = true, AFTER_DRAIN = false;
    bf16_t *QK, *VG; size_t qk_stride, vg_stride; const float *cosC, *sinC;
    __device__ __forceinline__ void operator()(const f32x4 (&acc)[2][2][4][2], const Unit& u, int wr, int wc, int fr, int fq) const {
        const int row0 = u.pm * BM + wr * 64 + fr;
        if (u.pn < 8) {
            const bool isk = u.pn >= 4; bf16_t* base = QK + (isk ? qk_stride : (size_t)0); const float sc = isk ? 0.0625f : 1.f;
            const int i0 = wc * 32 + 8 * fq, colb = (u.pn & 3) * 256 + i0;
#pragma unroll
            for (int ai = 0; ai < 2; ++ai)
#pragma unroll
                for (int m = 0; m < 4; ++m) {
                    const int row = row0 + ai * HALF + m * 16, sp = row & (kSeq - 1);
                    const f32x4 c0 = *(const f32x4*)(cosC + sp * 128 + i0), c1 = *(const f32x4*)(cosC + sp * 128 + i0 + 4);
                    const f32x4 s0 = *(const f32x4*)(sinC + sp * 128 + i0), s1 = *(const f32x4*)(sinC + sp * 128 + i0 + 4);
                    const f32x4 x1a = acc[ai][0][m][0], x1b = acc[ai][0][m][1], x2a = acc[ai][1][m][0], x2b = acc[ai][1][m][1];
                    const f32x4 o1a = (x1a * c0 - x2a * s0) * sc, o1b = (x1b * c1 - x2b * s1) * sc;
                    const f32x4 o2a = (x2a * c0 + x1a * s0) * sc, o2b = (x2b * c1 + x1b * s1) * sc;
                    bf16_t* rowp = base + (size_t)row * 1024 + colb;
                    u32x4 w; w.x = cvt_pk_bf16(o1a[0], o1a[1]); w.y = cvt_pk_bf16(o1a[2], o1a[3]); w.z = cvt_pk_bf16(o1b[0], o1b[1]); w.w = cvt_pk_bf16(o1b[2], o1b[3]);
                    *(u32x4*)rowp = w;
                    w.x = cvt_pk_bf16(o2a[0], o2a[1]); w.y = cvt_pk_bf16(o2a[2], o2a[3]); w.z = cvt_pk_bf16(o2b[0], o2b[1]); w.w = cvt_pk_bf16(o2b[2], o2b[3]);
                    *(u32x4*)(rowp + HALF) = w;
                }
        } else {
            bf16_t* base = VG + (u.pn >= 16 ? vg_stride : (size_t)0); const int col0 = ((u.pn - 8) & 7) * 256 + wc * 32 + 8 * fq;
#pragma unroll
            for (int ai = 0; ai < 2; ++ai)
#pragma unroll
                for (int m = 0; m < 4; ++m) { bf16_t* rowp = base + (size_t)(row0 + ai * HALF + m * 16) * 2048 + col0;
#pragma unroll
                    for (int bj = 0; bj < 2; ++bj) { const f32x4 v0 = acc[ai][bj][m][0], v1 = acc[ai][bj][m][1];
                        u32x4 w; w.x = cvt_pk_bf16(v0[0], v0[1]); w.y = cvt_pk_bf16(v0[2], v0[3]); w.z = cvt_pk_bf16(v1[0], v1[1]); w.w = cvt_pk_bf16(v1[2], v1[3]);
                        *(u32x4*)(rowp + bj * HALF) = w; } }
        }
    }
};

struct EpiResidual {
    static constexpr bool PERM = false, AFTER_DRAIN = false;
    const bf16_t* hin; float* hout; float alpha;
    __device__ __forceinline__ void operator()(const f32x4 (&acc)[2][2][4][2], const Unit& u, int wr, int wc, int fr, int fq) const {
        const int row0 = u.pm * BM + wr * 64 + fr, col0 = u.pn * BM + wc * 32 + 4 * fq;
#pragma unroll
        for (int ai = 0; ai < 2; ++ai)
#pragma unroll
            for (int m = 0; m < 4; ++m) { const size_t off = (size_t)(row0 + ai * HALF + m * 16) * 1024 + col0;
#pragma unroll
                for (int bj = 0; bj < 2; ++bj)
#pragma unroll
                    for (int n = 0; n < 2; ++n) { const u32x2 hb = *(const u32x2*)(hin + off + bj * HALF + n * 16);
                        f32x4 hv; hv[0] = __builtin_bit_cast(float, hb.x << 16); hv[1] = __builtin_bit_cast(float, hb.x & 0xffff0000u); hv[2] = __builtin_bit_cast(float, hb.y << 16); hv[3] = __builtin_bit_cast(float, hb.y & 0xffff0000u);
                        *(f32x4*)(hout + off + bj * HALF + n * 16) = hv * alpha + acc[ai][bj][m][n]; } }
    }
};

struct EpiMoeGU {
    static constexpr bool PERM = true, AFTER_DRAIN = false;
    bf16_t* HID;
    __device__ __forceinline__ void operator()(const f32x4 (&acc)[2][2][4][2], const Unit& u, int wr, int wc, int fr, int fq) const {
        const int row0 = u.pm * BM + wr * 64 + fr, col0 = u.pn * 128 + wc * 32 + 8 * fq;
#pragma unroll
        for (int ai = 0; ai < 2; ++ai)
#pragma unroll
            for (int m = 0; m < 4; ++m) {
                f32x4 h[2];
#pragma unroll
                for (int n = 0; n < 2; ++n) { const f32x4 g = acc[ai][0][m][n], up = acc[ai][1][m][n];
#pragma unroll
                    for (int j = 0; j < 4; ++j) h[n][j] = g[j] / (1.f + __expf(-g[j])) * up[j]; }
                u32x4 w; w.x = cvt_pk_bf16(h[0][0], h[0][1]); w.y = cvt_pk_bf16(h[0][2], h[0][3]); w.z = cvt_pk_bf16(h[1][0], h[1][1]); w.w = cvt_pk_bf16(h[1][2], h[1][3]);
                *(u32x4*)(HID + (size_t)(row0 + ai * HALF + m * 16) * 256 + col0) = w;
            }
    }
};

struct EpiMoeDown {
    static constexpr bool PERM = true, AFTER_DRAIN = false;
    bf16_t* Y; const float* rowgate;
    __device__ __forceinline__ void operator()(const f32x4 (&acc)[2][2][4][2], const Unit& u, int wr, int wc, int fr, int fq) const {
        const int row0 = u.pm * BM + wr * 64 + fr, col0 = u.pn * BM + wc * 32 + 8 * fq;
#pragma unroll
        for (int ai = 0; ai < 2; ++ai)
#pragma unroll
            for (int m = 0; m < 4; ++m) { const int row = row0 + ai * HALF + m * 16; const float gt = rowgate[row]; bf16_t* rowp = Y + (size_t)row * 1024 + col0;
#pragma unroll
                for (int bj = 0; bj < 2; ++bj) { const f32x4 v0 = acc[ai][bj][m][0] * gt, v1 = acc[ai][bj][m][1] * gt;
                    u32x4 w; w.x = cvt_pk_bf16(v0[0], v0[1]); w.y = cvt_pk_bf16(v0[2], v0[3]); w.z = cvt_pk_bf16(v1[0], v1[1]); w.w = cvt_pk_bf16(v1[2], v1[3]);
                    *(u32x4*)(rowp + bj * HALF) = w; } }
    }
};

struct MoeOrder {
    const PG8_LAS int* tile_e; int ntiles, ncol, bmul, G, c;
    __device__ __forceinline__ bool next(int i, Unit& u) const {
        int ti, j;
        if (G == 256) {
            const int x = c & 7, jc = c >> 3, base = ntiles >> 3, rem = ntiles & 7, t0 = x * base + (x < rem ? x : rem), cnt = base + (x < rem ? 1 : 0);
            const int m = i * 32 + jc; if (m >= cnt * ncol) return false;
            const int q = m / ncol; ti = t0 + q; j = m - q * ncol;
        } else { const int L = i * G + c; if (L >= ntiles * ncol) return false; ti = L / ncol; j = L - ti * ncol; }
        u.pm = ti; u.pn = j; u.pb = __builtin_amdgcn_readfirstlane(tile_e[ti] * bmul + j); return true;
    }
    __device__ __forceinline__ void a_ready(const Unit&) const {}
    __device__ __forceinline__ void done(const Unit&) const {}
};
}

struct Params {
    const float* in[24]; float* out; unsigned char* ws;
    double invA[8]; double invC[128];
};
typedef const __attribute__((address_space(4))) Params* ParamsK;
__device__ __forceinline__ ParamsK fresh_params() { ParamsK q = (ParamsK)__builtin_amdgcn_kernarg_segment_ptr(); asm volatile("" : "+s"(q)); return q; }
struct Ctx {
    int tid, lane, wave, G, bid;
    LAS unsigned char* lds;
};
__device__ __forceinline__ Ctx make_ctx(LAS unsigned char* lds, int wv) {
    Ctx c; unsigned m_ = ~0u; asm volatile("" : "+s"(m_)); asm volatile("" : "+s"(wv));
    const int lane = (int)__builtin_amdgcn_mbcnt_hi(m_, __builtin_amdgcn_mbcnt_lo(m_, 0u)); const int tid = wv * 64 + lane;
    int bid = blockIdx.x; asm volatile("" : "+s"(bid)); int G = gridDim.x; asm volatile("" : "+s"(G));
    asm volatile("" : "+s"(lds));
    c.tid = tid; c.lane = lane; c.wave = wv; c.G = G; c.bid = bid; c.lds = lds; return c;
}

#define LDS_BARRIER_D() do { asm volatile("s_waitcnt lgkmcnt(0)" ::: "memory"); __builtin_amdgcn_s_barrier(); asm volatile("" ::: "memory"); } while (0)
__device__ __forceinline__ void transpose_item(const float* W, int ldw, int k0, int n0, bf16_t* WT, int K, size_t dstrow0, LAS float* scr, int lane) {
    float vals[32];
#pragma unroll
    for (int i = 0; i < 32; ++i) { const int kk = 2 * i + (lane >> 5); vals[i] = W[(size_t)(k0 + kk) * ldw + n0 + (lane & 31)]; }
#pragma unroll
    for (int i = 0; i < 32; ++i) { const int kk = 2 * i + (lane >> 5); scr[kk * 33 + (lane & 31)] = vals[i]; }
    asm volatile("s_waitcnt lgkmcnt(0)" ::: "memory");
    const int c = lane & 7;
#pragma unroll
    for (int j = 0; j < 4; ++j) { const int n = (lane >> 3) + 8 * j; const LAS float* s = scr + (8 * c) * 33 + n;
        u32x4 o; o.x = pk2(s[0 * 33], s[1 * 33]); o.y = pk2(s[2 * 33], s[3 * 33]); o.z = pk2(s[4 * 33], s[5 * 33]); o.w = pk2(s[6 * 33], s[7 * 33]);
        *(u32x4*)(WT + (dstrow0 + n) * K + k0 + 8 * c) = o; }
    asm volatile("s_waitcnt lgkmcnt(0)" ::: "memory");
}
__device__ __forceinline__ void transpose_matrix(const Ctx& c, const float* W, int K, int ldw, int ncols, bf16_t* WT) {
    LAS float* scr = (LAS float*)(c.lds + c.wave * 8704);
    const int gw = c.bid * 8 + c.wave, NGW = c.G * 8, nblk = ncols / 32, items = (K / 64) * nblk;
    for (int it = gw; it < items; it += NGW) { const int kb = it / nblk, nb = it - kb * nblk; transpose_item(W, ldw, 64 * kb, 32 * nb, WT, K, (size_t)(32 * nb), scr, c.lane); }
}
__device__ __forceinline__ void convert_experts(LAS unsigned char* lds_, int wv_, int layer) {
    const Ctx c = make_ctx(lds_, wv_); layer = __builtin_amdgcn_readfirstlane(layer); asm volatile("" : "+s"(layer));
    LAS float* scr = (LAS float*)(c.lds + c.wave * 8704);
    const int gw = c.bid * 8 + c.wave, NGW = c.G * 8;
    ParamsK q = fresh_params(); const float* Wg = q->in[21] + (size_t)layer * 64 * 1024 * 256; const float* Wu = q->in[22] + (size_t)layer * 64 * 1024 * 256; const float* Wd = q->in[23] + (size_t)layer * 64 * 256 * 1024;
    unsigned char* ws = q->ws;
    bf16_t* GU = (bf16_t*)(ws + OFF_WE_GU); bf16_t* D = (bf16_t*)(ws + OFF_WE_D);
    for (int it = gw; it < 64 * 384; it += NGW) {
        const int e = it / 384, r = it - e * 384;
        if (r < 256) { const int isup = r >> 7, rr = r & 127, kb = rr >> 3, nb = rr & 7, n0 = 32 * nb;
            const float* W = (isup ? Wu : Wg) + (size_t)e * 1024 * 256;
            transpose_item(W, 256, 64 * kb, n0, GU, 1024, (size_t)e * 512 + (n0 >> 7) * 256 + isup * 128 + (n0 & 127), scr, c.lane);
        } else { const int rr = r - 256, kb = rr >> 5, nb = rr & 31;
            transpose_item(Wd + (size_t)e * 256 * 1024, 1024, 64 * kb, 32 * nb, D, 256, (size_t)e * 1024 + 32 * nb, scr, c.lane); }
    }
}
__device__ __forceinline__ void rope_entry(double w, int pos, float& co, float& si) {
    const double w2 = w * w; double cs = 1.0, sn = w, tc = 1.0, ts = w;
#pragma unroll
    for (int k = 1; k <= 11; ++k) { tc = -tc * w2 / (double)((2 * k - 1) * (2 * k)); ts = -ts * w2 / (double)((2 * k) * (2 * k + 1)); cs += tc; sn += ts; }
    double rc = 1.0, rs = 0.0, bc = cs, bs = sn; unsigned pp = (unsigned)pos;
#pragma unroll 1
    for (int b = 0; b < 20; ++b) { const bool on = ((pp >> b) & 1u) != 0u; const double t = rc * bc - rs * bs, u2 = rc * bs + rs * bc; rc = on ? t : rc; rs = on ? u2 : rs; const double t2 = bc * bc - bs * bs; bs = 2.0 * bc * bs; bc = t2; }
    co = (float)rc; si = (float)rs;
}
__device__ __forceinline__ void phase_prologue(LAS unsigned char* lds_, int wv_) {
    const Ctx c = make_ctx(lds_, wv_);
    unsigned char* ws = fresh_params()->ws;
    transpose_matrix(c, fresh_params()->in[6], 1024, 3072, 3072, (bf16_t*)(ws + OFF_WA_IN));
    transpose_matrix(c, fresh_params()->in[6] + (size_t)1024 * 3072, 1024, 3072, 3072, (bf16_t*)(ws + OFF_WA_IN) + (size_t)3072 * 1024);
    transpose_matrix(c, fresh_params()->in[7], 1024, 1024, 1024, (bf16_t*)(ws + OFF_WA_OUT));
    transpose_matrix(c, fresh_params()->in[7] + (size_t)1024 * 1024, 1024, 1024, 1024, (bf16_t*)(ws + OFF_WA_OUT) + (size_t)1024 * 1024);
    transpose_matrix(c, fresh_params()->in[8], 1024, 3088, 3072, (bf16_t*)(ws + OFF_WB_IN));
    transpose_matrix(c, fresh_params()->in[13], 1024, 1024, 1024, (bf16_t*)(ws + OFF_WB_OUT));
    transpose_matrix(c, fresh_params()->in[14], 1024, 6144, 6144, (bf16_t*)(ws + OFF_WC_IN));
    transpose_matrix(c, fresh_params()->in[16], 2048, 1024, 1024, (bf16_t*)(ws + OFF_WC_OUT));
    const int gt = c.bid * 512 + c.tid, NT = c.G * 512;
    { bf16_t* WR = (bf16_t*)(ws + OFF_WR);
      for (int i = gt; i < 4 * 80 * 1024; i += NT) { const int layer = i / (80 * 1024), r = i - layer * 80 * 1024, n = r >> 10, k = r & 1023;
          float w = 0.f; if (n < 8) w = fresh_params()->in[17][((size_t)layer * 1024 + k) * 8 + n]; else if (n < 72) w = fresh_params()->in[19][((size_t)layer * 1024 + k) * 64 + (n - 8)];
          const unsigned hi = f2bf(w); const float lo = w - __builtin_bit_cast(float, hi << 16);
          WR[((size_t)layer * 2 + 0) * 80 * 1024 + r] = (bf16_t)hi; WR[((size_t)layer * 2 + 1) * 80 * 1024 + r] = (bf16_t)f2bf(lo); } }
    { float* WG = (float*)(ws + OFF_WG); for (int i = gt; i < 16 * 1024; i += NT) { const int o = i >> 10, k = i & 1023; WG[i] = fresh_params()->in[8][(size_t)k * 3088 + 3072 + o]; } }
    { float* par = (float*)(ws + OFF_PAR);
      for (int i = gt; i < PAR_END; i += NT) { float v;
          if (i < PAR_LN1B) v = fresh_params()->in[2][i]; else if (i < PAR_LN2G) v = fresh_params()->in[3][i - PAR_LN1B]; else if (i < PAR_LN2B) v = fresh_params()->in[4][i - PAR_LN2G]; else if (i < PAR_GBIAS) v = fresh_params()->in[5][i - PAR_LN2B];
          else if (i < PAR_CONVW) v = fresh_params()->in[9][i - PAR_GBIAS]; else if (i < PAR_CONVB) v = fresh_params()->in[10][i - PAR_CONVW]; else if (i < PAR_BNG) v = fresh_params()->in[11][i - PAR_CONVB]; else if (i < PAR_CNG) v = fresh_params()->in[12][i - PAR_BNG];
          else if (i < PAR_RGB) v = fresh_params()->in[15][i - PAR_CNG]; else if (i < PAR_REB) v = fresh_params()->in[18][i - PAR_RGB]; else v = fresh_params()->in[20][i - PAR_REB];
          par[i] = v; } }
    { const int* pos = (const int*)fresh_params()->in[1]; float* cA = (float*)(ws + OFF_COSA); float* sA = (float*)(ws + OFF_SINA); float* cC = (float*)(ws + OFF_COSC); float* sC = (float*)(ws + OFF_SINC);
      for (int i = gt; i < SEQ * 136; i += NT) { const int s = i / 136, f = i - s * 136; float co, si;
          if (f < 8) { rope_entry(fresh_params()->invA[f], pos[s], co, si); cA[s * 8 + f] = co; sA[s * 8 + f] = si; }
          else { rope_entry(fresh_params()->invC[f - 8], pos[s], co, si); cC[s * 128 + f - 8] = co; sC[s * 128 + f - 8] = si; } } }
    { const f32x4* x4 = (const f32x4*)fresh_params()->in[0]; u32x2* hb = (u32x2*)(ws + OFF_HB);
      for (size_t i = gt; i < (size_t)NTOK * DM / 4; i += NT) { const f32x4 v = x4[i]; u32x2 w; w.x = pk2(v[0], v[1]); w.y = pk2(v[2], v[3]); hb[i] = w; } }
}

__device__ __forceinline__ void ln_apply(f32x4 (&v)[4], const f32x4 (&g)[4], const f32x4 (&b)[4]) {
    float s = 0.f;
#pragma unroll
    for (int j = 0; j < 4; ++j) s += (v[j][0] + v[j][1]) + (v[j][2] + v[j][3]);
    const float mean = wave_sum(s) * (1.f / DM); float s2 = 0.f;
#pragma unroll
    for (int j = 0; j < 4; ++j) { v[j] = v[j] - mean; s2 += (v[j][0] * v[j][0] + v[j][1] * v[j][1]) + (v[j][2] * v[j][2] + v[j][3] * v[j][3]); }
    const float rstd = 1.f / sqrtf(wave_sum(s2) * (1.f / DM) + LN_EPS);
#pragma unroll
    for (int j = 0; j < 4; ++j) v[j] = v[j] * rstd * g[j] + b[j];
}

__device__ __forceinline__ void phase_ln1_router(LAS unsigned char* lds_, int wv_, int layer, bool mixed, bool do_router) {
    const Ctx c = make_ctx(lds_, wv_); layer = __builtin_amdgcn_readfirstlane(layer); asm volatile("" : "+s"(layer));
    unsigned char* ws = fresh_params()->ws;
    float* H = (float*)(ws + OFF_H); bf16_t* HB = (bf16_t*)(ws + OFF_HB);
    const float* src = H; const float scale = 1.0f; (void)mixed;
    const float* par = (const float*)(ws + OFF_PAR); const float* lg = par + PAR_LN1G + layer * DM; const float* lb = par + PAR_LN1B + layer * DM;
    f32x4 g[4], b[4];
#pragma unroll
    for (int j = 0; j < 4; ++j) { g[j] = *(const f32x4*)(lg + 4 * c.lane + 256 * j); b[j] = *(const f32x4*)(lb + 4 * c.lane + 256 * j); }
    constexpr int WROW = 264;
    LAS bf16_t* wst = (LAS bf16_t*)c.lds;
    LAS float* lgt = (LAS float*)(c.lds + 86016) + c.wave * (16 * 80);
    LAS int* hist = (LAS int*)(c.lds + 86016 + 8 * 16 * 80 * 4);
    const bf16_t* WR = (const bf16_t*)(ws + OFF_WR) + (size_t)(layer * 2) * 80 * 1024;
    const int fr = c.lane & 15, fq = c.lane >> 4;
    const unsigned wvoff = (unsigned)((c.tid >> 5) * 2048 + (c.tid & 31) * 16), wloff = (unsigned)((c.tid >> 5) * (WROW * 2) + (c.tid & 31) * 16);
    for (int rb = c.bid; rb < NTOK / 128; rb += c.G) {
        const int row0 = rb * 128 + c.wave * 16;
        u32x4 wreg[10];
        if (do_router) {
#pragma unroll
            for (int k = 0; k < 10; ++k) wreg[k] = *(const u32x4*)((const char*)WR + (size_t)((k / 5) * 80 + 16 * (k % 5)) * 2048 + wvoff);
        }
        if (c.tid < 64) hist[c.tid] = 0;
#pragma unroll 1
        for (int r = 0; r < 16; r += 4) {
            f32x4 v[4][4];
#pragma unroll
            for (int q = 0; q < 4; ++q)
#pragma unroll
                for (int j = 0; j < 4; ++j) v[q][j] = *(const f32x4*)(src + (size_t)(row0 + r + q) * DM + 4 * c.lane + 256 * j);
#pragma unroll
            for (int q = 0; q < 4; ++q) {
#pragma unroll
                for (int j = 0; j < 4; ++j) v[q][j] = v[q][j] * scale;
                ln_apply(v[q], g, b);
                const size_t ro = (size_t)(row0 + r + q) * DM + 4 * c.lane;
#pragma unroll
                for (int j = 0; j < 4; ++j) { u32x2 w; w.x = pk2(v[q][j][0], v[q][j][1]); w.y = pk2(v[q][j][2], v[q][j][3]); *(u32x2*)(HB + ro + 256 * j) = w; }
            }
        }
        __syncthreads();
        if (do_router) {
            f32x4 acc[5];
#pragma unroll
            for (int t = 0; t < 5; ++t) acc[t] = (f32x4){0.f, 0.f, 0.f, 0.f};
            const bf16_t* arow = HB + (size_t)(row0 + fr) * DM + fq * 8;
#pragma unroll 1
            for (int st = 0; st < 4; ++st) {
                bf16x8 af[8];
#pragma unroll
                for (int ks = 0; ks < 8; ++ks) af[ks] = *(const bf16x8*)(arow + st * 256 + ks * 32);
#pragma unroll
                for (int k = 0; k < 10; ++k) *(LAS u32x4*)((LAS char*)wst + ((k / 5) * 80 + 16 * (k % 5)) * (WROW * 2) + wloff) = wreg[k];
                if (st < 3) {
#pragma unroll
                    for (int k = 0; k < 10; ++k) wreg[k] = *(const u32x4*)((const char*)WR + (size_t)((k / 5) * 80 + 16 * (k % 5)) * 2048 + (size_t)(st + 1) * 512 + wvoff);
                }
                LDS_BARRIER_D();
#pragma unroll
                for (int ks = 0; ks < 8; ++ks) {
                    const bf16x8 ah = af[ks];
#pragma unroll
                    for (int t = 0; t < 5; ++t) {
                        const bf16x8 bh = *(const LAS bf16x8*)(wst + (t * 16 + fr) * WROW + ks * 32 + fq * 8);
                        const bf16x8 bl = *(const LAS bf16x8*)(wst + (80 + t * 16 + fr) * WROW + ks * 32 + fq * 8);
                        acc[t] = __builtin_amdgcn_mfma_f32_16x16x32_bf16(ah, bh, acc[t], 0, 0, 0);
                        acc[t] = __builtin_amdgcn_mfma_f32_16x16x32_bf16(ah, bl, acc[t], 0, 0, 0);
                    }
                }
                LDS_BARRIER_D();
            }
#pragma unroll
            for (int t = 0; t < 5; ++t) { const int n = t * 16 + fr; float bias = 0.f; if (n < 8) bias = par[PAR_RGB + layer * 8 + n]; else if (n < 72) bias = par[PAR_REB + layer * 64 + n - 8];
#pragma unroll
                for (int r = 0; r < 4; ++r) lgt[(4 * fq + r) * 80 + n] = acc[t][r] + bias; }
            __syncthreads();
            if (c.lane < 16) {
                const LAS float* L = lgt + c.lane * 80; const int tok = row0 + c.lane;
                int grp = 0; float gm = L[0];
#pragma unroll
                for (int i = 1; i < 8; ++i) { const float x = L[i]; if (x > gm) { gm = x; grp = i; } }
                float se = 0.f;
#pragma unroll
                for (int i = 0; i < 8; ++i) se += __expf(L[i] - gm);
                const float pg = 1.f / se;
                const LAS float* E = L + 8 + grp * 8;
                int i0 = 0; float v0 = E[0];
#pragma unroll
                for (int i = 1; i < 8; ++i) { const float x = E[i]; if (x > v0) { v0 = x; i0 = i; } }
                int i1 = (i0 == 0) ? 1 : 0; float v1 = E[i1];
#pragma unroll
                for (int i = 0; i < 8; ++i) { const float x = E[i]; if (i != i0 && x > v1) { v1 = x; i1 = i; } }
                const float ex = __expf(v1 - v0), g0 = pg / (1.f + ex), g1 = pg * ex / (1.f + ex);
                const int e0 = grp * 8 + i0, e1 = grp * 8 + i1;
                int* EID = (int*)(ws + OFF_EID); float* GT = (float*)(ws + OFF_GATE);
                EID[tok * 2] = e0; EID[tok * 2 + 1] = e1; GT[tok * 2] = g0; GT[tok * 2 + 1] = g1;
                __hip_atomic_fetch_add(hist + e0, 1, __ATOMIC_RELAXED, __HIP_MEMORY_SCOPE_WORKGROUP);
                __hip_atomic_fetch_add(hist + e1, 1, __ATOMIC_RELAXED, __HIP_MEMORY_SCOPE_WORKGROUP);
            }
            __syncthreads();
            if (c.tid < 64) ((int*)(ws + OFF_CTL))[rb * 64 + c.tid] = hist[c.tid];
        }
        __syncthreads();
    }
}

__device__ __forceinline__ void phase_ln2(LAS unsigned char* lds_, int wv_, int layer, bool last, bool with_moe, bool do_gates) {
    const Ctx c = make_ctx(lds_, wv_); layer = __builtin_amdgcn_readfirstlane(layer); asm volatile("" : "+s"(layer));
    unsigned char* ws = fresh_params()->ws;
    float* dst = last ? fresh_params()->out : (float*)(ws + OFF_H);
    bf16_t* HB = (bf16_t*)(ws + OFF_HB);
    const float* par = (const float*)(ws + OFF_PAR); const float* lg = par + PAR_LN2G + layer * DM; const float* lb = par + PAR_LN2B + layer * DM;
    f32x4 g[4], b[4];
#pragma unroll
    for (int j = 0; j < 4; ++j) { g[j] = *(const f32x4*)(lg + 4 * c.lane + 256 * j); b[j] = *(const f32x4*)(lb + 4 * c.lane + 256 * j); }
    const int* SLOT = (const int*)(ws + OFF_SLOT); const bf16_t* Y = (const bf16_t*)(ws + OFF_R + RM_YEXP);
    LAS float* wg = (LAS float*)c.lds;
    if (do_gates) { const float* WG = (const float*)(ws + OFF_WG); for (int i = c.tid; i < 16 * 1024 / 4; i += 512) ((LAS f32x4*)wg)[i] = ((const f32x4*)WG)[i]; __syncthreads(); }
    float* GATES = (float*)(ws + OFF_GATES);
    for (int row4 = (c.bid * 8 + c.wave) * 4; row4 < NTOK; row4 += c.G * 32) {
        f32x4 v[4][4]; u32x2 ya[4][4], yb[4][4];
#pragma unroll
        for (int q = 0; q < 4; ++q) {
            const size_t ro = (size_t)(row4 + q) * DM + 4 * c.lane;
#pragma unroll
            for (int j = 0; j < 4; ++j) { const u32x2 hb = *(const u32x2*)(HB + ro + 256 * j); v[q][j][0] = bflo(hb.x); v[q][j][1] = bfhi(hb.x); v[q][j][2] = bflo(hb.y); v[q][j][3] = bfhi(hb.y); }
            if (with_moe) {
                const int s0 = SLOT[(row4 + q) * 2], s1 = SLOT[(row4 + q) * 2 + 1];
                const bf16_t* y0 = Y + (size_t)s0 * DM + 4 * c.lane; const bf16_t* y1 = Y + (size_t)s1 * DM + 4 * c.lane;
#pragma unroll
                for (int j = 0; j < 4; ++j) { ya[q][j] = *(const u32x2*)(y0 + 256 * j); yb[q][j] = *(const u32x2*)(y1 + 256 * j); }
            }
        }
#pragma unroll
        for (int q = 0; q < 4; ++q) {
            const int row = row4 + q; const size_t ro = (size_t)row * DM + 4 * c.lane;
#pragma unroll
            for (int j = 0; j < 4; ++j) { v[q][j] = v[q][j] * DN_ALPHA;
                if (with_moe) { const u32x2 a = ya[q][j], bb = yb[q][j];
                    v[q][j][0] += bflo(a.x) + bflo(bb.x); v[q][j][1] += bfhi(a.x) + bfhi(bb.x); v[q][j][2] += bflo(a.y) + bflo(bb.y); v[q][j][3] += bfhi(a.y) + bfhi(bb.y); } }
            ln_apply(v[q], g, b);
#pragma unroll
            for (int j = 0; j < 4; ++j) { if (last) *(f32x4*)(dst + ro + 256 * j) = v[q][j]; else { u32x2 w; w.x = pk2(v[q][j][0], v[q][j][1]); w.y = pk2(v[q][j][2], v[q][j][3]); *(u32x2*)(HB + ro + 256 * j) = w; } }
            if (do_gates) {
                float mine = 0.f;
#pragma unroll
                for (int o = 0; o < 16; ++o) { float s = 0.f;
#pragma unroll
                    for (int j = 0; j < 4; ++j) { const f32x4 w = *(const LAS f32x4*)(wg + o * 1024 + 4 * c.lane + 256 * j); s += (v[q][j][0] * w[0] + v[q][j][1] * w[1]) + (v[q][j][2] * w[2] + v[q][j][3] * w[3]); }
                    s = wave_sum(s); if (c.lane == o) mine = s; }
                if (c.lane < 16) GATES[(size_t)row * 16 + c.lane] = mine + par[PAR_GBIAS + c.lane];
            }
        }
    }
}

__device__ __forceinline__ void phase_moe_scan(LAS unsigned char* lds_, int wv_) {
    const Ctx c = make_ctx(lds_, wv_);
    unsigned char* ws = fresh_params()->ws;
    const int* CNT = (const int*)(ws + OFF_CTL); const int* EID = (const int*)(ws + OFF_EID); const float* GT = (const float*)(ws + OFF_GATE);
    int* SLOT = (int*)(ws + OFF_SLOT); float* RG = (float*)(ws + OFF_ROWGATE);
    int* RT = (int*)(ws + OFF_ROWTOK);
    LAS int* part = (LAS int*)c.lds;
    LAS int* tot = part + 1024;
    LAS int* bef = tot + 64;
    LAS int* pst = bef + 64;
    LAS int* eids = pst + 64;
    LAS int* dst = eids + 256;
    LAS int* misc = (LAS int*)(c.lds + LDS_MISC);
    { const int e = c.tid & 63, pt = c.tid >> 6; int sa = 0;
      for (int bb = pt * 32; bb < pt * 32 + 32; ++bb) sa += CNT[bb * 64 + e];
      part[pt * 64 + e] = sa; }
    __syncthreads();
    if (c.tid < 64) { int sa = 0;
#pragma unroll
        for (int pt = 0; pt < 8; ++pt) sa += part[pt * 64 + c.tid];
        tot[c.tid] = sa; }
    __syncthreads();
    if (c.tid == 0) { int pos = 0, nt = 0;
        for (int e = 0; e < 64; ++e) { pst[e] = pos; const int n = (tot[e] + 255) >> 8; for (int k = 0; k < n; ++k) misc[1 + nt++] = e; pos += n * 256; }
        misc[0] = nt; }
    __syncthreads();
    for (int e = c.bid; e < 64; e += c.G) { const int n0 = pst[e] + tot[e], n1 = pst[e] + (((tot[e] + 255) >> 8) << 8); for (int r = n0 + c.tid; r < n1; r += 512) RT[r] = 0; }
    for (int rb = c.bid; rb < NTOK / 128; rb += c.G) {
        { const int e = c.tid & 63, pt = c.tid >> 6; int sb = 0;
          for (int bb = pt * 32; bb < pt * 32 + 32; ++bb) { const int v = CNT[bb * 64 + e]; if (bb < rb) sb += v; }
          part[512 + pt * 64 + e] = sb; }
        __syncthreads();
        if (c.tid < 64) { int sb = 0;
#pragma unroll
            for (int pt = 0; pt < 8; ++pt) sb += part[512 + pt * 64 + c.tid];
            bef[c.tid] = sb; }
        if (c.tid < 256) eids[c.tid] = EID[(rb * 128) * 2 + c.tid];
        __syncthreads();
        if (c.tid < 256) { const int e = eids[c.tid]; int rank = 0; for (int a = 0; a < c.tid; ++a) rank += (eids[a] == e) ? 1 : 0;
            const int d = pst[e] + bef[e] + rank; SLOT[(rb * 128) * 2 + c.tid] = d; RG[d] = GT[(rb * 128) * 2 + c.tid]; RT[d] = rb * 128 + (c.tid >> 1); }
        __syncthreads();
        __syncthreads();
    }
}

#if defined(PROBE_W)
#define ASTAMP(type) do { if (blockIdx.x == 0 && threadIdx.x == 0) { const unsigned long long t_ = __builtin_amdgcn_s_memrealtime(); unsigned long long* TS_ = (unsigned long long*)(fresh_params()->ws + OFF_CTL + 131072); TS_[32 + (type)] += t_ - TS_[1]; TS_[1] = t_; } } while (0)
#else
#define ASTAMP(type) do { } while (0)
#endif
#define LDS_BARRIER() do { asm volatile("s_waitcnt lgkmcnt(0)" ::: "memory"); __builtin_amdgcn_s_barrier(); asm volatile("" ::: "memory"); } while (0)
__device__ __forceinline__ void phase_attn(LAS unsigned char* lds_, int wv_) {
    const Ctx c = make_ctx(lds_, wv_);
    unsigned char* ws = fresh_params()->ws;
    const bf16_t* Qg = (const bf16_t*)(ws + OFF_R + RA_Q); const bf16_t* Kg = (const bf16_t*)(ws + OFF_R + RA_K); const bf16_t* Vg = (const bf16_t*)(ws + OFF_R + RA_V);
    bf16_t* OG = (bf16_t*)(ws + OFF_R + RA_OG); float* LSE = (float*)(ws + OFF_R + RA_LSE);
    LAS bf16_t* Ks = (LAS bf16_t*)c.lds; LAS bf16_t* Vs = Ks + 384 * 72;
    const int fr = c.lane & 15, fq = c.lane >> 4;
    const int tq = (c.lane & 15) >> 2, tp = c.lane & 3;
    constexpr int NU = NBATCH * 16 * 48;
    u32x4 kreg[6], vreg[6];
#define ATT_DECODE(U) const int bh_ = (U) / 48, sub_ = (U) - bh_ * 48, b = bh_ >> 4, h = bh_ & 15, g = sub_ >> 4, idx_ = sub_ & 15; \
        const int dsh = 2 * g, nqb_ = 16 >> dsh, r = idx_ / nqb_, qb_ = idx_ - r * nqb_; const int lq0 = qb_ * 256, lk0 = lq0 - 128; const size_t tokbase = (size_t)b * SEQ;
#define ATT_LOAD(U) do { ATT_DECODE(U) \
        _Pragma("unroll") for (int k = 0; k < 6; ++k) { const int i_ = c.tid + k * 512, ri_ = i_ >> 3, ch_ = i_ & 7, l_ = lk0 + ri_; \
            const int lc_ = l_ < 0 ? 0 : l_;     \
            const int t_ = (lc_ << dsh) + r; const size_t ga_ = (((size_t)(bh_ * 16 + (t_ & 15)) * 256 + (t_ >> 4)) * 64) + ch_ * 8; kreg[k] = *(const u32x4*)(Kg + ga_); vreg[k] = *(const u32x4*)(Vg + ga_); } } while (0)
    const bool xl = (c.G == 256); const int nloc = xl ? NU / 256 : (NU - c.bid + c.G - 1) / c.G;
#define ATT_UNIT(K) (xl ? (((c.bid & 7) + 8 * (((c.bid >> 3) + 32 * (K)) / 48)) * 48 + (((c.bid >> 3) + 32 * (K)) % 48)) : (c.bid + (K) * c.G))
    if (nloc > 0) ATT_LOAD(ATT_UNIT(0));
#if defined(PROBE_W)
    if (blockIdx.x == 0 && threadIdx.x == 0) { unsigned long long* TS_ = (unsigned long long*)(fresh_params()->ws + OFF_CTL + 131072); TS_[1] = __builtin_amdgcn_s_memrealtime(); }
#endif
    for (int kk = 0; kk < nloc; ++kk) {
        const int u = ATT_UNIT(kk);
        ATT_DECODE(u)
        bf16x8 qf[2][2];
#pragma unroll
        for (int grp = 0; grp < 2; ++grp) { const int tq_ = ((lq0 + c.wave * 32 + grp * 16 + fr) << dsh) + r; const size_t qa = (((size_t)(bh_ * 16 + (tq_ & 15)) * 256 + (tq_ >> 4)) * 64);
            qf[grp][0] = *(const bf16x8*)(Qg + qa + fq * 8); qf[grp][1] = *(const bf16x8*)(Qg + qa + 32 + fq * 8); }
        ASTAMP(19);
        LDS_BARRIER();
        ASTAMP(16);
#pragma unroll
        for (int k = 0; k < 6; ++k) { const int i_ = c.tid + k * 512, ri_ = i_ >> 3, ch_ = i_ & 7; *(LAS u32x4*)(Ks + ri_ * 72 + ch_ * 8) = kreg[k]; *(LAS u32x4*)(Vs + ri_ * 72 + ch_ * 8) = vreg[k]; }
        ATT_LOAD(ATT_UNIT(kk + 1 < nloc ? kk + 1 : kk));
        LDS_BARRIER();
        ASTAMP(17);
        {
            const int l0 = lq0 + c.wave * 32, rbase = c.wave * 32;
            const int jmin = (l0 < 128) ? ((128 - l0) >> 4) : 0;
            f32x4 s0[9], s1[9]; float mx0 = -3.0e38f, mx1 = -3.0e38f;
#pragma unroll
            for (int jb = 0; jb < 10; ++jb) {
                const LAS bf16_t* kr = Ks + (rbase + jb * 16 + fr) * 72 + fq * 8;
                const bf16x8 k0 = *(const LAS bf16x8*)kr, k1 = *(const LAS bf16x8*)(kr + 32);
                const bool dead = jb < jmin;
                if (jb <= 8) { f32x4 a = {0.f, 0.f, 0.f, 0.f};
                    a = __builtin_amdgcn_mfma_f32_16x16x32_bf16(k0, qf[0][0], a, 0, 0, 0); a = __builtin_amdgcn_mfma_f32_16x16x32_bf16(k1, qf[0][1], a, 0, 0, 0);
#pragma unroll
                    for (int rg = 0; rg < 4; ++rg) {
                        if (jb == 0 || jb == 8) { const int rel = 128 + fr - (16 * jb + 4 * fq + rg); a[rg] = (rel < 0 || rel > 128) ? -3.0e38f : a[rg]; }
                        if (jb < 8) a[rg] = dead ? -3.0e38f : a[rg];
                        mx0 = fmaxf(mx0, a[rg]); }
                    s0[jb] = a; }
                if (jb >= 1) { const int jl = jb - 1; f32x4 a = {0.f, 0.f, 0.f, 0.f};
                    a = __builtin_amdgcn_mfma_f32_16x16x32_bf16(k0, qf[1][0], a, 0, 0, 0); a = __builtin_amdgcn_mfma_f32_16x16x32_bf16(k1, qf[1][1], a, 0, 0, 0);
#pragma unroll
                    for (int rg = 0; rg < 4; ++rg) {
                        if (jl == 0 || jl == 8) { const int rel = 128 + fr - (16 * jl + 4 * fq + rg); a[rg] = (rel < 0 || rel > 128) ? -3.0e38f : a[rg]; }
                        if (jl < 8) a[rg] = dead ? -3.0e38f : a[rg];
                        mx1 = fmaxf(mx1, a[rg]); }
                    s1[jl] = a; }
            }
            mx0 = fmaxf(mx0, __shfl_xor(mx0, 16)); mx0 = fmaxf(mx0, __shfl_xor(mx0, 32)); mx1 = fmaxf(mx1, __shfl_xor(mx1, 16)); mx1 = fmaxf(mx1, __shfl_xor(mx1, 32));
            float ls0 = 0.f, ls1 = 0.f;
#pragma unroll
            for (int jb = 0; jb < 9; ++jb)
#pragma unroll
                for (int rg = 0; rg < 4; ++rg) { const float e0 = __builtin_amdgcn_exp2f(s0[jb][rg] - mx0), e1 = __builtin_amdgcn_exp2f(s1[jb][rg] - mx1); s0[jb][rg] = e0; ls0 += e0; s1[jb][rg] = e1; ls1 += e1; }
            ls0 += __shfl_xor(ls0, 16); ls0 += __shfl_xor(ls0, 32); ls1 += __shfl_xor(ls1, 16); ls1 += __shfl_xor(ls1, 32);
            f32x4 o0[4], o1[4];
#pragma unroll
            for (int db = 0; db < 4; ++db) { o0[db] = (f32x4){0.f, 0.f, 0.f, 0.f}; o1[db] = (f32x4){0.f, 0.f, 0.f, 0.f}; }
            s16x4 va[4], vb[4], vc[4];
#define ATT_VLOAD(dst, JB) do { const LAS bf16_t* vp_ = Vs + (rbase + (JB) * 16 + 4 * fq + tq) * 72 + tp * 4; \
                _Pragma("unroll") for (int db = 0; db < 4; ++db) dst[db] = __builtin_amdgcn_ds_read_tr16_b64_v4i16((LAS s16x4*)(vp_ + db * 16)); } while (0)
#define ATT_PACK(dst, SA, SB, HASB) do { u32x4 w_; w_[0] = pk2(SA[0], SA[1]); w_[1] = pk2(SA[2], SA[3]); if (HASB) { w_[2] = pk2(SB[0], SB[1]); w_[3] = pk2(SB[2], SB[3]); } else { w_[2] = 0u; w_[3] = 0u; } dst = __builtin_bit_cast(bf16x8, w_); } while (0)
            ATT_VLOAD(va, 0); ATT_VLOAD(vb, 1);
#pragma unroll
            for (int i = 0; i < 5; ++i) {
                bf16x8 pf0, pf1;
                ATT_PACK(pf0, s0[2 * i], s0[(2 * i + 1 <= 8) ? 2 * i + 1 : 8], (2 * i + 1 <= 8));
                ATT_PACK(pf1, s1[2 * i], s1[(2 * i + 1 <= 8) ? 2 * i + 1 : 8], (2 * i + 1 <= 8));
                if (2 * i + 2 <= 9) ATT_VLOAD(vc, 2 * i + 2);
#pragma unroll
                for (int db = 0; db < 4; ++db) { bf16x8 vf; vf[0] = va[db][0]; vf[1] = va[db][1]; vf[2] = va[db][2]; vf[3] = va[db][3]; vf[4] = vb[db][0]; vf[5] = vb[db][1]; vf[6] = vb[db][2]; vf[7] = vb[db][3];
                    o0[db] = __builtin_amdgcn_mfma_f32_16x16x32_bf16(vf, pf0, o0[db], 0, 0, 0); }
#pragma unroll
                for (int db = 0; db < 4; ++db) { const s16x4 hi = (i < 4) ? vc[db] : vb[db]; bf16x8 vf; vf[0] = vb[db][0]; vf[1] = vb[db][1]; vf[2] = vb[db][2]; vf[3] = vb[db][3]; vf[4] = hi[0]; vf[5] = hi[1]; vf[6] = hi[2]; vf[7] = hi[3];
                    o1[db] = __builtin_amdgcn_mfma_f32_16x16x32_bf16(vf, pf1, o1[db], 0, 0, 0); }
                if (i < 4) {
#pragma unroll
                    for (int db = 0; db < 4; ++db) va[db] = vc[db];
                    ATT_VLOAD(vb, 2 * i + 3); }
            }
#undef ATT_VLOAD
#undef ATT_PACK
            LAS bf16_t* ost = (LAS bf16_t*)(c.lds + 2 * 384 * 72 * 2) + c.wave * (32 * 72);
#pragma unroll
            for (int grp = 0; grp < 2; ++grp) {
                const float inv = 1.f / (grp ? ls1 : ls0);
#pragma unroll
                for (int db = 0; db < 4; ++db) { const f32x4 ov = grp ? o1[db] : o0[db]; u32x2 w; w.x = pk2(ov[0] * inv, ov[1] * inv); w.y = pk2(ov[2] * inv, ov[3] * inv);
                    *(LAS u32x2*)(ost + (grp * 16 + fr) * 72 + db * 16 + 4 * fq) = w; }
                if (fq == 0) { const size_t qtok = tokbase + ((size_t)(l0 + grp * 16 + fr) << dsh) + r; LSE[(size_t)g * NTOK * 16 + qtok * 16 + h] = (grp ? mx1 : mx0) + __log2f(grp ? ls1 : ls0); }
            }
            asm volatile("s_waitcnt lgkmcnt(0)" ::: "memory");
#pragma unroll
            for (int it = 0; it < 4; ++it) { const int rw = it * 8 + (c.lane >> 3), ch = c.lane & 7; const size_t qtok = tokbase + ((size_t)(l0 + rw) << dsh) + r;
                *(u32x4*)(OG + (size_t)g * NTOK * DM + qtok * DM + h * 64 + ch * 8) = *(const LAS u32x4*)(ost + rw * 72 + ch * 8); }
            ASTAMP(18);
        }
    }
    ASTAMP(20);
#undef ATT_LOAD
#undef ATT_DECODE
#undef ATT_UNIT
}
__device__ __forceinline__ void phase_attn_combine(LAS unsigned char* lds_, int wv_) {
    const Ctx c = make_ctx(lds_, wv_);
    unsigned char* ws = fresh_params()->ws;
    const bf16_t* OG = (const bf16_t*)(ws + OFF_R + RA_OG); const float* LSE = (const float*)(ws + OFF_R + RA_LSE); bf16_t* O = (bf16_t*)(ws + OFF_R + RA_Q);
#pragma unroll 2
    for (int row = c.bid * 8 + c.wave; row < NTOK; row += c.G * 8) {
        const int h = c.lane >> 2;
        const float l0 = LSE[(size_t)row * 16 + h], l1 = LSE[(size_t)NTOK * 16 + (size_t)row * 16 + h], l2 = LSE[(size_t)2 * NTOK * 16 + (size_t)row * 16 + h];
        const float m = fmaxf(l0, fmaxf(l1, l2)); float w0 = __builtin_amdgcn_exp2f(l0 - m), w1 = __builtin_amdgcn_exp2f(l1 - m), w2 = __builtin_amdgcn_exp2f(l2 - m); const float iv = 1.f / (w0 + w1 + w2); w0 *= iv; w1 *= iv; w2 *= iv;
        const size_t off = (size_t)row * DM + c.lane * 16;
#pragma unroll
        for (int hf = 0; hf < 2; ++hf) {
            const u32x4 a = *(const u32x4*)(OG + off + hf * 8), bq = *(const u32x4*)(OG + (size_t)NTOK * DM + off + hf * 8), cq = *(const u32x4*)(OG + (size_t)2 * NTOK * DM + off + hf * 8);
            u32x4 o;
#pragma unroll
            for (int k = 0; k < 4; ++k) { const float lo = w0 * bflo(a[k]) + w1 * bflo(bq[k]) + w2 * bflo(cq[k]), hi = w0 * bfhi(a[k]) + w1 * bfhi(bq[k]) + w2 * bfhi(cq[k]); o[k] = pk2(lo, hi); }
            *(u32x4*)(O + off + hf * 8) = o;
        }
    }
}

template <int DK, int DVS, bool ML> struct ScanLds {
    static constexpr int QROW = DK + 8, VROW = DVS + 8;
    static constexpr int QS = 0;
    static constexpr int KS = QS + 64 * QROW * 2;
    static constexpr int VS = KS + 64 * QROW * 2;
    static constexpr int VZ = VS + 64 * VROW * 2;
    static constexpr int PS = VZ + 64 * VROW * 2;
    static constexpr int RBT = PS + 64 * 72 * 2;
    static constexpr int OS = RBT + DVS * QROW * 2;
    static constexpr int SC = OS + 64 * DVS * 4;
    static constexpr int END = SC + 2 * 6 * 64 * 4;
};
template <int DK, int DVS, bool ML>
__device__ __forceinline__ void phase_scan(LAS unsigned char* lds_, int wv_) {
    const Ctx c = make_ctx(lds_, wv_);
    typedef ScanLds<DK, DVS, ML> L; static_assert(L::END <= LDS_BAR, "scan LDS");
    constexpr int QROW = L::QROW, VROW = L::VROW, NCJ = DVS / 16, NRI = DK / 16, NSL = ML ? 4 : 8, NH = ML ? 8 : 4, NRA = (NRI >= 8 ? NRI / 8 : 1);
    constexpr int QCH = 64 * (DK / 8) / 512;
    unsigned char* ws = fresh_params()->ws;
    LAS bf16_t* Qs = (LAS bf16_t*)(c.lds + L::QS); LAS bf16_t* Ksh = (LAS bf16_t*)(c.lds + L::KS); LAS bf16_t* Vs = (LAS bf16_t*)(c.lds + L::VS); LAS bf16_t* Vz = (LAS bf16_t*)(c.lds + L::VZ);
    LAS bf16_t* Ps = (LAS bf16_t*)(c.lds + L::PS); LAS bf16_t* Rbt = (LAS bf16_t*)(c.lds + L::RBT);
    LAS float* Os = (LAS float*)(c.lds + L::OS); LAS float* scb = (LAS float*)(c.lds + L::SC);
    const int fr = c.lane & 15, fq = c.lane >> 4, w = c.wave, tq = (c.lane & 15) >> 2, tp = c.lane & 3;
    for (int u = c.bid; u < NBATCH * NH * NSL; u += c.G) {
        const int b = u / (NH * NSL), h = (u / NSL) % NH, sl = u % NSL;
        __syncthreads();
        for (int i = c.tid; i < DVS * QROW / 2; i += 512) ((LAS unsigned*)Rbt)[i] = 0u;
        for (int i = c.tid; i < 64 * 72 / 2; i += 512) ((LAS unsigned*)Ps)[i] = 0u;
        if (ML) { for (int i = c.tid; i < 64 * VROW; i += 512) { const int cc = i % VROW; Vs[i] = (cc == 32) ? (bf16_t)0x3F80 : (bf16_t)0; Vz[i] = (bf16_t)0; } }
        else if (c.tid < 128) { const float lgm = __logf(1.f - exp2f(-5.f - (float)h)); const int s = c.tid & 63; LAS float* sc = scb + (c.tid >> 6) * 384;
            sc[s] = -(float)s * lgm; sc[64 + s] = -(float)s * lgm; sc[128 + s] = __expf((float)(s + 1) * lgm); sc[192 + s] = __expf((float)(63 - s) * lgm); sc[256 + s] = 0.f; if (s == 0) sc[320] = __expf(64.f * lgm); }
        f32x4 accR[NRA][NCJ];
#pragma unroll
        for (int a = 0; a < NRA; ++a)
#pragma unroll
            for (int q = 0; q < NCJ; ++q) accR[a][q] = (f32x4){0.f, 0.f, 0.f, 0.f};
        float mprev = 0.f;
        const bf16_t* PR = (const bf16_t*)(ws + OFF_R + RB_PROJ);
        const bf16_t* Qg = (const bf16_t*)(ws + OFF_R + RC_Q); const bf16_t* Kg = (const bf16_t*)(ws + OFF_R + RC_K); const bf16_t* Vg = (const bf16_t*)(ws + OFF_R + RC_V);
        const int mrow = (c.tid >> 3) & 63, mcc = c.tid & 7;
        float cwr[2][4][8], cbr[2][8];
        if (ML) { const float* cw = (const float*)(ws + OFF_PAR) + PAR_CONVW; const float* cb = (const float*)(ws + OFF_PAR) + PAR_CONVB;
#pragma unroll
            for (int it = 0; it < 2; ++it) { const int ch0 = it * 512 + h * 64 + mcc * 8;
#pragma unroll
                for (int e = 0; e < 8; ++e) cbr[it][e] = cb[ch0 + e];
#pragma unroll
                for (int j = 0; j < 4; ++j)
#pragma unroll
                    for (int e = 0; e < 8; ++e) cwr[it][j][e] = cw[j * 1024 + ch0 + e]; } }
        u32x4 xr[2][4], qr[QCH > 0 ? QCH : 1], kr[QCH > 0 ? QCH : 1], vr; float gi = 0.f, gf = 0.f;
#define SCAN_LOAD(CH) do { const size_t tok0_ = (size_t)b * SEQ + (size_t)(CH) * 64; \
        if (ML) { _Pragma("unroll") for (int it = 0; it < 2; ++it) { const int ch0 = it * 512 + h * 64 + mcc * 8; \
                _Pragma("unroll") for (int j = 0; j < 4; ++j) { if ((CH) * 64 + mrow - 3 + j >= 0) xr[it][j] = *(const u32x4*)(PR + (tok0_ + mrow - 3 + j) * 3072 + ch0); else xr[it][j] = (u32x4){0u, 0u, 0u, 0u}; } } \
            if (c.tid < 256) vr = *(const u32x4*)(PR + (tok0_ + (c.tid >> 2)) * 3072 + 1024 + h * 128 + sl * 32 + (c.tid & 3) * 8); \
            if (w == 0) { const float* G_ = (const float*)(ws + OFF_GATES) + (tok0_ + c.lane) * 16; gi = G_[h]; gf = G_[8 + h]; } \
        } else { _Pragma("unroll") for (int k = 0; k < QCH; ++k) { const int i_ = c.tid + k * 512, row_ = i_ / (DK / 8), cc_ = i_ - row_ * (DK / 8); \
                qr[k] = *(const u32x4*)(Qg + (tok0_ + row_) * DM + h * DK + cc_ * 8); kr[k] = *(const u32x4*)(Kg + (tok0_ + row_) * DM + h * DK + cc_ * 8); } \
            vr = *(const u32x4*)(Vg + (tok0_ + (c.tid >> 3)) * 2048 + h * 512 + sl * 64 + (c.tid & 7) * 8); } } while (0)
#define SCAN_STORE(NB) do { \
        if (ML) { _Pragma("unroll") for (int it = 0; it < 2; ++it) { float y[8]; \
                _Pragma("unroll") for (int e = 0; e < 8; ++e) y[e] = cbr[it][e]; \
                _Pragma("unroll") for (int j = 0; j < 4; ++j) { const u32x4 x = xr[it][j]; \
                    y[0] += cwr[it][j][0] * bflo(x[0]); y[1] += cwr[it][j][1] * bfhi(x[0]); y[2] += cwr[it][j][2] * bflo(x[1]); y[3] += cwr[it][j][3] * bfhi(x[1]); \
                    y[4] += cwr[it][j][4] * bflo(x[2]); y[5] += cwr[it][j][5] * bfhi(x[2]); y[6] += cwr[it][j][6] * bflo(x[3]); y[7] += cwr[it][j][7] * bfhi(x[3]); } \
                const float ksc = it ? 0.125f : 1.f; \
                _Pragma("unroll") for (int e = 0; e < 8; ++e) y[e] = silu_f(y[e]) * ksc; \
                u32x4 o; o[0] = pk2(y[0], y[1]); o[1] = pk2(y[2], y[3]); o[2] = pk2(y[4], y[5]); o[3] = pk2(y[6], y[7]); \
                *(LAS u32x4*)((it ? Ksh : Qs) + mrow * QROW + mcc * 8) = o; } \
            if (c.tid < 256) *(LAS u32x4*)(Vs + (c.tid >> 2) * VROW + (c.tid & 3) * 8) = vr; \
            if (w == 0) { LAS float* sc = scb + (NB) * 384; \
                const float lf = fminf(gf, 0.f) - log1pf(__expf(-fabsf(gf))); float a = lf; \
                _Pragma("unroll") for (int o = 1; o < 64; o <<= 1) { const float t = __shfl_up(a, o); if (c.lane >= o) a += t; } \
                const float uu = gi - a; float bm = uu; \
                _Pragma("unroll") for (int o = 1; o < 64; o <<= 1) { const float t = __shfl_up(bm, o); if (c.lane >= o) bm = fmaxf(bm, t); } \
                const float bt = fmaxf(mprev, bm), b63 = __shfl(bt, 63), a63 = __shfl(a, 63); \
                sc[c.lane] = uu; sc[64 + c.lane] = bt; sc[128 + c.lane] = __expf(mprev - bt); sc[192 + c.lane] = __expf(uu - b63); sc[256 + c.lane] = __expf(-(a + bt)); \
                if (c.lane == 0) sc[320] = __expf(mprev - b63); \
                mprev = a63 + b63; } \
        } else { _Pragma("unroll") for (int k = 0; k < QCH; ++k) { const int i_ = c.tid + k * 512, row_ = i_ / (DK / 8), cc_ = i_ - row_ * (DK / 8); \
                *(LAS u32x4*)(Qs + row_ * QROW + cc_ * 8) = qr[k]; *(LAS u32x4*)(Ksh + row_ * QROW + cc_ * 8) = kr[k]; } \
            *(LAS u32x4*)(Vs + (c.tid >> 3) * VROW + (c.tid & 7) * 8) = vr; } } while (0)

        SCAN_LOAD(0);
        LDS_BARRIER();
        SCAN_STORE(0);
        LDS_BARRIER();
        for (int ch = 0; ch < 64; ++ch) {
            const size_t tok0 = (size_t)b * SEQ + (size_t)ch * 64;
            LAS float* sc = scb + (ch & 1) * 384;
            LAS float* cu = sc, *rb = sc + 64, *xi = sc + 128, *zeta = sc + 192, *em = sc + 256, *chi = sc + 320;
            if (ch < 63) SCAN_LOAD(ch + 1);
            { constexpr int VCH = (ML ? 32 : 64) / 8;
              if (c.tid < 64 * VCH) { const int row = c.tid / VCH, cc = c.tid - row * VCH; const float z = zeta[row];
                  const u32x4 x = *(const LAS u32x4*)(Vs + row * VROW + cc * 8); u32x4 o;
#pragma unroll
                  for (int e = 0; e < 4; ++e) o[e] = pk2(bflo(x[e]) * z, bfhi(x[e]) * z);
                  *(LAS u32x4*)(Vz + row * VROW + cc * 8) = o; }
              if (ML && c.tid < 64) Vz[c.tid * VROW + 32] = (bf16_t)f2bf(zeta[c.tid]); }
#pragma unroll
            for (int rep = 0; rep < 2; ++rep) {
                const int n = w + 8 * rep;
                if (n < 10) {
                    const int ti = (n >= 6) ? 3 : ((n >= 3) ? 2 : ((n >= 1) ? 1 : 0)), tj = n - ti * (ti + 1) / 2;
                    f32x4 a0 = {0.f, 0.f, 0.f, 0.f};
#pragma unroll
                    for (int ks = 0; ks < DK / 32; ++ks)
                        a0 = __builtin_amdgcn_mfma_f32_16x16x32_bf16(*(const LAS bf16x8*)(Qs + (16 * ti + fr) * QROW + ks * 32 + fq * 8), *(const LAS bf16x8*)(Ksh + (16 * tj + fr) * QROW + ks * 32 + fq * 8), a0, 0, 0, 0);
                    const float cu0 = cu[16 * tj + fr]; const int s0 = 16 * tj + fr;
#pragma unroll
                    for (int rg = 0; rg < 4; ++rg) { const int t = 16 * ti + 4 * fq + rg; Ps[t * 72 + s0] = (bf16_t)f2bf(s0 <= t ? a0[rg] * __expf(cu0 - rb[t]) : 0.f); }
                }
            }
            LDS_BARRIER();
            { const int ti = w >> 1, c0 = (w & 1) ? (NCJ + 1) / 2 : 0, c1 = (w & 1) ? NCJ : (NCJ + 1) / 2;
              const bf16x8 pa0 = *(const LAS bf16x8*)(Ps + (16 * ti + fr) * 72 + fq * 8), pa1 = *(const LAS bf16x8*)(Ps + (16 * ti + fr) * 72 + 32 + fq * 8);
#pragma unroll
              for (int cj = 0; cj < NCJ; ++cj) { if (cj >= c0 && cj < c1) {
                  f32x4 o1 = {0.f, 0.f, 0.f, 0.f}, o2 = {0.f, 0.f, 0.f, 0.f};
#pragma unroll
                  for (int ks = 0; ks < 2; ++ks) { const LAS bf16_t* vp = Vs + (32 * ks + 8 * fq + tq) * VROW + 16 * cj + 4 * tp;
                      const s16x4 x = __builtin_amdgcn_ds_read_tr16_b64_v4i16((LAS s16x4*)vp), y = __builtin_amdgcn_ds_read_tr16_b64_v4i16((LAS s16x4*)(vp + 4 * VROW));
                      bf16x8 vf; vf[0] = x[0]; vf[1] = x[1]; vf[2] = x[2]; vf[3] = x[3]; vf[4] = y[0]; vf[5] = y[1]; vf[6] = y[2]; vf[7] = y[3];
                      o1 = __builtin_amdgcn_mfma_f32_16x16x32_bf16(ks ? pa1 : pa0, vf, o1, 0, 0, 0); }
#pragma unroll
                  for (int ks = 0; ks < DK / 32; ++ks)
                      o2 = __builtin_amdgcn_mfma_f32_16x16x32_bf16(*(const LAS bf16x8*)(Qs + (16 * ti + fr) * QROW + ks * 32 + fq * 8), *(const LAS bf16x8*)(Rbt + (16 * cj + fr) * QROW + ks * 32 + fq * 8), o2, 0, 0, 0);
#pragma unroll
                  for (int rg = 0; rg < 4; ++rg) { const int t = 16 * ti + 4 * fq + rg; Os[t * DVS + 16 * cj + fr] = o1[rg] + xi[t] * o2[rg]; } } } }
            { const float cx = chi[0];
              if (NRI >= 8 || w < NRI) {
#pragma unroll
                  for (int a = 0; a < NRA; ++a) { const int ri = (NRI >= 8) ? w * NRA + a : w;
                      bf16x8 kf[2];
#pragma unroll
                      for (int ks = 0; ks < 2; ++ks) { const LAS bf16_t* kp = Ksh + (32 * ks + 8 * fq + tq) * QROW + 16 * ri + 4 * tp;
                          const s16x4 x = __builtin_amdgcn_ds_read_tr16_b64_v4i16((LAS s16x4*)kp), y = __builtin_amdgcn_ds_read_tr16_b64_v4i16((LAS s16x4*)(kp + 4 * QROW));
                          kf[ks][0] = x[0]; kf[ks][1] = x[1]; kf[ks][2] = x[2]; kf[ks][3] = x[3]; kf[ks][4] = y[0]; kf[ks][5] = y[1]; kf[ks][6] = y[2]; kf[ks][7] = y[3]; }
#pragma unroll
                      for (int cj = 0; cj < NCJ; ++cj) { f32x4 r4 = accR[a][cj] * cx;
#pragma unroll
                          for (int ks = 0; ks < 2; ++ks) { const LAS bf16_t* vp = Vz + (32 * ks + 8 * fq + tq) * VROW + 16 * cj + 4 * tp;
                              const s16x4 x = __builtin_amdgcn_ds_read_tr16_b64_v4i16((LAS s16x4*)vp), y = __builtin_amdgcn_ds_read_tr16_b64_v4i16((LAS s16x4*)(vp + 4 * VROW));
                              bf16x8 vf; vf[0] = x[0]; vf[1] = x[1]; vf[2] = x[2]; vf[3] = x[3]; vf[4] = y[0]; vf[5] = y[1]; vf[6] = y[2]; vf[7] = y[3];
                              r4 = __builtin_amdgcn_mfma_f32_16x16x32_bf16(kf[ks], vf, r4, 0, 0, 0); }
                          accR[a][cj] = r4; } } } }
            LDS_BARRIER();
            if (NRI >= 8 || w < NRI) {
#pragma unroll
                for (int a = 0; a < NRA; ++a) { const int ri = (NRI >= 8) ? w * NRA + a : w;
#pragma unroll
                    for (int cj = 0; cj < NCJ; ++cj) { const f32x4 r4 = accR[a][cj];
                        u32x2 wv; wv.x = pk2(r4[0], r4[1]); wv.y = pk2(r4[2], r4[3]); *(LAS u32x2*)(Rbt + (16 * cj + fr) * QROW + 16 * ri + 4 * fq) = wv; } } }
            if (ML) { bf16_t* OR = (bf16_t*)(ws + OFF_R + RB_ORAW);
                const int t = c.tid >> 3, c4 = (c.tid & 7) * 4; const float den = Os[t * DVS + 32], dn = 1.f / fmaxf(fabsf(den), em[t]);
                const f32x4 x = *(const LAS f32x4*)(Os + t * DVS + c4); u32x2 wv; wv.x = pk2(x[0] * dn, x[1] * dn); wv.y = pk2(x[2] * dn, x[3] * dn);
                *(u32x2*)(OR + (tok0 + t) * DM + h * 128 + sl * 32 + c4) = wv;
            } else { bf16_t* OR = (bf16_t*)(ws + OFF_R + RC_ORAW);
                const int t = c.tid >> 3, c8 = (c.tid & 7) * 8; const f32x4 x0 = *(const LAS f32x4*)(Os + t * DVS + c8), x1 = *(const LAS f32x4*)(Os + t * DVS + c8 + 4);
                u32x4 wv; wv[0] = pk2(x0[0], x0[1]); wv[1] = pk2(x0[2], x0[3]); wv[2] = pk2(x1[0], x1[1]); wv[3] = pk2(x1[2], x1[3]);
                *(u32x4*)(OR + (tok0 + t) * 2048 + h * 512 + sl * 64 + c8) = wv; }
            if (ch < 63) SCAN_STORE((ch + 1) & 1);
            LDS_BARRIER();
        }
#undef SCAN_LOAD
#undef SCAN_STORE
    }
}

__device__ __forceinline__ void phase_norm_b(LAS unsigned char* lds_, int wv_) {
    const Ctx c = make_ctx(lds_, wv_);
    unsigned char* ws = fresh_params()->ws;
    const bf16_t* OR = (const bf16_t*)(ws + OFF_R + RB_ORAW); const bf16_t* PR = (const bf16_t*)(ws + OFF_R + RB_PROJ); bf16_t* ON = (bf16_t*)(ws + OFF_R + RB_ONORM);
    const float* ng = (const float*)(ws + OFF_PAR) + PAR_BNG;
    float gv[16];
#pragma unroll
    for (int k = 0; k < 16; ++k) gv[k] = ng[c.lane * 16 + k];
#pragma unroll 2
    for (int row = c.bid * 8 + c.wave; row < NTOK; row += c.G * 8) {
        float x[16], gt[16];
#pragma unroll
        for (int hf = 0; hf < 2; ++hf) { const u32x4 a = *(const u32x4*)(OR + (size_t)row * DM + c.lane * 16 + hf * 8), gq = *(const u32x4*)(PR + (size_t)row * 3072 + 2048 + c.lane * 16 + hf * 8);
#pragma unroll
            for (int k = 0; k < 4; ++k) { x[hf * 8 + 2 * k] = bflo(a[k]); x[hf * 8 + 2 * k + 1] = bfhi(a[k]); gt[hf * 8 + 2 * k] = bflo(gq[k]); gt[hf * 8 + 2 * k + 1] = bfhi(gq[k]); } }
        float s = 0.f;
#pragma unroll
        for (int k = 0; k < 16; ++k) s += x[k];
        s += __shfl_xor(s, 1); s += __shfl_xor(s, 2); s += __shfl_xor(s, 4);
        const float mu = s * (1.f / 128.f); float q = 0.f;
#pragma unroll
        for (int k = 0; k < 16; ++k) { x[k] -= mu; q += x[k] * x[k]; }
        q += __shfl_xor(q, 1); q += __shfl_xor(q, 2); q += __shfl_xor(q, 4);
        const float rstd = 1.f / sqrtf(q * (1.f / 128.f) + LN_EPS);
        u32x4 o0, o1;
#pragma unroll
        for (int k = 0; k < 4; ++k) { o0[k] = pk2(x[2 * k] * rstd * gv[2 * k] * sigmoid_f(gt[2 * k]), x[2 * k + 1] * rstd * gv[2 * k + 1] * sigmoid_f(gt[2 * k + 1]));
            o1[k] = pk2(x[8 + 2 * k] * rstd * gv[8 + 2 * k] * sigmoid_f(gt[8 + 2 * k]), x[9 + 2 * k] * rstd * gv[9 + 2 * k] * sigmoid_f(gt[9 + 2 * k])); }
        *(u32x4*)(ON + (size_t)row * DM + c.lane * 16) = o0; *(u32x4*)(ON + (size_t)row * DM + c.lane * 16 + 8) = o1;
    }
}
__device__ __forceinline__ void phase_norm_c(LAS unsigned char* lds_, int wv_) {
    const Ctx c = make_ctx(lds_, wv_);
    unsigned char* ws = fresh_params()->ws;
    const bf16_t* OR = (const bf16_t*)(ws + OFF_R + RC_ORAW); const bf16_t* GG = (const bf16_t*)(ws + OFF_R + RC_G); bf16_t* ON = (bf16_t*)(ws + OFF_R + RC_V);
    const float* ng = (const float*)(ws + OFF_PAR) + PAR_CNG;
#pragma unroll 2
    for (int row = c.bid * 8 + c.wave; row < NTOK; row += c.G * 8) {
        float x[32];
#pragma unroll
        for (int qd = 0; qd < 4; ++qd) { const u32x4 a = *(const u32x4*)(OR + (size_t)row * 2048 + c.lane * 32 + qd * 8);
#pragma unroll
            for (int k = 0; k < 4; ++k) { x[qd * 8 + 2 * k] = bflo(a[k]); x[qd * 8 + 2 * k + 1] = bfhi(a[k]); } }
        float s = 0.f;
#pragma unroll
        for (int k = 0; k < 32; ++k) s += x[k];
        s += __shfl_xor(s, 1); s += __shfl_xor(s, 2); s += __shfl_xor(s, 4); s += __shfl_xor(s, 8);
        const float mu = s * (1.f / 512.f); float q = 0.f;
#pragma unroll
        for (int k = 0; k < 32; ++k) { x[k] -= mu; q += x[k] * x[k]; }
        q += __shfl_xor(q, 1); q += __shfl_xor(q, 2); q += __shfl_xor(q, 4); q += __shfl_xor(q, 8);
        const float rstd = 1.f / sqrtf(q * (1.f / 512.f) + LN_EPS);
#pragma unroll
        for (int qd = 0; qd < 4; ++qd) { const u32x4 gq = *(const u32x4*)(GG + (size_t)row * 2048 + c.lane * 32 + qd * 8);
            const f32x4 g0 = *(const f32x4*)(ng + c.lane * 32 + qd * 8), g1 = *(const f32x4*)(ng + c.lane * 32 + qd * 8 + 4);
            u32x4 o;
#pragma unroll
            for (int k = 0; k < 4; ++k) { const float ga = (k < 2) ? g0[2 * k] : g1[2 * k - 4], gb = (k < 2) ? g0[2 * k + 1] : g1[2 * k - 3];
                o[k] = pk2(x[qd * 8 + 2 * k] * rstd * ga * silu_f(bflo(gq[k])), x[qd * 8 + 2 * k + 1] * rstd * gb * silu_f(bfhi(gq[k]))); }
            *(u32x4*)(ON + (size_t)row * 2048 + c.lane * 32 + qd * 8) = o; }
    }
}

#define WS_FRESH() unsigned char* ws = fresh_params()->ws
__device__ __forceinline__ void gemm_qkv_a(LAS unsigned char* lds_, int wv_, int jj) { const Ctx c = make_ctx(lds_, wv_); jj = __builtin_amdgcn_readfirstlane(jj); asm volatile("" : "+s"(jj)); WS_FRESH();
    pg8::Gemm g{(const pg8::bf16_t*)(ws + OFF_HB), (const pg8::bf16_t*)(ws + OFF_WA_IN) + (size_t)jj * 3072 * 1024, NTOK, 3072, 1024}; pg8::StaticOrder S; S.init(NTOK, 3072, c.G, c.bid);
    pg8::EpiQkvA E{(bf16_t*)(ws + OFF_R + RA_Q), SZ_TOK1K / 2, (const float*)(ws + OFF_COSA), (const float*)(ws + OFF_SINA)};
    pg8::gemm_phase<pg8::EpiQkvA, pg8::StaticOrder, true, true>(c.lds, g, S, E, c.tid); }
__device__ __forceinline__ void gemm_proj_b(LAS unsigned char* lds_, int wv_) { const Ctx c = make_ctx(lds_, wv_); WS_FRESH();
    pg8::Gemm g{(const pg8::bf16_t*)(ws + OFF_HB), (const pg8::bf16_t*)(ws + OFF_WB_IN), NTOK, 3072, 1024}; pg8::StaticOrder S; S.init(NTOK, 3072, c.G, c.bid);
    pg8::EpiBf16Plain E{(bf16_t*)(ws + OFF_R + RB_PROJ), 3072};
    pg8::gemm_phase<pg8::EpiBf16Plain, pg8::StaticOrder, true, true>(c.lds, g, S, E, c.tid); }
__device__ __forceinline__ void gemm_proj_c(LAS unsigned char* lds_, int wv_) { const Ctx c = make_ctx(lds_, wv_); WS_FRESH();
    pg8::Gemm g{(const pg8::bf16_t*)(ws + OFF_HB), (const pg8::bf16_t*)(ws + OFF_WC_IN), NTOK, 6144, 1024}; pg8::StaticOrder S; S.init(NTOK, 6144, c.G, c.bid);
    pg8::EpiProjC E{(bf16_t*)(ws + OFF_R + RC_Q), (bf16_t*)(ws + OFF_R + RC_V), (RC_K - RC_Q) / 2, (RC_G - RC_V) / 2, (const float*)(ws + OFF_COSC), (const float*)(ws + OFF_SINC)};
    pg8::gemm_phase<pg8::EpiProjC, pg8::StaticOrder, true, true>(c.lds, g, S, E, c.tid); }
__device__ __forceinline__ void gemm_out(LAS unsigned char* lds_, int wv_, int kind, int jj, bool first) { const Ctx c = make_ctx(lds_, wv_); kind = __builtin_amdgcn_readfirstlane(kind); asm volatile("" : "+s"(kind)); jj = __builtin_amdgcn_readfirstlane(jj); asm volatile("" : "+s"(jj)); WS_FRESH();
    const size_t aoff = OFF_R + (kind == 0 ? RA_Q : (kind == 1 ? RB_ONORM : RC_V));
    const size_t boff = kind == 0 ? OFF_WA_OUT + (size_t)jj * 1024 * 1024 * 2 : (kind == 1 ? OFF_WB_OUT : OFF_WC_OUT);
    pg8::Gemm g{(const pg8::bf16_t*)(ws + aoff), (const pg8::bf16_t*)(ws + boff), NTOK, 1024, kind == 2 ? 2048 : 1024}; pg8::StaticOrder S; S.init(NTOK, 1024, c.G, c.bid);
    pg8::EpiResidual E{(const bf16_t*)(ws + OFF_HB), (float*)(ws + OFF_H), DN_ALPHA};
    pg8::gemm_phase<pg8::EpiResidual, pg8::StaticOrder, true, true>(c.lds, g, S, E, c.tid); }
__device__ __forceinline__ void gemm_moe_gu(LAS unsigned char* lds_, int wv_) { const Ctx c = make_ctx(lds_, wv_); WS_FRESH();
    const LAS int* misc = (const LAS int*)(c.lds + LDS_MISC); const int ntiles = __builtin_amdgcn_readfirstlane(misc[0]);
    pg8::MoeOrder S{misc + 1, ntiles, 2, 2, c.G, c.bid}; pg8::EpiMoeGU E{(bf16_t*)(ws + OFF_R + RM_HID)};
    LAS int* rt = (LAS int*)(c.lds + LDS_MISC + 2048); const int* ROWTOK = (const int*)(ws + OFF_ROWTOK);
    { pg8::Unit u; for (int i = 0; i < 8 && S.next(i, u); ++i) if (c.tid < 256) rt[i * 256 + c.tid] = ROWTOK[u.pm * 256 + c.tid]; }
    __syncthreads();
    pg8::Gemm g{(const pg8::bf16_t*)(ws + OFF_HB), (const pg8::bf16_t*)(ws + OFF_WE_GU), 0, 0, 1024, rt};
    pg8::gemm_phase<pg8::EpiMoeGU, pg8::MoeOrder, true, true, true>(c.lds, g, S, E, c.tid); }
__device__ __forceinline__ void gemm_moe_down(LAS unsigned char* lds_, int wv_) { const Ctx c = make_ctx(lds_, wv_); WS_FRESH();
    const LAS int* misc = (const LAS int*)(c.lds + LDS_MISC); const int ntiles = __builtin_amdgcn_readfirstlane(misc[0]);
    pg8::Gemm g{(const pg8::bf16_t*)(ws + OFF_R + RM_HID), (const pg8::bf16_t*)(ws + OFF_WE_D), 0, 0, 256};
    pg8::MoeOrder S{misc + 1, ntiles, 4, 4, c.G, c.bid}; pg8::EpiMoeDown E{(bf16_t*)(ws + OFF_R + RM_YEXP), (const float*)(ws + OFF_ROWGATE)};
    pg8::gemm_phase<pg8::EpiMoeDown, pg8::MoeOrder, true, true>(c.lds, g, S, E, c.tid); }


#define XB_TMO      128
#define XB_XCNT(j)  (256  + 64 * (j))
#define XB_XSUB(j)  (1280 + 64 * (j))
#define XB_XGEN(j)  (2304 + 64 * (j))
#define XB_TOP      3328
#define XB_TOPGEN   3392
#define XCD_BAR_WORDS 3456
#define XB_SPIN_CAP (1u << 22)
__device__ __forceinline__ unsigned xb_ld(unsigned* p)              { return __hip_atomic_load(p, __ATOMIC_RELAXED, __HIP_MEMORY_SCOPE_AGENT); }
__device__ __forceinline__ unsigned xb_add(unsigned* p, unsigned v) { return __hip_atomic_fetch_add(p, v, __ATOMIC_RELAXED, __HIP_MEMORY_SCOPE_AGENT); }
__device__ __forceinline__ unsigned xb_xcc_id() { return (unsigned)__builtin_amdgcn_s_getreg((3 << 11) | 20) & 0xFu; }
#define XB_SPIN(cond, bar) do { unsigned _sp = 0; while (cond) { __builtin_amdgcn_s_sleep(1); \
    if ((++_sp & 255u) == 0u) { if (xb_ld(&(bar)[XB_TMO])) break; if (_sp > XB_SPIN_CAP) { atomicAdd(&(bar)[XB_TMO], 1u); break; } } } } while (0)
__device__ __forceinline__ void xcd_barrier_post(LAS unsigned char* lds, int wv) {
    unsigned* bar = (unsigned*)(fresh_params()->ws + OFF_BAR);
    if (wv == 0 && __builtin_amdgcn_mbcnt_hi(~0u, __builtin_amdgcn_mbcnt_lo(~0u, 0u)) == 0u) { volatile LAS unsigned* st = (volatile LAS unsigned*)(lds + LDS_BAR); st[0] = 0u; st[1] = 0u; (void)xb_add(&bar[XB_XCNT(xb_xcc_id())], 1u); }
    __syncthreads();
}
__device__ __forceinline__ void xcd_barrier_complete(unsigned* bar, unsigned x, unsigned& nloc, unsigned& nx) {
    const unsigned G = gridDim.x * gridDim.y * gridDim.z;
    unsigned sum, cnt, mine, sp = 0u;
    for (;;) {
        sum = 0u; cnt = 0u; mine = 0u;
#pragma unroll
        for (unsigned j = 0; j < 16; ++j) { const unsigned c = xb_ld(&bar[XB_XCNT(j)]); sum += c; cnt += (c > 0u) ? 1u : 0u; mine = (j == x) ? c : mine; }
        if (sum == G) break;
        __builtin_amdgcn_s_sleep(1);
        if ((++sp & 255u) == 0u) { if (xb_ld(&bar[XB_TMO])) break; if (sp > XB_SPIN_CAP) { atomicAdd(&bar[XB_TMO], 1u); break; } }
    }
    nloc = mine > 0u ? mine : 1u; nx = cnt > 0u ? cnt : 1u;
}
__device__ __forceinline__ void xcd_barrier(LAS unsigned char* lds, int wv) {
    unsigned* bar = (unsigned*)(fresh_params()->ws + OFF_BAR);
    asm volatile("s_waitcnt vmcnt(0)" ::: "memory");
    __syncthreads();
    if (wv == 0 && __builtin_amdgcn_mbcnt_hi(~0u, __builtin_amdgcn_mbcnt_lo(~0u, 0u)) == 0u) {
        const unsigned x = xb_xcc_id(); volatile LAS unsigned* st = (volatile LAS unsigned*)(lds + LDS_BAR);
        __builtin_amdgcn_s_waitcnt(0);
        unsigned nloc = st[0], nx = st[1];
        if (nloc == 0u) { xcd_barrier_complete(bar, x, nloc, nx); st[0] = nloc; st[1] = nx; }
        const unsigned old = xb_add(&bar[XB_XSUB(x)], 1u);
        const unsigned gen = old / nloc;
        if (old + 1u == (gen + 1u) * nloc) {
            __builtin_amdgcn_fence(__ATOMIC_RELEASE, "agent");
            asm volatile("s_waitcnt vmcnt(0)" ::: "memory");
            const unsigned og = xb_add(&bar[XB_TOP], 1u);
            const unsigned tg = og / nx;
            if (og + 1u == (tg + 1u) * nx) xb_add(&bar[XB_TOPGEN], 1u);
            else XB_SPIN(xb_ld(&bar[XB_TOPGEN]) == tg, bar);
            __builtin_amdgcn_fence(__ATOMIC_ACQUIRE, "agent");
            xb_add(&bar[XB_XGEN(x)], 1u);
            asm volatile("s_waitcnt vmcnt(0)" ::: "memory");
        } else {
            XB_SPIN(xb_ld(&bar[XB_XGEN(x)]) == gen, bar);
            __builtin_amdgcn_fence(__ATOMIC_ACQUIRE, "agent");
            asm volatile("s_waitcnt vmcnt(0)" ::: "memory");
        }
    }
    __syncthreads();
}
#ifdef USE_CG_SYNC
#define GRID_SYNC() grid.sync()
#else
#define GRID_SYNC() xcd_barrier(lds, wv)
#endif

#ifdef DBL_SYNC
#define STAMP(type) GRID_SYNC()
#elif defined(PROBE_A) || defined(PROBE_W)
#define STAMP(type) do { if (blockIdx.x == 0 && threadIdx.x == 0) { const unsigned long long t_ = __builtin_amdgcn_s_memrealtime(); unsigned long long* TS_ = (unsigned long long*)(fresh_params()->ws + OFF_CTL + 131072); TS_[32 + (type)] += t_ - TS_[0]; TS_[0] = t_; } } while (0)
#else
#define STAMP(type) do { } while (0)
#endif
__global__ void __launch_bounds__(512, 2) fwd_megakernel(Params p) {
    extern __shared__ __attribute__((aligned(16))) unsigned char lds_raw[];
    cg::grid_group grid = cg::this_grid();
    LAS unsigned char* lds = (LAS unsigned char*)lds_raw;
    const int wv = __builtin_amdgcn_readfirstlane((int)(threadIdx.x >> 6));
#if defined(PROBE_A) || defined(PROBE_W)
    if (blockIdx.x == 0 && threadIdx.x == 0) { unsigned long long* TS_ = (unsigned long long*)(fresh_params()->ws + OFF_CTL + 131072); for (int i = 0; i < 32; ++i) TS_[32 + i] = 0ull; TS_[0] = __builtin_amdgcn_s_memrealtime(); }
#endif

    xcd_barrier_post(lds, wv);
    phase_prologue(lds, wv);
#ifdef DBL_PRO
    grid.sync();
    phase_prologue(lds, wv);
#endif
    grid.sync(); STAMP(0);

#pragma unroll 1
    for (int layer = 0; layer < DEPTH; ++layer) {
        const int kind = layer % 3, jj = layer / 3;
        const bool mix_on = (kind == 0) ? (EN_MIX_A != 0) : (kind == 1 ? (EN_MIX_B != 0) : (EN_MIX_C != 0));
        if (mix_on) {
            if (kind == 0) {
#if EN_MIX_A
                gemm_qkv_a(lds, wv, jj);
#ifdef DBL_INPROJ
                GRID_SYNC();
                gemm_qkv_a(lds, wv, jj);
#endif
                GRID_SYNC(); STAMP(1);
                phase_attn(lds, wv);
#ifdef DBL_ATTN
                GRID_SYNC();
                phase_attn(lds, wv);
#endif
                GRID_SYNC(); STAMP(2);
                phase_attn_combine(lds, wv);
#ifdef DBL_NORMS
                GRID_SYNC();
                phase_attn_combine(lds, wv);
#endif
                GRID_SYNC(); STAMP(3);
#endif
            } else if (kind == 1) {
#if EN_MIX_B
                gemm_proj_b(lds, wv);
#ifdef DBL_INPROJ
                GRID_SYNC();
                gemm_proj_b(lds, wv);
#endif
                GRID_SYNC(); STAMP(4);
                phase_scan<64, 48, true>(lds, wv);
#ifdef DBL_SCANB
                GRID_SYNC();
                phase_scan<64, 48, true>(lds, wv);
#endif
                GRID_SYNC(); STAMP(5);
                phase_norm_b(lds, wv);
#ifdef DBL_NORMS
                GRID_SYNC();
                phase_norm_b(lds, wv);
#endif
                GRID_SYNC(); STAMP(6);
#endif
            } else {
#if EN_MIX_C
                gemm_proj_c(lds, wv);
#ifdef DBL_INPROJ
                GRID_SYNC();
                gemm_proj_c(lds, wv);
#endif
                GRID_SYNC(); STAMP(7);
                phase_scan<256, 64, false>(lds, wv);
#ifdef DBL_SCANC
                GRID_SYNC();
                phase_scan<256, 64, false>(lds, wv);
#endif
                GRID_SYNC(); STAMP(8);
                phase_norm_c(lds, wv);
#ifdef DBL_NORMS
                GRID_SYNC();
                phase_norm_c(lds, wv);
#endif
                GRID_SYNC(); STAMP(9);
#endif
            }
            gemm_out(lds, wv, kind, jj, layer == 0);
            GRID_SYNC(); STAMP(10);
        }
        phase_ln1_router(lds, wv, layer, mix_on, EN_MOE != 0);
        GRID_SYNC(); STAMP(11);
#if EN_MOE
        convert_experts(lds, wv, layer);
        __syncthreads();
        phase_moe_scan(lds, wv);
#ifdef DBL_MOESCAN
        GRID_SYNC();
        convert_experts(lds, wv, layer);
        __syncthreads();
        phase_moe_scan(lds, wv);
#endif
        GRID_SYNC(); STAMP(12);
        gemm_moe_gu(lds, wv);
#ifdef DBL_MOEGEMM
        GRID_SYNC();
        gemm_moe_gu(lds, wv);
#endif
        GRID_SYNC(); STAMP(13);
        gemm_moe_down(lds, wv);
#ifdef DBL_MOEGEMM
        GRID_SYNC();
        gemm_moe_down(lds, wv);
#endif
        GRID_SYNC(); STAMP(14);
#endif
        phase_ln2(lds, wv, layer, layer == DEPTH - 1, EN_MOE != 0, (layer + 1 < DEPTH) && ((layer + 1) % 3 == 1) && (EN_MIX_B != 0));
        GRID_SYNC(); STAMP(15);
    }
#ifdef PROBE_W
    if (blockIdx.x == 0 && threadIdx.x == 0) { const unsigned long long* TS_ = (const unsigned long long*)(fresh_params()->ws + OFF_CTL + 131072);
        const unsigned long long w_ = (unsigned long long)PROBE_K * TS_[32 + PROBE_W], t0_ = __builtin_amdgcn_s_memrealtime();
        while (__builtin_amdgcn_s_memrealtime() - t0_ < w_) __builtin_amdgcn_s_sleep(8); }
#endif
#ifdef PROBE_A
    GRID_SYNC();
    { ParamsK q = fresh_params(); const unsigned long long* TS_ = (const unsigned long long*)(q->ws + OFF_CTL + 131072);
      const float ta = (float)__hip_atomic_load(TS_ + 32 + PROBE_A, __ATOMIC_RELAXED, __HIP_MEMORY_SCOPE_AGENT) * 0.01f, tb = (float)__hip_atomic_load(TS_ + 32 + PROBE_B, __ATOMIC_RELAXED, __HIP_MEMORY_SCOPE_AGENT) * 0.01f;
      const float dl = sqrtf(tb * 1e-4f); float* o = q->out;
      for (size_t i = (size_t)blockIdx.x * 512 + threadIdx.x; i < (size_t)NTOK * DM; i += (size_t)gridDim.x * 512) o[i] = (i == 0) ? 20.f + 0.1f * ta : o[i] + dl; }
#endif
}

extern "C" void kernel_launch(void* const* d_in, const int* in_sizes, int n_in, void* d_out, int out_size, void* d_ws, size_t ws_size, hipStream_t stream) {
    static int grid = 0;
    if (grid == 0) {
        if (n_in != 24 || in_sizes[0] != NTOK * DM || out_size != NTOK * DM || ws_size < WS_END) {
            fprintf(stderr, "kernel_launch: built for 24 inputs, x/out of %d floats, >= %zu bytes of workspace; got n_in %d, in0 %d, out %d, ws %zu; nothing launched\n", NTOK * DM, (size_t)WS_END, n_in, n_in > 0 ? in_sizes[0] : -1, out_size, ws_size);
            grid = -1; return; }
        int dev = 0, cus = 0, per_cu = 0;
        if (hipGetDevice(&dev) != hipSuccess || hipDeviceGetAttribute(&cus, hipDeviceAttributeMultiprocessorCount, dev) != hipSuccess) { fprintf(stderr, "kernel_launch: device query failed\n"); grid = -1; return; }
        if (hipFuncSetAttribute((const void*)fwd_megakernel, hipFuncAttributeMaxDynamicSharedMemorySize, LDS_BYTES) != hipSuccess) { fprintf(stderr, "kernel_launch: hipFuncSetAttribute(%d B LDS) failed\n", LDS_BYTES); grid = -1; return; }
        if (hipOccupancyMaxActiveBlocksPerMultiprocessor(&per_cu, (const void*)fwd_megakernel, 512, LDS_BYTES) != hipSuccess || per_cu < 1) { fprintf(stderr, "kernel_launch: occupancy query says %d blocks per CU\n", per_cu); (void)hipGetLastError(); per_cu = 1; }
        grid = cus * (per_cu > 1 ? 1 : per_cu);
    }
    if (grid < 0) return;
    Params p{};
    for (int i = 0; i < 24; ++i) p.in[i] = (const float*)d_in[i];
    p.out = (float*)d_out; p.ws = (unsigned char*)d_ws;
    for (int i = 0; i < 8; ++i) p.invA[i] = pow(500000.0, -(double)(2 * i) / 16.0);
    for (int i = 0; i < 128; ++i) p.invC[i] = pow(10000.0, -(double)(2 * i) / 256.0);
    if (hipMemsetAsync((char*)d_ws + OFF_BAR, 0, 16384, stream) != hipSuccess) { fprintf(stderr, "kernel_launch: hipMemsetAsync of the barrier words failed\n"); return; }
    void* args[] = {&p};
    const hipError_t e = hipLaunchCooperativeKernel((const void*)fwd_megakernel, dim3(grid), dim3(512), args, LDS_BYTES, stream);
    if (e != hipSuccess) fprintf(stderr, "kernel_launch: cooperative launch failed: %s (grid %d, %d B LDS)\n", hipGetErrorString(e), grid, LDS_BYTES);
}
```
